# Optimizing an MI355X kernel written in HIP

```python
import jax, jax.numpy as jnp
from jax import lax
import numpy as np

D_MODEL = 1024
BATCH = 16
SEQ = 2048
DEPTH = 4

N_MIXERS = 2
HEAD_DIM = 64
ROPE_THETA = 10000.0
NORM_EPS = 1e-6
Q_BLOCK = 128
NSA_Q_HEADS = D_MODEL // HEAD_DIM
NSA_KV_HEADS = 4
NSA_GROUP = NSA_Q_HEADS // NSA_KV_HEADS
CMP_BLOCK = 32
CMP_STRIDE = 16
CMP_HIDDEN = 4 * HEAD_DIM
SEL_BLOCK = 64
SEL_TOPK = 8
SEL_Q_CHUNK = 32
NSA_WINDOW = 512
NSA_IN = NSA_Q_HEADS * HEAD_DIM + 6 * NSA_KV_HEADS * HEAD_DIM + 3 * NSA_Q_HEADS
SWA_Q_HEADS = D_MODEL // HEAD_DIM
SWA_KV_HEADS = 2
SWA_GROUP = SWA_Q_HEADS // SWA_KV_HEADS
SWA_WINDOW = 128
SWA_IN = SWA_Q_HEADS * HEAD_DIM + 2 * SWA_KV_HEADS * HEAD_DIM
MLP_HIDDEN = 4 * D_MODEL

kernel_name = "hybrid_nsa_swa_sink_sqrelu_adaln"


def rms_norm(x, g):
    xf = x.astype(jnp.float32)
    y = xf * lax.rsqrt(jnp.mean(xf * xf, axis=-1, keepdims=True) + NORM_EPS)
    return (y * g.astype(jnp.float32)).astype(x.dtype)


def modulate(h, shift, scale):
    return h * (1 + scale[:, None, :]) + shift[:, None, :]


def rope_tables(positions):
    inv = 1.0 / (ROPE_THETA ** (jnp.arange(0, HEAD_DIM, 2, dtype=jnp.float32) / HEAD_DIM))
    ang = positions.astype(jnp.float32)[..., None] * inv
    return jnp.cos(ang)[:, :, None, :], jnp.sin(ang)[:, :, None, :]


def apply_rope(x, cos, sin):
    x1, x2 = jnp.split(x.astype(jnp.float32), 2, axis=-1)
    return jnp.concatenate([x1 * cos - x2 * sin, x2 * cos + x1 * sin], axis=-1).astype(x.dtype)


def banded_attention(q, k, v, window, sinks):
    B, S, Hkv, G, dh = q.shape
    span = window + Q_BLOCK
    pad = ((0, 0), (window, 0), (0, 0), (0, 0))
    kp = jnp.pad(k, pad)
    vp = jnp.pad(v, pad)
    scale = dh ** -0.5

    def block(bi):
        s0 = bi * Q_BLOCK
        qb = lax.dynamic_slice_in_dim(q, s0, Q_BLOCK, axis=1)
        kb = lax.dynamic_slice_in_dim(kp, s0, span, axis=1)
        vb = lax.dynamic_slice_in_dim(vp, s0, span, axis=1)
        s = jnp.einsum('bqhgd,bkhd->bhgqk', qb, kb).astype(jnp.float32) * scale
        t = s0 + jnp.arange(Q_BLOCK)
        j = s0 - window + jnp.arange(span)
        dist = t[:, None] - j[None, :]
        mask = (dist >= 0) & (dist < window) & (j[None, :] >= 0)
        s = jnp.where(mask, s, -jnp.inf)
        if sinks is None:
            p = jax.nn.softmax(s, axis=-1)
        else:
            sk = sinks.astype(jnp.float32)[None, :, :, None, None]
            m = jnp.maximum(jnp.max(s, axis=-1, keepdims=True), sk)
            e = jnp.exp(s - m)
            p = e / (jnp.sum(e, axis=-1, keepdims=True) + jnp.exp(sk - m))
        return jnp.einsum('bhgqk,bkhd->bqhgd', p.astype(v.dtype), vb)

    out = lax.map(block, jnp.arange(S // Q_BLOCK))
    return jnp.moveaxis(out, 0, 1).reshape(B, S, Hkv, G, dh)


def compress_tokens(x, pe, w1, b1, w2, b2):
    B, S, Hkv, dh = x.shape
    n_cmp = (S - CMP_BLOCK) // CMP_STRIDE + 1
    idx = np.arange(n_cmp)[:, None] * CMP_STRIDE + np.arange(CMP_BLOCK)[None, :]
    xb = x[:, idx] + pe[None, None, :, None, :]
    xb = jnp.moveaxis(xb, 3, 2).reshape(B, n_cmp, Hkv, CMP_BLOCK * dh)
    return jax.nn.gelu(xb @ w1 + b1) @ w2 + b2


def compressed_attention(q, kc, vc):
    B, S, Hkv, G, dh = q.shape
    n_cmp = kc.shape[1]
    s = jnp.einsum('bshgd,bnhd->bhgsn', q, kc).astype(jnp.float32) * dh ** -0.5
    blk_end = jnp.arange(n_cmp) * CMP_STRIDE + CMP_BLOCK - 1
    mask = blk_end[None, :] <= jnp.arange(S)[:, None]
    s = jnp.where(mask, s, -jnp.inf)
    m = jnp.max(s, axis=-1, keepdims=True)
    m = jnp.where(jnp.isfinite(m), m, 0.0)
    e = jnp.where(mask, jnp.exp(s - m), 0.0)
    den = jnp.sum(e, axis=-1, keepdims=True)
    p = e / jnp.where(den > 0, den, 1.0)
    o = jnp.einsum('bhgsn,bnhd->bshgd', p.astype(vc.dtype), vc)
    return o, p


def select_blocks(p_cmp, S):
    n_cmp = p_cmp.shape[-1]
    n_sel = S // SEL_BLOCK
    cs = np.arange(n_cmp)[:, None] * CMP_STRIDE
    ss = np.arange(n_sel)[None, :] * SEL_BLOCK
    overlap = np.clip(np.minimum(cs + CMP_BLOCK, ss + SEL_BLOCK) - np.maximum(cs, ss), 0, None)
    M = jnp.asarray((overlap / CMP_STRIDE).astype(np.float32))
    imp = jnp.einsum('bhgsn,nj->bhsj', p_cmp, M)
    cur = jnp.arange(S) // SEL_BLOCK
    jj = jnp.arange(n_sel)
    causal = jj[None, :] <= cur[:, None]
    forced = (jj[None, :] == 0) | (jj[None, :] == cur[:, None]) | (jj[None, :] == cur[:, None] - 1)
    imp = jnp.where(forced, jnp.inf, jnp.where(causal, imp, -jnp.inf))
    _, idx = lax.top_k(imp, min(SEL_TOPK, n_sel))
    return idx


def selected_block_attention(q, k, v, sel_idx):
    B, S, Hkv, G, dh = q.shape
    n_sel = S // SEL_BLOCK
    kb = k.reshape(B, n_sel, SEL_BLOCK, Hkv, dh).transpose(0, 3, 1, 2, 4)
    vb = v.reshape(B, n_sel, SEL_BLOCK, Hkv, dh).transpose(0, 3, 1, 2, 4)
    bi = jnp.arange(B)[:, None, None, None]
    hi = jnp.arange(Hkv)[None, :, None, None]
    scale = dh ** -0.5

    def chunk(ci):
        s0 = ci * SEL_Q_CHUNK
        qc = lax.dynamic_slice_in_dim(q, s0, SEL_Q_CHUNK, axis=1)
        ic = lax.dynamic_slice_in_dim(sel_idx, s0, SEL_Q_CHUNK, axis=2)
        kg = kb[bi, hi, ic]
        vg = vb[bi, hi, ic]
        s = jnp.einsum('bqhgd,bhqnld->bhgqnl', qc, kg).astype(jnp.float32) * scale
        t = s0 + jnp.arange(SEL_Q_CHUNK)
        pos = ic[..., None] * SEL_BLOCK + jnp.arange(SEL_BLOCK)
        mask = (pos <= t[None, None, :, None, None])[:, :, None]
        s = jnp.where(mask, s, -jnp.inf)
        n = ic.shape[-1]
        p = jax.nn.softmax(s.reshape(B, Hkv, G, SEL_Q_CHUNK, n * SEL_BLOCK), axis=-1).reshape(s.shape)
        return jnp.einsum('bhgqnl,bhqnld->bqhgd', p.astype(v.dtype), vg)

    out = lax.map(chunk, jnp.arange(S // SEL_Q_CHUNK))
    return jnp.moveaxis(out, 0, 1).reshape(B, S, Hkv, G, dh)


def nsa_mixer(h, w_in, w_out, cmp_pe, phi_w1, phi_b1, phi_w2, phi_b2, cos, sin):
    B, S, _ = h.shape
    qd = NSA_Q_HEADS * HEAD_DIM
    kd = NSA_KV_HEADS * HEAD_DIM
    proj = h @ w_in
    splits = [qd + i * kd for i in range(7)]
    q, kc, vc, ks, vs, kw, vw, g = jnp.split(proj, splits, axis=-1)
    q = apply_rope(q.reshape(B, S, NSA_Q_HEADS, HEAD_DIM), cos, sin)
    q = q.reshape(B, S, NSA_KV_HEADS, NSA_GROUP, HEAD_DIM)
    kv_shape = (B, S, NSA_KV_HEADS, HEAD_DIM)
    kc = apply_rope(kc.reshape(kv_shape), cos, sin)
    ks = apply_rope(ks.reshape(kv_shape), cos, sin)
    kw = apply_rope(kw.reshape(kv_shape), cos, sin)
    vc, vs, vw = vc.reshape(kv_shape), vs.reshape(kv_shape), vw.reshape(kv_shape)
    kcc = compress_tokens(kc, cmp_pe[0], phi_w1[0], phi_b1[0], phi_w2[0], phi_b2[0])
    vcc = compress_tokens(vc, cmp_pe[1], phi_w1[1], phi_b1[1], phi_w2[1], phi_b2[1])
    o_cmp, p_cmp = compressed_attention(q, kcc, vcc)
    sel_idx = select_blocks(p_cmp, S)
    o_sel = selected_block_attention(q, ks, vs, sel_idx)
    o_win = banded_attention(q, kw, vw, NSA_WINDOW, None)
    g = jax.nn.sigmoid(g.astype(jnp.float32)).astype(h.dtype)
    g = g.reshape(B, S, NSA_KV_HEADS, NSA_GROUP, 3)
    o = g[..., 0:1] * o_cmp + g[..., 1:2] * o_sel + g[..., 2:3] * o_win
    return o.reshape(B, S, qd) @ w_out


def swa_sink_mixer(h, w_in, w_out, sinks, cos, sin):
    B, S, _ = h.shape
    qd = SWA_Q_HEADS * HEAD_DIM
    kd = SWA_KV_HEADS * HEAD_DIM
    q, k, v = jnp.split(h @ w_in, [qd, qd + kd], axis=-1)
    q = apply_rope(q.reshape(B, S, SWA_Q_HEADS, HEAD_DIM), cos, sin)
    q = q.reshape(B, S, SWA_KV_HEADS, SWA_GROUP, HEAD_DIM)
    k = apply_rope(k.reshape(B, S, SWA_KV_HEADS, HEAD_DIM), cos, sin)
    v = v.reshape(B, S, SWA_KV_HEADS, HEAD_DIM)
    o = banded_attention(q, k, v, SWA_WINDOW, sinks.reshape(SWA_KV_HEADS, SWA_GROUP))
    return o.reshape(B, S, qd) @ w_out


def squared_relu_mlp(h, w_up, w_down):
    a = jax.nn.relu(h @ w_up)
    return (a * a) @ w_down


def setup_inputs(seed: int = 0) -> dict:
    key = jax.random.key(seed)
    ks = jax.random.split(key, 20)
    n_a = (DEPTH + N_MIXERS - 1) // N_MIXERS
    n_b = DEPTH // N_MIXERS
    nrm = jax.random.normal
    f32 = jnp.float32
    x = nrm(ks[0], (BATCH, SEQ, D_MODEL), f32)
    c = nrm(ks[1], (BATCH, D_MODEL), f32)
    offset = jax.random.randint(ks[2], (BATCH, 1), 0, 4096, dtype=jnp.int32)
    positions = (offset + jnp.arange(SEQ, dtype=jnp.int32)[None, :]).astype(jnp.int32)
    ada_w = nrm(ks[3], (DEPTH, D_MODEL, 6 * D_MODEL), f32) * (0.5 * D_MODEL ** -0.5)
    ada_b = nrm(ks[4], (DEPTH, 6 * D_MODEL), f32) * 0.01
    norm_g = 1.0 + 0.02 * nrm(ks[5], (DEPTH, 4, D_MODEL), f32)
    nsa_w_in = nrm(ks[6], (n_a, D_MODEL, NSA_IN), f32) * D_MODEL ** -0.5
    nsa_w_out = nrm(ks[7], (n_a, NSA_Q_HEADS * HEAD_DIM, D_MODEL), f32) * (NSA_Q_HEADS * HEAD_DIM) ** -0.5
    nsa_cmp_pe = 0.1 * nrm(ks[8], (n_a, 2, CMP_BLOCK, HEAD_DIM), f32)
    nsa_phi_w1 = nrm(ks[9], (n_a, 2, CMP_BLOCK * HEAD_DIM, CMP_HIDDEN), f32) * (CMP_BLOCK * HEAD_DIM) ** -0.5
    nsa_phi_b1 = 0.01 * nrm(ks[10], (n_a, 2, CMP_HIDDEN), f32)
    nsa_phi_w2 = nrm(ks[11], (n_a, 2, CMP_HIDDEN, HEAD_DIM), f32) * CMP_HIDDEN ** -0.5
    nsa_phi_b2 = 0.01 * nrm(ks[12], (n_a, 2, HEAD_DIM), f32)
    swa_w_in = nrm(ks[13], (n_b, D_MODEL, SWA_IN), f32) * D_MODEL ** -0.5
    swa_w_out = nrm(ks[14], (n_b, SWA_Q_HEADS * HEAD_DIM, D_MODEL), f32) * (SWA_Q_HEADS * HEAD_DIM) ** -0.5
    swa_sinks = nrm(ks[15], (n_b, SWA_Q_HEADS), f32)
    mlp_w_up = nrm(ks[16], (DEPTH, D_MODEL, MLP_HIDDEN), f32) * D_MODEL ** -0.5
    mlp_w_down = nrm(ks[17], (DEPTH, MLP_HIDDEN, D_MODEL), f32) * MLP_HIDDEN ** -0.5
    return {"x": x, "c": c, "positions": positions, "ada_w": ada_w, "ada_b": ada_b,
            "norm_g": norm_g, "nsa_w_in": nsa_w_in, "nsa_w_out": nsa_w_out,
            "nsa_cmp_pe": nsa_cmp_pe, "nsa_phi_w1": nsa_phi_w1, "nsa_phi_b1": nsa_phi_b1,
            "nsa_phi_w2": nsa_phi_w2, "nsa_phi_b2": nsa_phi_b2, "swa_w_in": swa_w_in,
            "swa_w_out": swa_w_out, "swa_sinks": swa_sinks, "mlp_w_up": mlp_w_up,
            "mlp_w_down": mlp_w_down}


def reference(x, c, positions, ada_w, ada_b, norm_g, nsa_w_in, nsa_w_out, nsa_cmp_pe,
              nsa_phi_w1, nsa_phi_b1, nsa_phi_w2, nsa_phi_b2, swa_w_in, swa_w_out,
              swa_sinks, mlp_w_up, mlp_w_down):
    cos, sin = rope_tables(positions)
    cond = jax.nn.silu(c)
    for i in range(DEPTH):
        mod = cond @ ada_w[i] + ada_b[i]
        sh1, sc1, g1, sh2, sc2, g2 = jnp.split(mod, 6, axis=-1)
        h = modulate(rms_norm(x, norm_g[i, 0]), sh1, sc1)
        a = i // N_MIXERS
        if i % N_MIXERS == 0:
            y = nsa_mixer(h, nsa_w_in[a], nsa_w_out[a], nsa_cmp_pe[a], nsa_phi_w1[a],
                          nsa_phi_b1[a], nsa_phi_w2[a], nsa_phi_b2[a], cos, sin)
        else:
            y = swa_sink_mixer(h, swa_w_in[a], swa_w_out[a], swa_sinks[a], cos, sin)
        x = x + (1 + g1)[:, None, :] * rms_norm(y, norm_g[i, 1])
        h = modulate(rms_norm(x, norm_g[i, 2]), sh2, sc2)
        y = squared_relu_mlp(h, mlp_w_up[i], mlp_w_down[i])
        x = x + (1 + g2)[:, None, :] * rms_norm(y, norm_g[i, 3])
    return x
```

```cpp
#include <hip/hip_runtime.h>
#include <cstdio>
#include <cstdint>

#ifndef MK_ONE_LAUNCH
#define MK_ONE_LAUNCH 1
#endif

#define LAS __attribute__((address_space(3)))
#define GAS __attribute__((address_space(1)))
typedef _Float16 half_t;
typedef _Float16 h8 __attribute__((ext_vector_type(8)));
typedef _Float16 h4 __attribute__((ext_vector_type(4)));
typedef _Float16 h2 __attribute__((ext_vector_type(2)));
typedef float f32x2 __attribute__((ext_vector_type(2)));
typedef float f32x4 __attribute__((ext_vector_type(4)));
typedef float f32x16 __attribute__((ext_vector_type(16)));
typedef unsigned u32x2 __attribute__((ext_vector_type(2)));
typedef unsigned u32x4 __attribute__((ext_vector_type(4)));
typedef short s16x4 __attribute__((ext_vector_type(4)));

constexpr int D = 1024, NB = 16, S = 2048, M = NB * S, DEPTH = 4, HD = 64, FF = 4096;
constexpr int NSA_IN = 2608, NSA_INP = 2816, SWA_IN = 1280;
constexpr int NCMP = 127;
constexpr float NORM_EPS = 1e-6f;
constexpr float LOG2E = 1.4426950408889634f;
constexpr float C2 = 0.125f * LOG2E;
constexpr float NEG_BIG = -1.0e30f;

constexpr size_t MiB = 1u << 20;
constexpr size_t WS_CTL = 0, CTL_ZERO_BYTES = 1 * MiB;
constexpr size_t WS_MOD  = 1 * MiB;
constexpr size_t WS_B1F  = 3 * MiB;
constexpr size_t WS_W2T  = 3 * MiB + 65536;
constexpr size_t WS_ROPE = 4 * MiB;
constexpr size_t WS_PART = 12 * MiB;
constexpr size_t WS_WINN = 24 * MiB;
constexpr size_t WS_WINS = 36 * MiB;
constexpr size_t WS_WOUT = 41 * MiB;
constexpr size_t WS_W1T  = 49 * MiB;
constexpr size_t WS_WUP  = 53 * MiB;
constexpr size_t WS_WDN  = 85 * MiB;
constexpr size_t WS_Y    = 117 * MiB;
constexpr size_t WS_H    = 181 * MiB;
constexpr size_t WS_OACC = 117 * MiB;
constexpr size_t WS_BIG  = 245 * MiB;
constexpr size_t WS_Q    = 245 * MiB;
constexpr size_t WS_KV   = 309 * MiB;
constexpr size_t WS_O    = 405 * MiB;
constexpr size_t WS_G    = 469 * MiB;
constexpr size_t WS_HIDC = 475 * MiB;
constexpr size_t WS_KCC  = 483 * MiB;
constexpr size_t WS_SELM = 485 * MiB;
constexpr size_t WS_END  = 501 * MiB;
constexpr size_t KVT = (size_t)M * 256;

constexpr int CW_BAR = 4096;

constexpr int RING_BYTES = 131072;
constexpr int LDSCTL_OFF = RING_BYTES, MISC_OFF = LDSCTL_OFF + 320;
constexpr int LDS_BYTES = 147456;

__device__ __forceinline__ unsigned pkh2(float lo, float hi) { h2 p = {(half_t)lo, (half_t)hi}; return __builtin_bit_cast(unsigned, p); }
__device__ __forceinline__ u32x2 pk4(const f32x4 v) { u32x2 w; w.x = pkh2(v[0], v[1]); w.y = pkh2(v[2], v[3]); return w; }
__device__ __forceinline__ float fast_exp2(float x) { return __builtin_amdgcn_exp2f(x); }
__device__ __forceinline__ float fast_rcp(float x) { return __builtin_amdgcn_rcpf(x); }
__device__ __forceinline__ float wave_sum(float v) {
#pragma unroll
    for (int o = 1; o < 64; o <<= 1) v += __shfl_xor(v, o);
    return v;
}

namespace pg8 {
#define PG8_LAS __attribute__((address_space(3)))
typedef _Float16 bf16_t;
typedef _Float16 bf16x8 __attribute__((ext_vector_type(8)));
typedef float f32x4 __attribute__((ext_vector_type(4)));
typedef unsigned u32x4 __attribute__((ext_vector_type(4)));
constexpr int BM = 256, BK = 64, HALF = 128, HTB = HALF * BK * 2  , STAGE_BYTES = 8 * HTB, NXCD = 8, WGM = 8;

__host__ __device__ __forceinline__ int lds_byte(int r, int c) { const int st = (r >> 4) * 2 + (c >> 5), rr = r & 15, cc = c & 31, ob = rr * 64 + cc * 2; return st * 1024 + (ob ^ (((ob >> 9) & 1) << 5)); }
__host__ __device__ __forceinline__ void stage_rc(int b, int& R, int& C) { const int st = b / 1024, sb = b % 1024, swz = sb ^ (((sb >> 9) & 1) << 5); R = (st >> 1) * 16 + swz / 64; C = (st & 1) * 32 + (swz % 64) / 2; }
__host__ __device__ __forceinline__ int perm32(int rho) { const int n = rho >> 4, i = rho & 15; return 8 * (i >> 2) + 4 * n + (i & 3); }

struct Unit { int pm, pn; };
struct Gemm { const bf16_t* A; const bf16_t* Bt; int M, N, K, lda; };

struct StaticOrder {
    int nM, nN, nwg, G, c;
    __host__ __device__ void init(int M, int N, int G_, int c_) { nM = M / BM; nN = N / BM; nwg = nM * nN; G = G_; c = c_; }
    __host__ __device__ bool next(int i, Unit& u) const {
        const long L = (long)i * G + c; if (L >= nwg) return false;
        int wgid = (int)L; { const int q = nwg / NXCD, r = nwg % NXCD, xcd = wgid % NXCD, off = wgid / NXCD; wgid = (xcd < r ? xcd * (q + 1) : r * (q + 1) + (xcd - r) * q) + off; }
        const int nig = WGM * nN, gid = wgid / nig, fm = gid * WGM, gsz = (nM - fm) < WGM ? (nM - fm) : WGM;
        u.pm = fm + ((wgid % nig) % gsz); u.pn = (wgid % nig) / gsz; return true;
    }
    __device__ __forceinline__ void a_ready(const Unit&) const {}
    __device__ __forceinline__ void done(const Unit&) const {}
};


struct CmpOrder {
    int G, c;
    __device__ bool next(int i, Unit& u) const { const int L = i * G + c; if (L >= 64) return false; u.pm = L; u.pn = L >> 5; return true; }
    __device__ __forceinline__ void a_ready(const Unit&) const {}
    __device__ __forceinline__ void done(const Unit&) const {}
};

__device__ __forceinline__ u32x4 pack8h(const f32x4 v0, const f32x4 v1) { u32x4 w; w.x = pkh2(v0[0], v0[1]); w.y = pkh2(v0[2], v0[3]); w.z = pkh2(v1[0], v1[1]); w.w = pkh2(v1[2], v1[3]); return w; }
__device__ __forceinline__ float gelu_tanh(float v) {
    const float u2 = 1.5957691216057308f * (v + 0.044715f * v * v * v);
    return v * fast_rcp(1.0f + fast_exp2(-u2 * LOG2E));
}
template <int ACT> struct EpiF16 {
    static constexpr bool PERM = true, AFTER_DRAIN = false;
    half_t* O; int ldc; const float* bias;
    __device__ __forceinline__ void operator()(const f32x4 (&acc)[2][2][4][2], const Unit& u, int wr, int wc, int fr, int fq) const {
        const int row0 = u.pm * BM + wr * 64 + fr;
        const int col0 = (ACT == 2 ? 0 : u.pn * BM) + wc * 32 + 8 * fq, bcol0 = u.pn * BM + wc * 32 + 8 * fq;
        f32x4 bv[2][2];
#pragma unroll
        for (int bj = 0; bj < 2; ++bj)
#pragma unroll
            for (int n = 0; n < 2; ++n) bv[bj][n] = (ACT == 2) ? *(const f32x4*)(bias + bcol0 + bj * HALF + 4 * n) : (f32x4){0.f, 0.f, 0.f, 0.f};
#pragma unroll
        for (int ai = 0; ai < 2; ++ai)
#pragma unroll
            for (int m = 0; m < 4; ++m) { half_t* rowp = O + (size_t)(row0 + ai * HALF + m * 16) * ldc + col0;
#pragma unroll
                for (int bj = 0; bj < 2; ++bj) { f32x4 v0 = acc[ai][bj][m][0], v1 = acc[ai][bj][m][1];
                    if (ACT == 1) {
#pragma unroll
                        for (int e = 0; e < 4; ++e) { const float a = fmaxf(v0[e], 0.f), b = fmaxf(v1[e], 0.f); v0[e] = a * a; v1[e] = b * b; } }
                    if (ACT == 2) { v0 = v0 + bv[bj][0]; v1 = v1 + bv[bj][1];
#pragma unroll
                        for (int e = 0; e < 4; ++e) { v0[e] = gelu_tanh(v0[e]); v1[e] = gelu_tanh(v1[e]); } }
                    *(u32x4*)(rowp + bj * HALF) = pack8h(v0, v1); } }
    }
};

__device__ __forceinline__ void rope8(const f32x4 v0, const f32x4 v1, const float* ropetok, int i0, float sc, f32x4& o1, f32x4& o2) {
    const f32x4 c = *(const f32x4*)(ropetok + i0), s = *(const f32x4*)(ropetok + 32 + i0);
    const f32x4 x1 = {v0[0], v0[2], v1[0], v1[2]}, x2 = {v0[1], v0[3], v1[1], v1[3]};
    o1 = (x1 * c - x2 * s) * sc; o2 = (x2 * c + x1 * s) * sc;
}
__device__ __forceinline__ u32x2 pack4h(const f32x4 v) { u32x2 w; w.x = pkh2(v[0], v[1]); w.y = pkh2(v[2], v[3]); return w; }

struct EpiNsaIn {
    static constexpr bool PERM = true, AFTER_DRAIN = false;
    half_t* Q; half_t* KV; float* G; const float* rope;
    __device__ __forceinline__ void operator()(const f32x4 (&acc)[2][2][4][2], const Unit& u, int wr, int wc, int fr, int fq) const {
        const int pn = u.pn;
#pragma unroll
        for (int ai = 0; ai < 2; ++ai)
#pragma unroll
            for (int m = 0; m < 4; ++m) {
                const int tok = u.pm * BM + ai * HALF + wr * 64 + m * 16 + fr, b = tok >> 11, s = tok & 2047;
                const float* rt = rope + (size_t)tok * 64;
#pragma unroll
                for (int bj = 0; bj < 2; ++bj) {
                    const int cit = bj * HALF + wc * 32 + 8 * fq, hh = cit >> 6, jj0 = cit & 63;
                    const f32x4 v0 = acc[ai][bj][m][0], v1 = acc[ai][bj][m][1];
                    if (pn < 4) { f32x4 o1, o2; rope8(v0, v1, rt, jj0 >> 1, C2, o1, o2);
                        half_t* p = Q + (size_t)tok * D + pn * 256 + hh * 64 + (jj0 >> 1);
                        *(u32x2*)p = pack4h(o1); *(u32x2*)(p + 32) = pack4h(o2);
                    } else if (pn == 10) {
                        if (cit < 48) { f32x4 g0, g1;
#pragma unroll
                            for (int e = 0; e < 4; ++e) { g0[e] = fast_rcp(1.0f + fast_exp2(-v0[e] * LOG2E)); g1[e] = fast_rcp(1.0f + fast_exp2(-v1[e] * LOG2E)); }
                            float* p = G + (size_t)tok * 48 + cit; *(f32x4*)p = g0; *(f32x4*)(p + 4) = g1; }
                    } else {
                        const int t = pn - 4;
                        half_t* base = KV + (size_t)t * KVT + ((size_t)(b * 4 + hh) * S + s) * 64;
                        if ((t & 1) == 0) { f32x4 o1, o2; rope8(v0, v1, rt, jj0 >> 1, 1.0f, o1, o2);
                            *(u32x2*)(base + (jj0 >> 1)) = pack4h(o1); *(u32x2*)(base + 32 + (jj0 >> 1)) = pack4h(o2);
                        } else *(u32x4*)(base + jj0) = pack8h(v0, v1);
                    }
                }
            }
    }
};
struct EpiSwaIn {
    static constexpr bool PERM = true, AFTER_DRAIN = false;
    half_t* Q; half_t* KV; const float* rope;
    __device__ __forceinline__ void operator()(const f32x4 (&acc)[2][2][4][2], const Unit& u, int wr, int wc, int fr, int fq) const {
        const int pn = u.pn;
#pragma unroll
        for (int ai = 0; ai < 2; ++ai)
#pragma unroll
            for (int m = 0; m < 4; ++m) {
                const int tok = u.pm * BM + ai * HALF + wr * 64 + m * 16 + fr, b = tok >> 11, s = tok & 2047;
                const float* rt = rope + (size_t)tok * 64;
#pragma unroll
                for (int bj = 0; bj < 2; ++bj) {
                    const int cit = bj * HALF + wc * 32 + 8 * fq, hh = cit >> 6, jj0 = cit & 63;
                    const f32x4 v0 = acc[ai][bj][m][0], v1 = acc[ai][bj][m][1];
                    if (pn < 4) { f32x4 o1, o2; rope8(v0, v1, rt, jj0 >> 1, C2, o1, o2);
                        half_t* p = Q + (size_t)tok * D + pn * 256 + hh * 64 + (jj0 >> 1);
                        *(u32x2*)p = pack4h(o1); *(u32x2*)(p + 32) = pack4h(o2);
                    } else if (bj == 0) {
                        half_t* base = KV + ((size_t)(b * 2 + hh) * S + s) * 64;
                        f32x4 o1, o2; rope8(v0, v1, rt, jj0 >> 1, 1.0f, o1, o2);
                        *(u32x2*)(base + (jj0 >> 1)) = pack4h(o1); *(u32x2*)(base + 32 + (jj0 >> 1)) = pack4h(o2);
                    } else {
                        half_t* base = KV + (size_t)M * 128 + ((size_t)(b * 2 + (hh - 2)) * S + s) * 64;
                        *(u32x4*)(base + jj0) = pack8h(v0, v1);
                    }
                }
            }
    }
};
template <class Epi, class Sched, bool ALIGN_EPI = false, bool SP2 = false>
__device__ __forceinline__ void gemm_phase(PG8_LAS unsigned char* lds, const Gemm g, const Sched& S, const Epi& E) {
    int tid_ = threadIdx.x; asm volatile("" : "+v"(tid_));
    const int tid = tid_, wid = __builtin_amdgcn_readfirstlane(tid >> 6), lane = tid & 63, wr = wid >> 2, wc = wid & 3, fr = lane & 15, fq = lane >> 4;
    const int K = g.K, nt = K / BK;
    unsigned voffA[2], voffB[2];
#pragma unroll
    for (int i = 0; i < 2; ++i) { int R, C; stage_rc(tid * 16 + i * 8192, R, C); const int Rb = Epi::PERM ? ((R & ~31) + perm32(R & 31)) : R;
        voffA[i] = (unsigned)(R * g.lda + C) * 2u; voffB[i] = (unsigned)(Rb * K + C) * 2u; }
    const size_t kstep = (size_t)(BK * 2);
    const size_t hstep = (size_t)HALF * K * 2;
    const size_t tstep = 2 * hstep;
    const size_t hstepA = (size_t)HALF * g.lda * 2, tstepA = 2 * hstepA;
    const unsigned ldsw = (unsigned)wid * 1024u;
    const int aoff = lds_byte(wr * 64 + fr, fq * 8), boff = lds_byte(wc * 32 + fr, fq * 8);
#define PG8_SA(b, h) (((b) * 2 + (h)) * HTB)
#define PG8_SB(b, h) ((4 + (b) * 2 + (h)) * HTB)
#define PG8_STAGE(bufoff, gbase, voff) do { _Pragma("unroll") for (int _i = 0; _i < 2; ++_i) \
        __builtin_amdgcn_global_load_lds((const unsigned*)((const char*)(gbase) + (voff)[_i]), (PG8_LAS unsigned*)(lds + (bufoff) + ldsw + _i * 8192), 16, 0, 0); } while (0)
#define PG8_LDA(dst, b, h) do { _Pragma("unroll") for (int m = 0; m < 4; ++m) _Pragma("unroll") for (int k = 0; k < 2; ++k) dst[m][k] = *(const PG8_LAS bf16x8*)(lds + PG8_SA(b, h) + aoff + m * 2048 + k * 1024); } while (0)
#define PG8_LDB(dst, b, h) do { _Pragma("unroll") for (int n = 0; n < 2; ++n) _Pragma("unroll") for (int k = 0; k < 2; ++k) dst[n][k] = *(const PG8_LAS bf16x8*)(lds + PG8_SB(b, h) + boff + n * 2048 + k * 1024); } while (0)
#define PG8_MMA(ai, bj, At, Bt) do { __builtin_amdgcn_s_setprio(1); _Pragma("unroll") for (int m = 0; m < 4; ++m) _Pragma("unroll") for (int n = 0; n < 2; ++n) _Pragma("unroll") for (int k = 0; k < 2; ++k) \
        acc[ai][bj][m][n] = __builtin_amdgcn_mfma_f32_16x16x32_f16(Bt[n][k], At[m][k], acc[ai][bj][m][n], 0, 0, 0); __builtin_amdgcn_s_setprio(0); } while (0)
#define PG8_WAIT_V(n) asm volatile("s_waitcnt vmcnt(" #n ")" ::: "memory")
#define PG8_WAIT_L(n) asm volatile("s_waitcnt lgkmcnt(" #n ")" ::: "memory")
#define PG8_BAR __builtin_amdgcn_s_barrier()
#define PG8_SCHED __builtin_amdgcn_sched_barrier(0)
    Unit cur, nxt; int ui = 0;
    if (!S.next(0, cur)) return;
    f32x4 acc[2][2][4][2];
#pragma unroll
    for (int a = 0; a < 2; ++a)
#pragma unroll
        for (int b = 0; b < 2; ++b)
#pragma unroll
            for (int m = 0; m < 4; ++m)
#pragma unroll
                for (int n = 0; n < 2; ++n) acc[a][b][m][n] = (f32x4){0.f, 0.f, 0.f, 0.f};
    bf16x8 At[4][2], B0[2][2], B1[2][2];
    const char* cA = (const char*)g.A + (size_t)cur.pm * tstepA; const char* cB = (const char*)g.Bt + (size_t)cur.pn * tstep;
    S.a_ready(cur);
    static_assert(SP2, "only the SP2 loop is kept in this file");
    {
        PG8_STAGE(PG8_SB(0, 0), cB, voffB); PG8_STAGE(PG8_SB(0, 1), cB + hstep, voffB); PG8_STAGE(PG8_SA(0, 0), cA, voffA); PG8_STAGE(PG8_SA(0, 1), cA + hstepA, voffA);
        if (wr == 1) PG8_BAR;
        PG8_WAIT_V(2); PG8_BAR;
        PG8_STAGE(PG8_SB(1, 0), cB + kstep, voffB); PG8_STAGE(PG8_SA(1, 0), cA + kstep, voffA); PG8_STAGE(PG8_SB(1, 1), cB + hstep + kstep, voffB);
        PG8_WAIT_V(6); PG8_BAR;
    }
    for (;;) {
        const bool has_next = S.next(ui + 1, nxt);
        const char* nA = has_next ? (const char*)g.A + (size_t)nxt.pm * tstepA : cA; const char* nB = has_next ? (const char*)g.Bt + (size_t)nxt.pn * tstep : cB;
        for (int t = 0; t < nt; t += 2) {
            const bool last = (t == nt - 2);
            const char* a1 = cA + (size_t)(t + 1) * kstep;
            const char* a2 = last ? nA : cA + (size_t)(t + 2) * kstep; const char* b2 = last ? nB : cB + (size_t)(t + 2) * kstep;
            const char* a3 = a2 + kstep; const char* b3 = b2 + kstep;
            if (last && has_next) S.a_ready(nxt);
            {
            PG8_LDB(B0, 0, 0); PG8_LDB(B1, 0, 1); PG8_SCHED; PG8_LDA(At, 0, 0); PG8_STAGE(PG8_SA(1, 1), a1 + hstepA, voffA);
            PG8_WAIT_V(8); PG8_WAIT_L(0); PG8_BAR; PG8_MMA(0, 0, At, B0); PG8_MMA(0, 1, At, B1); PG8_BAR; PG8_SCHED;
            PG8_LDA(At, 0, 1); PG8_STAGE(PG8_SB(0, 0), b2, voffB); PG8_STAGE(PG8_SB(0, 1), b2 + hstep, voffB); PG8_STAGE(PG8_SA(0, 0), a2, voffA);
            PG8_WAIT_V(8); PG8_WAIT_L(0); PG8_BAR; PG8_MMA(1, 0, At, B0); PG8_MMA(1, 1, At, B1); PG8_BAR; PG8_SCHED;
            PG8_LDB(B0, 1, 0); PG8_LDB(B1, 1, 1); PG8_SCHED; PG8_LDA(At, 1, 0); PG8_STAGE(PG8_SA(0, 1), a2 + hstepA, voffA);
            PG8_WAIT_V(8); PG8_WAIT_L(0); PG8_BAR; PG8_MMA(0, 0, At, B0); PG8_MMA(0, 1, At, B1); PG8_BAR; PG8_SCHED;
            PG8_LDA(At, 1, 1); PG8_STAGE(PG8_SB(1, 0), b3, voffB); PG8_STAGE(PG8_SB(1, 1), b3 + hstep, voffB); PG8_STAGE(PG8_SA(1, 0), a3, voffA);
            PG8_WAIT_V(8); PG8_WAIT_L(0); PG8_BAR; PG8_MMA(1, 0, At, B0); PG8_MMA(1, 1, At, B1); PG8_BAR; PG8_SCHED;
            }
        }
        if constexpr (ALIGN_EPI) { if (wr == 0) PG8_BAR; }
        if constexpr (!Epi::AFTER_DRAIN) { E(acc, cur, wr, wc, fr, fq); S.done(cur); }
        if (!has_next) break;
#pragma unroll
        for (int a = 0; a < 2; ++a)
#pragma unroll
            for (int b = 0; b < 2; ++b)
#pragma unroll
                for (int m = 0; m < 4; ++m)
#pragma unroll
                    for (int n = 0; n < 2; ++n) acc[a][b][m][n] = (f32x4){0.f, 0.f, 0.f, 0.f};
        cur = nxt; cA = nA; cB = nB; ++ui;
        if constexpr (ALIGN_EPI) { if (wr == 1) PG8_BAR; }
    }
    PG8_WAIT_V(0);
    if constexpr (!ALIGN_EPI) { if (wr == 0) PG8_BAR; }
    PG8_BAR;
    if constexpr (Epi::AFTER_DRAIN) { E.fused(acc, cur, wr, wc, fr, fq, lds, wid, lane); S.done(cur); }
#undef PG8_SA
#undef PG8_SB
#undef PG8_STAGE
#undef PG8_LDA
#undef PG8_LDB
#undef PG8_MMA
#undef PG8_WAIT_V
#undef PG8_WAIT_L
#undef PG8_BAR
#undef PG8_SCHED
}
}

#define XB_TMO      128
#define XB_XCNT(j)  (256  + 64 * (j))
#define XB_XSUB(j)  (1280 + 64 * (j))
#define XB_XGEN(j)  (2304 + 64 * (j))
#define XB_TOP      3328
#define XB_TOPGEN   3392
#define XCD_BAR_WORDS 3456
#define XB_SPIN_CAP (1u << 18)

__device__ __forceinline__ unsigned xb_ld(unsigned* p)              { return __hip_atomic_load(p, __ATOMIC_RELAXED, __HIP_MEMORY_SCOPE_AGENT); }
__device__ __forceinline__ unsigned xb_add(unsigned* p, unsigned v) { return __hip_atomic_fetch_add(p, v, __ATOMIC_RELAXED, __HIP_MEMORY_SCOPE_AGENT); }
__device__ __forceinline__ unsigned xb_xcc_id() { return (unsigned)__builtin_amdgcn_s_getreg((3 << 11) | 20) & 0xFu; }
#define XB_SPIN(cond, bar) do { unsigned _sp = 0; while (cond) { __builtin_amdgcn_s_sleep(1); \
    if ((++_sp & 255u) == 0u) { if (xb_ld(&(bar)[XB_TMO])) break; if (_sp > XB_SPIN_CAP) { atomicAdd(&(bar)[XB_TMO], 1u); break; } } } } while (0)

struct XcdBarrier {
    unsigned* bar; unsigned x;
    volatile LAS unsigned* st;
};

__device__ __forceinline__ XcdBarrier xcd_barrier_post(unsigned* bar, volatile LAS unsigned* st) {
    XcdBarrier b; b.bar = bar; b.x = xb_xcc_id(); b.st = st;
    if (threadIdx.x == 0) (void)xb_add(&bar[XB_XCNT(b.x)], 1u);
    return b;
}
__device__ __forceinline__ void xcd_barrier_complete(unsigned* bar, unsigned x, unsigned& nloc, unsigned& nx) {
    const unsigned G = gridDim.x * gridDim.y * gridDim.z;
    unsigned sum, cnt, mine, sp = 0u;
    for (;;) {
        sum = 0u; cnt = 0u; mine = 0u;
#pragma unroll
        for (unsigned j = 0; j < 16; ++j) { const unsigned c = xb_ld(&bar[XB_XCNT(j)]); sum += c; cnt += (c > 0u) ? 1u : 0u; mine = (j == x) ? c : mine; }
        if (sum == G) break;
        __builtin_amdgcn_s_sleep(1);
        if ((++sp & 255u) == 0u) { if (xb_ld(&bar[XB_TMO])) break; if (sp > XB_SPIN_CAP) { atomicAdd(&bar[XB_TMO], 1u); break; } }
    }
    nloc = mine > 0u ? mine : 1u; nx = cnt > 0u ? cnt : 1u;
}

__device__ __forceinline__ void xcd_barrier(const XcdBarrier& b) {
    asm volatile("s_waitcnt vmcnt(0)" ::: "memory");
    __syncthreads();
    if (threadIdx.x == 0) {
        unsigned* bar = b.bar;
        __builtin_amdgcn_s_waitcnt(0);
        unsigned nloc = b.st[0], nx = b.st[1];
        if (nloc == 0u) { xcd_barrier_complete(bar, b.x, nloc, nx); b.st[0] = nloc; b.st[1] = nx; }
        const unsigned old = xb_add(&bar[XB_XSUB(b.x)], 1u);
        const unsigned gen = old / nloc;
        if (old + 1u == (gen + 1u) * nloc) {
            __builtin_amdgcn_fence(__ATOMIC_RELEASE, "agent");
            asm volatile("s_waitcnt vmcnt(0)" ::: "memory");
            const unsigned og = xb_add(&bar[XB_TOP], 1u);
            const unsigned tg = og / nx;
            if (og + 1u == (tg + 1u) * nx) xb_add(&bar[XB_TOPGEN], 1u);
            else XB_SPIN(xb_ld(&bar[XB_TOPGEN]) == tg, bar);
            __builtin_amdgcn_fence(__ATOMIC_ACQUIRE, "agent");
            xb_add(&bar[XB_XGEN(b.x)], 1u);
            asm volatile("s_waitcnt vmcnt(0)" ::: "memory");
        } else {
            XB_SPIN(xb_ld(&bar[XB_XGEN(b.x)]) == gen, bar);
            __builtin_amdgcn_fence(__ATOMIC_ACQUIRE, "agent");
            asm volatile("s_waitcnt vmcnt(0)" ::: "memory");
        }
    }
    __syncthreads();
}

struct Args { const void* in[18]; float* out; unsigned char* ws; int ph_lo, ph_hi; };
struct Ctx {
    LAS unsigned char* lds;
    int tid, lane, wave, G, gw, ngw;
    unsigned char* ws;
};
#define LDS_WAIT() asm volatile("s_waitcnt lgkmcnt(0)" ::: "memory")

__device__ const float INVF[32] = {1.000000000e+00f, 7.498942018e-01f, 5.623413324e-01f, 4.216965139e-01f, 3.162277639e-01f, 2.371373922e-01f, 1.778279394e-01f, 1.333521456e-01f,
    1.000000015e-01f, 7.498941571e-02f, 5.623412877e-02f, 4.216964915e-02f, 3.162277862e-02f, 2.371373586e-02f, 1.778279431e-02f, 1.333521493e-02f,
    9.999999776e-03f, 7.498942316e-03f, 5.623413250e-03f, 4.216964822e-03f, 3.162277862e-03f, 2.371373819e-03f, 1.778279431e-03f, 1.333521446e-03f,
    1.000000047e-03f, 7.498941850e-04f, 5.623413017e-04f, 4.216965463e-04f, 3.162277862e-04f, 2.371373848e-04f, 1.778279402e-04f, 1.333521504e-04f};

__device__ __forceinline__ void sincos_d(double x, double& sn, double& cs) {
    const double k = __builtin_rint(x * 0.63661977236758134308);
    double r = __builtin_fma(-k, 1.57079632679489655800e+00, x); r = __builtin_fma(-k, 6.12323399573676603587e-17, r);
    const double z = r * r;
    double sp = 1.0 / 6227020800.0; sp = sp * z - 1.0 / 39916800.0; sp = sp * z + 1.0 / 362880.0; sp = sp * z - 1.0 / 5040.0; sp = sp * z + 1.0 / 120.0; sp = sp * z - 1.0 / 6.0; sp = sp * z + 1.0;
    const double s0 = sp * r;
    double cp = -1.0 / 87178291200.0; cp = cp * z + 1.0 / 479001600.0; cp = cp * z - 1.0 / 3628800.0; cp = cp * z + 1.0 / 40320.0; cp = cp * z - 1.0 / 720.0; cp = cp * z + 1.0 / 24.0; cp = cp * z - 0.5; cp = cp * z + 1.0;
    const int q = ((int)k) & 3;
    sn = (q == 0) ? s0 : (q == 1) ? cp : (q == 2) ? -s0 : -cp;
    cs = (q == 0) ? cp : (q == 1) ? -s0 : (q == 2) ? -cp : s0;
}

__device__ __forceinline__ int w_rowmap(int mode, int n) {
    if (mode == 0) return n;
    bool rope;
    if (mode == 1) { const int t = n >> 8; rope = (t < 4) || t == 4 || t == 6 || t == 8; }
    else rope = n < 1152;
    if (!rope) return n;
    const int d = n & 63; return (n & ~63) + 2 * (d & 31) + (d >> 5);
}
__device__ __forceinline__ void convert_item(const float* W, int K, int N, half_t* WT, int mode, LAS float* scr, int item, int lane) {
    const int nblk = (N + 31) / 32, kb = item / nblk, nb = item % nblk, k0 = 64 * kb, n0 = 32 * nb;
    const int nn = n0 + (lane & 31);
#pragma unroll 8
    for (int i = 0; i < 32; ++i) { const int kk = 2 * i + (lane >> 5); scr[kk * 33 + (lane & 31)] = (nn < N) ? W[(size_t)(k0 + kk) * N + nn] : 0.f; }
    LDS_WAIT(); asm volatile("" ::: "memory");
    const int c = lane & 7;
#pragma unroll
    for (int j = 0; j < 4; ++j) { const int nl = (lane >> 3) + 8 * j, n = n0 + nl; const LAS float* s = scr + (8 * c) * 33 + nl;
        u32x4 o; o.x = pkh2(s[0 * 33], s[1 * 33]); o.y = pkh2(s[2 * 33], s[3 * 33]); o.z = pkh2(s[4 * 33], s[5 * 33]); o.w = pkh2(s[6 * 33], s[7 * 33]);
        if (n < N) *(u32x4*)(WT + (size_t)w_rowmap(mode, n) * K + k0 + 8 * c) = o; }
    LDS_WAIT(); asm volatile("" ::: "memory");
}
struct WDesc { const float* src; half_t* dst; int K, N, mode; };
__device__ __forceinline__ WDesc wdesc(const Args& a, int mid) {
    WDesc d; unsigned char* ws = a.ws;
    if (mid < 2)       { d.src = (const float*)a.in[6] + (size_t)mid * D * NSA_IN;            d.dst = (half_t*)(ws + WS_WINN) + (size_t)mid * NSA_INP * D;         d.K = D;    d.N = NSA_IN; d.mode = 1; }
    else if (mid < 4)  { d.src = (const float*)a.in[13] + (size_t)(mid - 2) * D * SWA_IN;     d.dst = (half_t*)(ws + WS_WINS) + (size_t)(mid - 2) * SWA_IN * D;    d.K = D;    d.N = SWA_IN; d.mode = 2; }
    else if (mid < 6)  { d.src = (const float*)a.in[7] + (size_t)(mid - 4) * D * D;           d.dst = (half_t*)(ws + WS_WOUT) + (size_t)(2 * (mid - 4)) * D * D;   d.K = D;    d.N = D;      d.mode = 0; }
    else if (mid < 8)  { d.src = (const float*)a.in[14] + (size_t)(mid - 6) * D * D;          d.dst = (half_t*)(ws + WS_WOUT) + (size_t)(2 * (mid - 6) + 1) * D * D; d.K = D;  d.N = D;      d.mode = 0; }
    else if (mid < 12) { d.src = (const float*)a.in[9] + (size_t)(mid - 8) * 2048 * 256;      d.dst = (half_t*)(ws + WS_W1T) + (size_t)(mid - 8) * 256 * 2048;     d.K = 2048; d.N = 256;    d.mode = 0; }
    else if (mid < 16) { d.src = (const float*)a.in[11] + (size_t)(mid - 12) * 256 * 64;      d.dst = (half_t*)(ws + WS_W2T) + (size_t)(mid - 12) * 64 * 256;      d.K = 256;  d.N = 64;     d.mode = 0; }
    else if (mid < 20) { d.src = (const float*)a.in[16] + (size_t)(mid - 16) * D * FF;        d.dst = (half_t*)(ws + WS_WUP) + (size_t)(mid - 16) * FF * D;        d.K = D;    d.N = FF;     d.mode = 0; }
    else               { d.src = (const float*)a.in[17] + (size_t)(mid - 20) * FF * D;        d.dst = (half_t*)(ws + WS_WDN) + (size_t)(mid - 20) * D * FF;        d.K = FF;   d.N = D;      d.mode = 0; }
    return d;
}

__device__ __forceinline__ void phase_prologue(const Args& a, const Ctx& C) {
    unsigned char* ws = C.ws;
    {
        LAS float* scr = (LAS float*)(C.lds + C.wave * 16384);
        for (int mid = 0; mid < 24; ++mid) { const WDesc d = wdesc(a, mid); const int nit = (d.K / 64) * ((d.N + 31) / 32);
            for (int it = C.gw; it < nit; it += C.ngw) convert_item(d.src, d.K, d.N, d.dst, d.mode, scr, it, C.lane); }
    }
    {
        const int gt = C.gw * 64 + C.lane, ngt = C.ngw * 64;
        for (int i = gt; i < 2 * 208 * 128; i += ngt) { const int mat = i / (208 * 128), r = i % (208 * 128);
            *(u32x4*)((half_t*)(ws + WS_WINN) + (size_t)mat * NSA_INP * D + (size_t)NSA_IN * D + (size_t)r * 8) = (u32x4){0u, 0u, 0u, 0u}; }
        const int* pos = (const int*)a.in[2]; float* rope = (float*)(ws + WS_ROPE);
        for (int i = gt; i < M * 32; i += ngt) { const int tok = i >> 5, fi = i & 31;
            const float ang = (float)pos[tok] * INVF[fi]; double sn, cs; sincos_d((double)ang, sn, cs);
            rope[(size_t)tok * 64 + fi] = (float)cs; rope[(size_t)tok * 64 + 32 + fi] = (float)sn; }
    }
    {
        if (C.gw < 16) { const int lw = C.gw >> 2, j = (C.gw & 3) * 64 + C.lane;
            const float* w1 = (const float*)a.in[9] + (size_t)lw * 2048 * 256; const float* pe = (const float*)a.in[8] + (size_t)lw * 2048;
            float s = ((const float*)a.in[10])[lw * 256 + j];
            for (int k = 0; k < 2048; ++k) s += pe[k] * w1[(size_t)k * 256 + j];
            ((float*)(ws + WS_B1F))[lw * 256 + j] = s; }
    }
    __syncthreads();
    {
        LAS float* cl = (LAS float*)C.lds; const float* cin = (const float*)a.in[1];
        for (int i = C.tid; i < 16 * 1024; i += 512) { const int b = i >> 10, k = i & 1023; const float v = cin[i]; cl[k * 16 + b] = v / (1.0f + __expf(-v)); }
        __syncthreads();
        const float* aw = (const float*)a.in[3]; float* part = (float*)(ws + WS_PART);
        for (int task = C.gw; task < 4 * 8 * 96; task += C.ngw) {
            const int ng = task % 96, lk = task / 96, ks = lk & 7, L = lk >> 3, col = ng * 64 + C.lane;
            const float* wp = aw + ((size_t)L * 1024 + ks * 128) * 6144 + col;
            float acc[16];
#pragma unroll
            for (int b = 0; b < 16; ++b) acc[b] = 0.f;
#pragma unroll 4
            for (int kk = 0; kk < 128; ++kk) { const float w = wp[(size_t)kk * 6144]; const LAS f32x4* cv = (const LAS f32x4*)(cl + (ks * 128 + kk) * 16);
#pragma unroll
                for (int q = 0; q < 4; ++q) { const f32x4 c4 = cv[q]; acc[4 * q] += c4[0] * w; acc[4 * q + 1] += c4[1] * w; acc[4 * q + 2] += c4[2] * w; acc[4 * q + 3] += c4[3] * w; } }
#pragma unroll
            for (int b = 0; b < 16; ++b) part[((size_t)(ks * 4 + L) * 16 + b) * 6144 + col] = acc[b];
        }
    }
}
__device__ __forceinline__ void phase_modfinal(const Args& a, const Ctx& C) {
    const float* part = (const float*)(C.ws + WS_PART); const float* ab = (const float*)a.in[4]; float* mod = (float*)(C.ws + WS_MOD);
    for (int i = C.gw * 64 + C.lane; i < 4 * 16 * 6144; i += C.ngw * 64) { const int L = i / 98304, rem = i % 98304, n = rem % 6144;
        float s = ab[L * 6144 + n];
#pragma unroll
        for (int ks = 0; ks < 8; ++ks) s += part[(size_t)(ks * 4 + L) * 98304 + rem];
        mod[i] = s; }
}

__device__ __forceinline__ void row_norm_mod(const f32x4 (&v)[4], float rstd, const float* gain, const float* sh, const float* sc, half_t* hrow, int lane) {
#pragma unroll
    for (int j = 0; j < 4; ++j) { const int c = 4 * lane + 256 * j;
        const f32x4 g = *(const f32x4*)(gain + c), s1 = *(const f32x4*)(sc + c), s0 = *(const f32x4*)(sh + c);
        const f32x4 h = (v[j] * rstd * g) * (s1 + 1.0f) + s0;
        *(u32x2*)(hrow + c) = pk4(h); }
}

__device__ __forceinline__ void phase_row_first(const Args& a, const Ctx& C) {
    const float* x = (const float*)a.in[0]; const float* ng = (const float*)a.in[5]; const float* mod = (const float*)(C.ws + WS_MOD); half_t* H = (half_t*)(C.ws + WS_H);
    for (int row = C.gw; row < M; row += C.ngw) { const int b = row >> 11;
        f32x4 v[4]; float ss = 0.f;
#pragma unroll
        for (int j = 0; j < 4; ++j) { v[j] = *(const f32x4*)(x + (size_t)row * D + 4 * C.lane + 256 * j); ss += (v[j][0] * v[j][0] + v[j][1] * v[j][1]) + (v[j][2] * v[j][2] + v[j][3] * v[j][3]); }
        const float rstd = 1.0f / sqrtf(wave_sum(ss) * (1.0f / D) + NORM_EPS);
        const float* mb = mod + (size_t)b * 6144;
        row_norm_mod(v, rstd, ng, mb, mb + 1024, H + (size_t)row * D, C.lane);
    }
}
__device__ __forceinline__ void phase_row_update(const Args& a, const Ctx& C, int L, int which) {
    const float* ng = (const float*)a.in[5]; const float* mod = (const float*)(C.ws + WS_MOD);
    const half_t* Y = (const half_t*)(C.ws + WS_Y); half_t* H = (half_t*)(C.ws + WS_H);
    const float* xin = (L == 0 && which == 0) ? (const float*)a.in[0] : (const float*)a.out; float* xout = a.out;
    const float* gy = ng + (size_t)(L * 4 + (which ? 3 : 1)) * D;
    const bool doh = !(which == 1 && L == DEPTH - 1);
    const int Lh = which ? L + 1 : L;
    const float* gh = ng + (size_t)(Lh * 4 + (which ? 0 : 2)) * D;
    for (int row = C.gw; row < M; row += C.ngw) { const int b = row >> 11;
        const float* mg = mod + ((size_t)L * 16 + b) * 6144 + (which ? 5 : 2) * 1024;
        f32x4 y[4], xv[4]; float ss = 0.f;
#pragma unroll
        for (int j = 0; j < 4; ++j) { const int c = 4 * C.lane + 256 * j; const h4 yh = *(const h4*)(Y + (size_t)row * D + c); y[j] = (f32x4){(float)yh[0], (float)yh[1], (float)yh[2], (float)yh[3]};
            xv[j] = *(const f32x4*)(xin + (size_t)row * D + c); ss += (y[j][0] * y[j][0] + y[j][1] * y[j][1]) + (y[j][2] * y[j][2] + y[j][3] * y[j][3]); }
        const float r1 = 1.0f / sqrtf(wave_sum(ss) * (1.0f / D) + NORM_EPS);
        float s2 = 0.f;
#pragma unroll
        for (int j = 0; j < 4; ++j) { const int c = 4 * C.lane + 256 * j; const f32x4 g = *(const f32x4*)(gy + c), gt = *(const f32x4*)(mg + c);
            xv[j] = xv[j] + (gt + 1.0f) * (y[j] * r1 * g); *(f32x4*)(xout + (size_t)row * D + c) = xv[j];
            s2 += (xv[j][0] * xv[j][0] + xv[j][1] * xv[j][1]) + (xv[j][2] * xv[j][2] + xv[j][3] * xv[j][3]); }
        if (doh) { const float r2 = 1.0f / sqrtf(wave_sum(s2) * (1.0f / D) + NORM_EPS);
            const float* mh = mod + ((size_t)Lh * 16 + b) * 6144 + (which ? 0 : 3) * 1024;
            row_norm_mod(xv, r2, gh, mh, mh + 1024, H + (size_t)row * D, C.lane); }
    }
}

__device__ __forceinline__ void phase_cmp2(const Args& a, const Ctx& C, int la) {
    const half_t* HC = (const half_t*)(C.ws + WS_HIDC); half_t* KCC = (half_t*)(C.ws + WS_KCC);
    const int r32 = C.lane & 31, hi = C.lane >> 5;
    for (int task = C.gw; task < 512; task += C.ngw) {
        const int R0 = task * 32, which = R0 >> 13;
        const half_t* W2 = (const half_t*)(C.ws + WS_W2T) + (size_t)(la * 2 + which) * 64 * 256;
        const float* b2 = (const float*)a.in[12] + (la * 2 + which) * 64;
        f32x16 acc[2]; acc[0] = (f32x16){}; acc[1] = (f32x16){};
        const half_t* ap = HC + (size_t)(R0 + r32) * 256 + hi * 8;
#pragma unroll 4
        for (int ks = 0; ks < 16; ++ks) {
            const h8 af = *(const h8*)(ap + ks * 16);
            const h8 w0 = *(const h8*)(W2 + (size_t)r32 * 256 + ks * 16 + hi * 8), w1 = *(const h8*)(W2 + (size_t)(32 + r32) * 256 + ks * 16 + hi * 8);
            acc[0] = __builtin_amdgcn_mfma_f32_32x32x16_f16(w0, af, acc[0], 0, 0, 0);
            acc[1] = __builtin_amdgcn_mfma_f32_32x32x16_f16(w1, af, acc[1], 0, 0, 0);
        }
        const int row = R0 + r32; const bool dead = (row & 127) == 127;
#pragma unroll
        for (int ct = 0; ct < 2; ++ct)
#pragma unroll
            for (int rg = 0; rg < 4; ++rg) { const int oc = 32 * ct + 8 * rg + 4 * hi; const f32x4 bb = *(const f32x4*)(b2 + oc);
                f32x4 v = {acc[ct][4 * rg] + bb[0], acc[ct][4 * rg + 1] + bb[1], acc[ct][4 * rg + 2] + bb[2], acc[ct][4 * rg + 3] + bb[3]};
                if (dead) v = (f32x4){0.f, 0.f, 0.f, 0.f};
                *(u32x2*)(KCC + (size_t)row * 64 + oc) = pk4(v); }
    }
}

constexpr int AL_K = 0, AL_V = 16384, AL_PSUM = 32768, AL_W = 65536;
__device__ __forceinline__ int crow(int r, int hi) { return (r & 3) + 8 * (r >> 2) + 4 * hi; }
__device__ __forceinline__ void kv_load(const half_t* Kt, const half_t* Vt, int wave, int lane, u32x4& kr, u32x4& vr) {
    kr = *(const u32x4*)(Kt + (size_t)lane * 64 + wave * 8);
    vr = *(const u32x4*)(Vt + (size_t)(16 * (wave & 3) + (lane >> 2)) * 64 + (wave >> 2) * 32 + (lane & 3) * 8);
}
__device__ __forceinline__ void kv_store(LAS unsigned char* Kb, LAS unsigned char* Vb, int wave, int lane, const u32x4 kr, const u32x4 vr) {
    *(LAS u32x4*)(Kb + wave * 1024 + lane * 16) = kr;
    *(LAS u32x4*)(Vb + (wave >> 2) * 4096 + (16 * (wave & 3) + (lane >> 2)) * 64 + (lane & 3) * 16) = vr;
}
__device__ __forceinline__ void qk_tile(f32x16& p0, f32x16& p1, const LAS unsigned char* Kb, const h8 (&qf)[4], int r32, int hi) {
    p0 = (f32x16){}; p1 = (f32x16){};
#pragma unroll
    for (int d0 = 0; d0 < 4; ++d0) {
        const h8 k0 = *(const LAS h8*)(Kb + (2 * d0 + hi) * 1024 + r32 * 16), k1 = *(const LAS h8*)(Kb + (2 * d0 + hi) * 1024 + (32 + r32) * 16);
        p0 = __builtin_amdgcn_mfma_f32_32x32x16_f16(k0, qf[d0], p0, 0, 0, 0);
        p1 = __builtin_amdgcn_mfma_f32_32x32x16_f16(k1, qf[d0], p1, 0, 0, 0);
    }
}
__device__ __forceinline__ s16x4 tr_read(const LAS unsigned char* p) { return __builtin_amdgcn_ds_read_tr16_b64_v4i16((LAS s16x4*)p); }
__device__ __forceinline__ h8 p8(const f32x16& p, int base) {
    return (h8){(half_t)p[base], (half_t)p[base + 1], (half_t)p[base + 2], (half_t)p[base + 3], (half_t)p[base + 4], (half_t)p[base + 5], (half_t)p[base + 6], (half_t)p[base + 7]};
}
__device__ __forceinline__ void pv_tile(f32x16 (&o)[2], const LAS unsigned char* Vb, const f32x16& p0, const f32x16& p1, int lane) {
    const int hi = lane >> 5;
    const LAS unsigned char* va = Vb + ((lane >> 4) & 1) * 32 + (lane & 3) * 8 + (4 * hi + ((lane & 15) >> 2)) * 64;
    h8 pf[4]; pf[0] = p8(p0, 0); pf[1] = p8(p0, 8); pf[2] = p8(p1, 0); pf[3] = p8(p1, 8);
#pragma unroll
    for (int dh = 0; dh < 2; ++dh)
#pragma unroll
        for (int s = 0; s < 4; ++s) {
            const s16x4 lo = tr_read(va + dh * 4096 + s * 1024), hh = tr_read(va + dh * 4096 + s * 1024 + 512);
            typedef short s16x8 __attribute__((ext_vector_type(8)));
            const s16x8 t8 = {lo[0], lo[1], lo[2], lo[3], hh[0], hh[1], hh[2], hh[3]};
            const h8 vf = __builtin_bit_cast(h8, t8);
            o[dh] = __builtin_amdgcn_mfma_f32_32x32x16_f16(vf, pf[s], o[dh], 0, 0, 0);
        }
}
__device__ __forceinline__ float max16(const f32x16& p) {
    float a = fmaxf(fmaxf(p[0], p[1]), fmaxf(p[2], p[3])), b = fmaxf(fmaxf(p[4], p[5]), fmaxf(p[6], p[7]));
    float c = fmaxf(fmaxf(p[8], p[9]), fmaxf(p[10], p[11])), d = fmaxf(fmaxf(p[12], p[13]), fmaxf(p[14], p[15]));
    return fmaxf(fmaxf(a, b), fmaxf(c, d));
}
__device__ __forceinline__ float sum16(const f32x16& p) {
    return (((p[0] + p[1]) + (p[2] + p[3])) + ((p[4] + p[5]) + (p[6] + p[7]))) + (((p[8] + p[9]) + (p[10] + p[11])) + ((p[12] + p[13]) + (p[14] + p[15])));
}

enum { MODE_WIN = 0, MODE_SEL = 1, MODE_SWA = 2 };
template <int MODE>
__device__ __forceinline__ void attn_unit(const Ctx& C, int b, int hkv, int chunk, const half_t* Q, const half_t* Kh, const half_t* Vh,
                                          const unsigned* selm, const float* Gt, float* Oacc, half_t* O, const float* sinks) {
    constexpr int GH = (MODE == MODE_SWA) ? 8 : 4, TPW = 32 / GH, TPB = 8 * TPW, WIN = (MODE == MODE_SWA) ? 128 : 512;
    const int lane = C.lane, wave = C.wave, r32 = lane & 31, hi = lane >> 5;
    const int t0 = chunk * TPB, tw0 = t0 + wave * TPW, tok = tw0 + r32 / GH, head = hkv * GH + (r32 % GH);
    const size_t gtok = (size_t)b * S + tok;
    LAS unsigned char* lds = C.lds;
    h8 qf[4];
#pragma unroll
    for (int d0 = 0; d0 < 4; ++d0) qf[d0] = *(const h8*)(Q + gtok * D + head * 64 + d0 * 16 + hi * 8);
    const int jlast = (t0 + TPB - 1) >> 6;
    unsigned tiles, msk = 0u, wneed = 0u;
    if (MODE == MODE_SEL) {
        msk = selm[tok]; unsigned x = msk;
#pragma unroll
        for (int o = 1; o < 64; o <<= 1) x |= (unsigned)__shfl_xor((int)x, o);
        wneed = (unsigned)__builtin_amdgcn_readfirstlane((int)x);
        LAS unsigned* bw = (LAS unsigned*)(lds + AL_W);
        if (C.tid == 0) bw[0] = 0u;
        __syncthreads();
        if (lane == 0) __hip_atomic_fetch_or(bw, wneed, __ATOMIC_RELAXED, __HIP_MEMORY_SCOPE_WORKGROUP);
        __syncthreads();
        tiles = bw[0];
        tiles = (unsigned)__builtin_amdgcn_readfirstlane((int)tiles);
    } else {
        const int kfirst = t0 - WIN + 1, jlo = (kfirst > 0 ? kfirst : 0) >> 6;
        tiles = (jlast >= 31 ? 0xffffffffu : ((1u << (jlast + 1)) - 1u)) & ~((1u << jlo) - 1u);
    }
    float m = NEG_BIG, l = 0.f; f32x16 o[2]; o[0] = (f32x16){}; o[1] = (f32x16){};
    u32x4 kr, vr; int buf = 0;
    unsigned tm = tiles;
    { const int j = __builtin_ctz(tm); kv_load(Kh + (size_t)j * 4096, Vh + (size_t)j * 4096, wave, lane, kr, vr); kv_store(lds + AL_K, lds + AL_V, wave, lane, kr, vr); }
    __syncthreads();
    while (tm) {
        const int j = __builtin_ctz(tm); tm &= tm - 1u;
        const bool more = tm != 0u;
        if (more) { const int jn = __builtin_ctz(tm); kv_load(Kh + (size_t)jn * 4096, Vh + (size_t)jn * 4096, wave, lane, kr, vr); }
        bool need;
        if (MODE == MODE_SEL) need = (wneed >> j) & 1u;
        else need = (64 * j <= tw0 + TPW - 1) && (64 * j + 63 >= tw0 - WIN + 1);
        if (need) {
            f32x16 p0, p1; qk_tile(p0, p1, lds + AL_K + buf * 8192, qf, r32, hi);
            const bool rowok = (MODE == MODE_SEL) ? (((msk >> j) & 1u) != 0u) : true;
            float tmax = NEG_BIG;
#pragma unroll
            for (int r = 0; r < 16; ++r) { const int k0 = 64 * j + crow(r, hi), k1 = k0 + 32;
                const bool v0 = rowok && (k0 <= tok) && (MODE == MODE_SEL || k0 > tok - WIN), v1 = rowok && (k1 <= tok) && (MODE == MODE_SEL || k1 > tok - WIN);
                p0[r] = v0 ? p0[r] : NEG_BIG; p1[r] = v1 ? p1[r] : NEG_BIG; tmax = fmaxf(tmax, fmaxf(p0[r], p1[r])); }
            tmax = fmaxf(tmax, __shfl_xor(tmax, 32));
            const float mn = fmaxf(m, tmax), alpha = fast_exp2(m - mn);
            m = mn;
#pragma unroll
            for (int r = 0; r < 16; ++r) { p0[r] = (p0[r] > -1.0e29f) ? fast_exp2(p0[r] - mn) : 0.f; p1[r] = (p1[r] > -1.0e29f) ? fast_exp2(p1[r] - mn) : 0.f; }
            l = l * alpha + (sum16(p0) + sum16(p1));
#pragma unroll
            for (int r = 0; r < 16; ++r) { o[0][r] *= alpha; o[1][r] *= alpha; }
            pv_tile(o, lds + AL_V + buf * 8192, p0, p1, lane);
        }
        if (more) kv_store(lds + AL_K + (buf ^ 1) * 8192, lds + AL_V + (buf ^ 1) * 8192, wave, lane, kr, vr);
        __syncthreads();
        buf ^= 1;
    }
    float lt = l + __shfl_xor(l, 32);
    if (MODE == MODE_SWA) lt += fast_exp2(sinks[head] * LOG2E - m);
    float sc = 1.0f / lt;
    if (MODE != MODE_SWA) sc *= Gt[gtok * 48 + head * 3 + (MODE == MODE_SEL ? 1 : 2)];
#pragma unroll
    for (int dh = 0; dh < 2; ++dh)
#pragma unroll
        for (int rg = 0; rg < 4; ++rg) { const size_t off = gtok * D + head * 64 + 32 * dh + 8 * rg + 4 * hi;
            f32x4 v = {o[dh][4 * rg] * sc, o[dh][4 * rg + 1] * sc, o[dh][4 * rg + 2] * sc, o[dh][4 * rg + 3] * sc};
            if (MODE == MODE_SEL) { *(f32x4*)(Oacc + off) = *(const f32x4*)(Oacc + off) + v; }
            else { if (MODE == MODE_WIN) v = v + *(const f32x4*)(Oacc + off); *(u32x2*)(O + off) = pk4(v); } }
}

__device__ __forceinline__ void cmp_unit(const Ctx& C, int b, int hkv, int c, const half_t* Q, const half_t* Kc, const half_t* Vc, const float* Gt, float* Oacc, unsigned* selm) {
    const int lane = C.lane, wave = C.wave, r32 = lane & 31, hi = lane >> 5;
    const int t0 = c * 64, tl = wave * 8 + (r32 >> 2), tok = t0 + tl, head = hkv * 4 + (r32 & 3);
    const size_t gtok = (size_t)b * S + tok;
    LAS unsigned char* lds = C.lds;
    h8 qf[4];
#pragma unroll
    for (int d0 = 0; d0 < 4; ++d0) qf[d0] = *(const h8*)(Q + gtok * D + head * 64 + d0 * 16 + hi * 8);
    { u32x4 kr, vr;
      kv_load(Kc, Vc, wave, lane, kr, vr); kv_store(lds + AL_K, lds + AL_V, wave, lane, kr, vr);
      kv_load(Kc + 4096, Vc + 4096, wave, lane, kr, vr); kv_store(lds + AL_K + 8192, lds + AL_V + 8192, wave, lane, kr, vr); }
    __syncthreads();
    f32x16 p[4];
    qk_tile(p[0], p[1], lds + AL_K, qf, r32, hi); qk_tile(p[2], p[3], lds + AL_K + 8192, qf, r32, hi);
    const int nvis = (tok >= 31) ? ((tok - 31) >> 4) + 1 : 0;
    float mx = NEG_BIG;
#pragma unroll
    for (int q = 0; q < 4; ++q)
#pragma unroll
        for (int r = 0; r < 16; ++r) { const int n = 32 * q + crow(r, hi); p[q][r] = (n < nvis) ? p[q][r] : NEG_BIG; mx = fmaxf(mx, p[q][r]); }
    mx = fmaxf(mx, __shfl_xor(mx, 32));
    float l = 0.f;
#pragma unroll
    for (int q = 0; q < 4; ++q) {
#pragma unroll
        for (int r = 0; r < 16; ++r) p[q][r] = (p[q][r] > -1.0e29f) ? fast_exp2(p[q][r] - mx) : 0.f;
        l += sum16(p[q]); }
    l += __shfl_xor(l, 32);
    const float inv = (l > 0.f) ? 1.0f / l : 0.f;
#pragma unroll
    for (int q = 0; q < 4; ++q)
#pragma unroll
        for (int r = 0; r < 16; ++r) p[q][r] *= inv;
    f32x16 o[2]; o[0] = (f32x16){}; o[1] = (f32x16){};
    pv_tile(o, lds + AL_V, p[0], p[1], lane); pv_tile(o, lds + AL_V + 8192, p[2], p[3], lane);
    const float g0 = Gt[gtok * 48 + head * 3 + 0];
#pragma unroll
    for (int dh = 0; dh < 2; ++dh)
#pragma unroll
        for (int rg = 0; rg < 4; ++rg) { const size_t off = gtok * D + head * 64 + 32 * dh + 8 * rg + 4 * hi;
            *(f32x4*)(Oacc + off) = (f32x4){o[dh][4 * rg] * g0, o[dh][4 * rg + 1] * g0, o[dh][4 * rg + 2] * g0, o[dh][4 * rg + 3] * g0}; }
    LAS float* ps = (LAS float*)(lds + AL_PSUM);
#pragma unroll
    for (int q = 0; q < 4; ++q)
#pragma unroll
        for (int rg = 0; rg < 4; ++rg) { f32x4 v = {p[q][4 * rg], p[q][4 * rg + 1], p[q][4 * rg + 2], p[q][4 * rg + 3]};
#pragma unroll
            for (int e = 0; e < 4; ++e) { v[e] += __shfl_xor(v[e], 1); v[e] += __shfl_xor(v[e], 2); }
            if ((r32 & 3) == 0) *(LAS f32x4*)(ps + tl * 128 + 32 * q + 8 * rg + 4 * hi) = v; }
    __syncthreads();
#pragma unroll 1
    for (int it = 0; it < 4; ++it) {
        const int tl2 = wave * 8 + 2 * it + hi, j = r32; const LAS float* pr = ps + tl2 * 128 + 4 * j;
        const f32x4 q4 = *(const LAS f32x4*)pr; const float pm1 = (j > 0) ? pr[-1] : 0.f;
        const float imp = pm1 + 2.0f * q4[0] + 2.0f * q4[1] + 2.0f * q4[2] + q4[3];
        const bool forced = (j == 0) || (j == c) || (j == c - 1);
        const float val = forced ? __builtin_inff() : ((j <= c) ? imp : -__builtin_inff());
        int rank = 0;
#pragma unroll 8
        for (int jj = 0; jj < 32; ++jj) { const float vv = __shfl(val, (lane & 32) + jj); rank += (vv > val || (vv == val && jj < j)) ? 1 : 0; }
        const bool sel = (rank < 8) && (j <= c);
        const unsigned long long bal = __ballot(sel);
        if (r32 == 0) selm[t0 + tl2] = hi ? (unsigned)(bal >> 32) : (unsigned)bal;
    }
    __syncthreads();
}

#ifndef EN_PRO
#define EN_PRO 1
#endif
#ifndef EN_ROW
#define EN_ROW 1
#endif
#ifndef EN_INPROJ
#define EN_INPROJ 1
#endif
#ifndef EN_CMP1
#define EN_CMP1 1
#endif
#ifndef EN_CMP2
#define EN_CMP2 1
#endif
#ifndef EN_CMPATT
#define EN_CMPATT 1
#endif
#ifndef EN_SEL
#define EN_SEL 1
#endif
#ifndef EN_WIN
#define EN_WIN 1
#endif
#ifndef EN_SWA
#define EN_SWA 1
#endif
#ifndef EN_OUT
#define EN_OUT 1
#endif
#ifndef EN_UP
#define EN_UP 1
#endif
#ifndef EN_DOWN
#define EN_DOWN 1
#endif
constexpr int NPHASE = 3 + 11 * DEPTH;
__host__ __device__ constexpr bool phase_exists(int p) { return p < 3 ? true : (((p - 3) / 11) % 2 == 0 ? true : !(((p - 3) % 11) >= 1 && ((p - 3) % 11) <= 4)); }

__global__ void __launch_bounds__(512, 2) mk_fwd(Args a) {
    extern __shared__ __attribute__((aligned(16))) unsigned char lds_raw[];
    Ctx C;
    C.lds = (LAS unsigned char*)lds_raw;
    C.tid = threadIdx.x; C.lane = C.tid & 63; C.wave = __builtin_amdgcn_readfirstlane(C.tid >> 6);
    C.G = gridDim.x; C.gw = blockIdx.x * 8 + C.wave; C.ngw = C.G * 8; C.ws = a.ws;
    unsigned char* ws = a.ws;
    for (int u = C.tid; u < (LDS_BYTES - LDSCTL_OFF) / 4; u += 512) ((LAS unsigned*)(C.lds + LDSCTL_OFF))[u] = 0u;
    __syncthreads();
#if MK_ONE_LAUNCH
    XcdBarrier bar = xcd_barrier_post((unsigned*)(ws + WS_CTL) + CW_BAR, (volatile LAS unsigned*)(C.lds + MISC_OFF) + 8);
#define SEAM() xcd_barrier(bar)
#else
#define SEAM() do { } while (0)
#endif
    const int lo = a.ph_lo, hi = a.ph_hi;
#define RUN(p) (lo <= (p) && (p) < hi)
#define FRESH() Ctx Cp = C; { int t_ = threadIdx.x; asm volatile("" : "+v"(t_)); Cp.tid = t_; Cp.lane = t_ & 63; Cp.wave = __builtin_amdgcn_readfirstlane(t_ >> 6); Cp.gw = blockIdx.x * 8 + Cp.wave; }

    half_t* const Hb = (half_t*)(ws + WS_H); half_t* const Yb = (half_t*)(ws + WS_Y); half_t* const Qb = (half_t*)(ws + WS_Q); half_t* const KVb = (half_t*)(ws + WS_KV);
    half_t* const Ob = (half_t*)(ws + WS_O); float* const Gb = (float*)(ws + WS_G); float* const OAb = (float*)(ws + WS_OACC); half_t* const HIDb = (half_t*)(ws + WS_BIG);
    const float* const ropeb = (const float*)(ws + WS_ROPE); unsigned* const selb = (unsigned*)(ws + WS_SELM);

    if (EN_PRO && RUN(0)) { FRESH(); phase_prologue(a, Cp); SEAM(); }
    if (EN_PRO && RUN(1)) { FRESH(); phase_modfinal(a, Cp); SEAM(); }
    if (EN_ROW && RUN(2)) { FRESH(); phase_row_first(a, Cp); SEAM(); }

#pragma unroll 1
    for (int L = 0; L < DEPTH; ++L) {
        const int pb = 3 + 11 * L, la = L >> 1; const bool nsa = (L & 1) == 0;
        if (EN_INPROJ && RUN(pb + 0)) {
            if (nsa) { pg8::Gemm g{Hb, (const half_t*)(ws + WS_WINN) + (size_t)la * NSA_INP * D, M, NSA_INP, D, D}; pg8::StaticOrder So; So.init(M, NSA_INP, C.G, (int)blockIdx.x);
                pg8::EpiNsaIn E{Qb, KVb, Gb, ropeb};
                pg8::gemm_phase<pg8::EpiNsaIn, pg8::StaticOrder, true, true>(C.lds, g, So, E);
            } else { pg8::Gemm g{Hb, (const half_t*)(ws + WS_WINS) + (size_t)la * SWA_IN * D, M, SWA_IN, D, D}; pg8::StaticOrder So; So.init(M, SWA_IN, C.G, (int)blockIdx.x);
                pg8::EpiSwaIn E{Qb, KVb, ropeb};
                pg8::gemm_phase<pg8::EpiSwaIn, pg8::StaticOrder, true, true>(C.lds, g, So, E);
            }
            SEAM();
        }
        if (nsa) {
            if (EN_CMP1 && RUN(pb + 1)) {
                pg8::Gemm g{KVb, (const half_t*)(ws + WS_W1T) + (size_t)la * 512 * 2048, 16384, 512, 2048, 1024}; pg8::CmpOrder So{C.G, (int)blockIdx.x};
                pg8::EpiF16<2> E{(half_t*)(ws + WS_HIDC), 256, (const float*)(ws + WS_B1F) + la * 512};
                pg8::gemm_phase<pg8::EpiF16<2>, pg8::CmpOrder, true, true>(C.lds, g, So, E);
                SEAM();
            }
            if (EN_CMP2 && RUN(pb + 2)) { FRESH(); phase_cmp2(a, Cp, la); SEAM(); }
            if (EN_CMPATT && RUN(pb + 3)) { FRESH();
                for (int u = blockIdx.x; u < NB * 4 * 32; u += C.G) { const int c = u & 31, bh = u >> 5, b = bh >> 2, hk = bh & 3;
                    const half_t* Kc = (const half_t*)(ws + WS_KCC) + (size_t)bh * 128 * 64; const half_t* Vc = Kc + (size_t)64 * 128 * 64;
                    cmp_unit(Cp, b, hk, c, Qb, Kc, Vc, Gb, OAb, selb + (size_t)bh * S); }
                SEAM();
            }
            if (EN_SEL && RUN(pb + 4)) { FRESH();
                for (int u = blockIdx.x; u < NB * 4 * 32; u += C.G) { const int c = 31 - (u & 31), bh = u >> 5, b = bh >> 2, hk = bh & 3;
                    attn_unit<MODE_SEL>(Cp, b, hk, c, Qb, KVb + 2 * KVT + (size_t)bh * S * 64, KVb + 3 * KVT + (size_t)bh * S * 64, selb + (size_t)bh * S, Gb, OAb, Ob, nullptr); }
                SEAM();
            }
            if (EN_WIN && RUN(pb + 5)) { FRESH();
                for (int u = blockIdx.x; u < NB * 4 * 32; u += C.G) { const int c = u & 31, bh = u >> 5, b = bh >> 2, hk = bh & 3;
                    attn_unit<MODE_WIN>(Cp, b, hk, c, Qb, KVb + 4 * KVT + (size_t)bh * S * 64, KVb + 5 * KVT + (size_t)bh * S * 64, nullptr, Gb, OAb, Ob, nullptr); }
                SEAM();
            }
        } else {
            if (EN_SWA && RUN(pb + 5)) { FRESH();
                const float* sinks = (const float*)a.in[15] + la * 16;
                for (int u = blockIdx.x; u < NB * 2 * 64; u += C.G) { const int c = u & 63, bh = u >> 6, b = bh >> 1, hk = bh & 1;
                    attn_unit<MODE_SWA>(Cp, b, hk, c, Qb, KVb + (size_t)bh * S * 64, KVb + (size_t)M * 128 + (size_t)bh * S * 64, nullptr, nullptr, nullptr, Ob, sinks); }
                SEAM();
            }
        }
        if (EN_OUT && RUN(pb + 6)) {
            pg8::Gemm g{Ob, (const half_t*)(ws + WS_WOUT) + (size_t)L * D * D, M, D, D, D}; pg8::StaticOrder So; So.init(M, D, C.G, (int)blockIdx.x);
            pg8::EpiF16<0> E{Yb, D, nullptr};
            pg8::gemm_phase<pg8::EpiF16<0>, pg8::StaticOrder, true, true>(C.lds, g, So, E);
            SEAM();
        }
        if (EN_ROW && RUN(pb + 7)) { FRESH(); phase_row_update(a, Cp, L, 0); SEAM(); }
        if (EN_UP && RUN(pb + 8)) {
            pg8::Gemm g{Hb, (const half_t*)(ws + WS_WUP) + (size_t)L * FF * D, M, FF, D, D}; pg8::StaticOrder So; So.init(M, FF, C.G, (int)blockIdx.x);
            pg8::EpiF16<1> E{HIDb, FF, nullptr};
            pg8::gemm_phase<pg8::EpiF16<1>, pg8::StaticOrder, true, true>(C.lds, g, So, E);
            SEAM();
        }
        if (EN_DOWN && RUN(pb + 9)) {
            pg8::Gemm g{HIDb, (const half_t*)(ws + WS_WDN) + (size_t)L * D * FF, M, D, FF, FF}; pg8::StaticOrder So; So.init(M, D, C.G, (int)blockIdx.x);
            pg8::EpiF16<0> E{Yb, D, nullptr};
            pg8::gemm_phase<pg8::EpiF16<0>, pg8::StaticOrder, true, true>(C.lds, g, So, E);
            SEAM();
        }
        if (EN_ROW && RUN(pb + 10)) { FRESH(); phase_row_update(a, Cp, L, 1); if (L + 1 < DEPTH) SEAM(); }
    }
#undef RUN
#undef SEAM
}

extern "C" void kernel_launch(void* const* d_in, const int* in_sizes, int n_in, void* d_out, int out_size, void* d_ws, size_t ws_size, hipStream_t stream) {
    static int grid = 0;
    if (grid == 0) {
        if (n_in != 18 || in_sizes[0] != M * D || out_size != M * D || ws_size < WS_END) {
            fprintf(stderr, "kernel_launch: built for 18 inputs, x/out of %d floats, >= %zu bytes of workspace; got n_in %d, in0 %d, out %d, ws %zu; nothing launched\n", M * D, (size_t)WS_END, n_in, n_in > 0 ? in_sizes[0] : -1, out_size, ws_size);
            grid = -1; return; }
        int dev = 0, cus = 0, per_cu = 0;
        if (hipGetDevice(&dev) != hipSuccess || hipDeviceGetAttribute(&cus, hipDeviceAttributeMultiprocessorCount, dev) != hipSuccess) { fprintf(stderr, "kernel_launch: device query failed\n"); grid = -1; return; }
        if (hipFuncSetAttribute((const void*)mk_fwd, hipFuncAttributeMaxDynamicSharedMemorySize, LDS_BYTES) != hipSuccess) { fprintf(stderr, "kernel_launch: hipFuncSetAttribute failed\n"); grid = -1; return; }
        if (hipOccupancyMaxActiveBlocksPerMultiprocessor(&per_cu, (const void*)mk_fwd, 512, LDS_BYTES) != hipSuccess || per_cu < 1)
            fprintf(stderr, "kernel_launch: note: occupancy query reports %d workgroups per CU\n", per_cu);
        (void)hipGetLastError();
        grid = cus;
    }
    if (grid < 0) return;
    if (hipMemsetAsync((char*)d_ws + WS_CTL, 0, CTL_ZERO_BYTES, stream) != hipSuccess) { fprintf(stderr, "kernel_launch: memset failed\n"); return; }
    Args a{};
    for (int i = 0; i < 18; ++i) a.in[i] = d_in[i];
    a.out = (float*)d_out; a.ws = (unsigned char*)d_ws;
#if MK_ONE_LAUNCH
    a.ph_lo = 0; a.ph_hi = NPHASE;
    hipLaunchKernelGGL(mk_fwd, dim3(grid), dim3(512), LDS_BYTES, stream, a);
#else
    for (int p = 0; p < NPHASE; ++p) { if (!phase_exists(p)) continue;
        a.ph_lo = p; a.ph_hi = p + 1;
        hipLaunchKernelGGL(mk_fwd, dim3(grid), dim3(512), LDS_BYTES, stream, a); }
#endif
    const hipError_t le = hipPeekAtLastError();
    if (le != hipSuccess) fprintf(stderr, "kernel_launch: launch failed: %s\n", hipGetErrorName(le));
}
```

```cpp
#include <hip/hip_runtime.h>
#include <cstdio>
#include <cstdint>

#ifndef MK_ONE_LAUNCH
#define MK_ONE_LAUNCH 1
#endif

#define LAS __attribute__((address_space(3)))
#define GAS __attribute__((address_space(1)))
typedef _Float16 half_t;
typedef _Float16 h8 __attribute__((ext_vector_type(8)));
typedef _Float16 h4 __attribute__((ext_vector_type(4)));
typedef _Float16 h2 __attribute__((ext_vector_type(2)));
typedef float f32x2 __attribute__((ext_vector_type(2)));
typedef float f32x4 __attribute__((ext_vector_type(4)));
typedef float f32x16 __attribute__((ext_vector_type(16)));
typedef unsigned u32x2 __attribute__((ext_vector_type(2)));
typedef unsigned u32x4 __attribute__((ext_vector_type(4)));
typedef short s16x4 __attribute__((ext_vector_type(4)));

constexpr int D = 1024, NB = 16, S = 2048, M = NB * S, DEPTH = 4, HD = 64, FF = 4096;
constexpr int NSA_IN = 2608, NSA_INP = 2816, SWA_IN = 1280;
constexpr int NCMP = 127;
constexpr float NORM_EPS = 1e-6f;
constexpr float LOG2E = 1.4426950408889634f;
constexpr float C2 = 0.125f * LOG2E;
constexpr float NEG_BIG = -1.0e30f;

constexpr size_t MiB = 1u << 20;
constexpr size_t WS_CTL = 0, CTL_ZERO_BYTES = 1 * MiB;
constexpr size_t WS_MOD  = 1 * MiB;
constexpr size_t WS_B1F  = 3 * MiB;
constexpr size_t WS_W2T  = 3 * MiB + 65536;
constexpr size_t WS_ROPE = 4 * MiB;
constexpr size_t WS_PART = 12 * MiB;
constexpr size_t WS_WINN = 24 * MiB;
constexpr size_t WS_WINS = 36 * MiB;
constexpr size_t WS_WOUT = 41 * MiB;
constexpr size_t WS_W1T  = 49 * MiB;
constexpr size_t WS_WUP  = 53 * MiB;
constexpr size_t WS_WDN  = 85 * MiB;
constexpr size_t WS_Y    = 117 * MiB;
constexpr size_t WS_H    = 181 * MiB;
constexpr size_t WS_OACC = 117 * MiB;
constexpr size_t WS_BIG  = 245 * MiB;
constexpr size_t WS_Q    = 245 * MiB;
constexpr size_t WS_KV   = 309 * MiB;
constexpr size_t WS_O    = 405 * MiB;
constexpr size_t WS_G    = 469 * MiB;
constexpr size_t WS_HIDC = 475 * MiB;
constexpr size_t WS_KCC  = 483 * MiB;
constexpr size_t WS_SELM = 485 * MiB;
constexpr size_t WS_END  = 501 * MiB;
constexpr size_t KVT = (size_t)M * 256;

constexpr int CW_BAR = 4096;

constexpr int RING_BYTES = 131072;
constexpr int LDSCTL_OFF = RING_BYTES, MISC_OFF = LDSCTL_OFF + 320;
constexpr int LDS_BYTES = 147456;

__device__ __forceinline__ unsigned pkh2(float lo, float hi) { h2 p = {(half_t)lo, (half_t)hi}; return __builtin_bit_cast(unsigned, p); }
__device__ __forceinline__ u32x2 pk4(const f32x4 v) { u32x2 w; w.x = pkh2(v[0], v[1]); w.y = pkh2(v[2], v[3]); return w; }
__device__ __forceinline__ float fast_exp2(float x) { return __builtin_amdgcn_exp2f(x); }
__device__ __forceinline__ float fast_rcp(float x) { return __builtin_amdgcn_rcpf(x); }
__device__ __forceinline__ float shx(float v, int o, int lane) { return __builtin_bit_cast(float, __builtin_amdgcn_ds_bpermute((lane ^ o) << 2, __builtin_bit_cast(int, v))); }
__device__ __forceinline__ int shxi(int v, int o, int lane) { return __builtin_amdgcn_ds_bpermute((lane ^ o) << 2, v); }
__device__ __forceinline__ float shidx(float v, int src) { return __builtin_bit_cast(float, __builtin_amdgcn_ds_bpermute(src << 2, __builtin_bit_cast(int, v))); }
__device__ __forceinline__ float wave_sum(float v, int lane) {
#pragma unroll
    for (int o = 1; o < 64; o <<= 1) v += shx(v, o, lane);
    return v;
}

namespace pg8 {
#define PG8_LAS __attribute__((address_space(3)))
typedef _Float16 bf16_t;
typedef _Float16 bf16x8 __attribute__((ext_vector_type(8)));
typedef float f32x4 __attribute__((ext_vector_type(4)));
typedef unsigned u32x4 __attribute__((ext_vector_type(4)));
constexpr int BM = 256, BK = 64, HALF = 128, HTB = HALF * BK * 2  , STAGE_BYTES = 8 * HTB, NXCD = 8, WGM = 8;

__host__ __device__ __forceinline__ int lds_byte(int r, int c) { const int st = (r >> 4) * 2 + (c >> 5), rr = r & 15, cc = c & 31, ob = rr * 64 + cc * 2; return st * 1024 + (ob ^ (((ob >> 9) & 1) << 5)); }
__host__ __device__ __forceinline__ void stage_rc(int b, int& R, int& C) { const int st = b / 1024, sb = b % 1024, swz = sb ^ (((sb >> 9) & 1) << 5); R = (st >> 1) * 16 + swz / 64; C = (st & 1) * 32 + (swz % 64) / 2; }
__host__ __device__ __forceinline__ int perm32(int rho) { const int n = rho >> 4, i = rho & 15; return 8 * (i >> 2) + 4 * n + (i & 3); }

struct Unit { int pm, pn; };
struct Gemm { const bf16_t* A; const bf16_t* Bt; int M, N, K, lda; };

struct StaticOrder {
    int nM, nN, nwg, G, c;
    __host__ __device__ void init(int M, int N, int G_, int c_) { nM = M / BM; nN = N / BM; nwg = nM * nN; G = G_; c = c_; }
    __host__ __device__ bool next(int i, Unit& u) const {
        const long L = (long)i * G + c; if (L >= nwg) return false;
        int wgid = (int)L; { const int q = nwg / NXCD, r = nwg % NXCD, xcd = wgid % NXCD, off = wgid / NXCD; wgid = (xcd < r ? xcd * (q + 1) : r * (q + 1) + (xcd - r) * q) + off; }
        const int nig = WGM * nN, gid = wgid / nig, fm = gid * WGM, gsz = (nM - fm) < WGM ? (nM - fm) : WGM;
        u.pm = fm + ((wgid % nig) % gsz); u.pn = (wgid % nig) / gsz; return true;
    }
    __device__ __forceinline__ void a_ready(const Unit&) const {}
    __device__ __forceinline__ void done(const Unit&) const {}
};


struct CmpOrder {
    int G, c;
    __device__ bool next(int i, Unit& u) const { const int L = i * G + c; if (L >= 64) return false; u.pm = L; u.pn = L >> 5; return true; }
    __device__ __forceinline__ void a_ready(const Unit&) const {}
    __device__ __forceinline__ void done(const Unit&) const {}
};

__device__ __forceinline__ u32x4 pack8h(const f32x4 v0, const f32x4 v1) { u32x4 w; w.x = pkh2(v0[0], v0[1]); w.y = pkh2(v0[2], v0[3]); w.z = pkh2(v1[0], v1[1]); w.w = pkh2(v1[2], v1[3]); return w; }
__device__ __forceinline__ float gelu_tanh(float v) {
    const float u2 = 1.5957691216057308f * (v + 0.044715f * v * v * v);
    return v * fast_rcp(1.0f + fast_exp2(-u2 * LOG2E));
}
template <int ACT> struct EpiF16 {
    static constexpr bool PERM = true, AFTER_DRAIN = false;
    half_t* O; int ldc; const float* bias;
    __device__ __forceinline__ void operator()(const f32x4 (&acc)[2][2][4][2], const Unit& u, int wr, int wc, int fr, int fq) const {
        asm volatile("" : "+v"(fr), "+v"(fq));
        const int row0 = u.pm * BM + wr * 64 + fr;
        const int col0 = (ACT == 2 ? 0 : u.pn * BM) + wc * 32 + 8 * fq, bcol0 = u.pn * BM + wc * 32 + 8 * fq;
        f32x4 bv[2][2];
#pragma unroll
        for (int bj = 0; bj < 2; ++bj)
#pragma unroll
            for (int n = 0; n < 2; ++n) bv[bj][n] = (ACT == 2) ? *(const f32x4*)(bias + bcol0 + bj * HALF + 4 * n) : (f32x4){0.f, 0.f, 0.f, 0.f};
#pragma unroll
        for (int ai = 0; ai < 2; ++ai)
#pragma unroll
            for (int m = 0; m < 4; ++m) { half_t* rowp = O + (size_t)(row0 + ai * HALF + m * 16) * ldc + col0;
#pragma unroll
                for (int bj = 0; bj < 2; ++bj) { f32x4 v0 = acc[ai][bj][m][0], v1 = acc[ai][bj][m][1];
                    if (ACT == 1) {
#pragma unroll
                        for (int e = 0; e < 4; ++e) { const float a = fmaxf(v0[e], 0.f), b = fmaxf(v1[e], 0.f); v0[e] = a * a; v1[e] = b * b; } }
                    if (ACT == 2) { v0 = v0 + bv[bj][0]; v1 = v1 + bv[bj][1];
#pragma unroll
                        for (int e = 0; e < 4; ++e) { v0[e] = gelu_tanh(v0[e]); v1[e] = gelu_tanh(v1[e]); } }
                    *(u32x4*)(rowp + bj * HALF) = pack8h(v0, v1); } }
    }
};

__device__ __forceinline__ void rope8(const f32x4 v0, const f32x4 v1, const float* ropetok, int i0, float sc, f32x4& o1, f32x4& o2) {
    const f32x4 c = *(const f32x4*)(ropetok + i0), s = *(const f32x4*)(ropetok + 32 + i0);
    const f32x4 x1 = {v0[0], v0[2], v1[0], v1[2]}, x2 = {v0[1], v0[3], v1[1], v1[3]};
    o1 = (x1 * c - x2 * s) * sc; o2 = (x2 * c + x1 * s) * sc;
}
__device__ __forceinline__ u32x2 pack4h(const f32x4 v) { u32x2 w; w.x = pkh2(v[0], v[1]); w.y = pkh2(v[2], v[3]); return w; }

struct EpiNsaIn {
    static constexpr bool PERM = true, AFTER_DRAIN = false;
    half_t* Q; half_t* KV; float* G; const float* rope;
    __device__ __forceinline__ void operator()(const f32x4 (&acc)[2][2][4][2], const Unit& u, int wr, int wc, int fr, int fq) const {
        asm volatile("" : "+v"(fr), "+v"(fq));
        const int pn = u.pn;
#pragma unroll
        for (int ai = 0; ai < 2; ++ai)
#pragma unroll
            for (int m = 0; m < 4; ++m) {
                const int tok = u.pm * BM + ai * HALF + wr * 64 + m * 16 + fr, b = tok >> 11, s = tok & 2047;
                const float* rt = rope + (size_t)tok * 64;
#pragma unroll
                for (int bj = 0; bj < 2; ++bj) {
                    const int cit = bj * HALF + wc * 32 + 8 * fq, hh = cit >> 6, jj0 = cit & 63;
                    const f32x4 v0 = acc[ai][bj][m][0], v1 = acc[ai][bj][m][1];
                    if (pn < 4) { f32x4 o1, o2; rope8(v0, v1, rt, jj0 >> 1, C2, o1, o2);
                        half_t* p = Q + (size_t)tok * D + pn * 256 + hh * 64 + (jj0 >> 1);
                        *(u32x2*)p = pack4h(o1); *(u32x2*)(p + 32) = pack4h(o2);
                    } else if (pn == 10) {
                        if (cit < 48) { f32x4 g0, g1;
#pragma unroll
                            for (int e = 0; e < 4; ++e) { g0[e] = fast_rcp(1.0f + fast_exp2(-v0[e] * LOG2E)); g1[e] = fast_rcp(1.0f + fast_exp2(-v1[e] * LOG2E)); }
                            float* p = G + (size_t)tok * 48 + cit; *(f32x4*)p = g0; *(f32x4*)(p + 4) = g1; }
                    } else {
                        const int t = pn - 4;
                        half_t* base = KV + (size_t)t * KVT + ((size_t)(b * 4 + hh) * S + s) * 64;
                        if ((t & 1) == 0) { f32x4 o1, o2; rope8(v0, v1, rt, jj0 >> 1, 1.0f, o1, o2);
                            *(u32x2*)(base + (jj0 >> 1)) = pack4h(o1); *(u32x2*)(base + 32 + (jj0 >> 1)) = pack4h(o2);
                        } else *(u32x4*)(base + jj0) = pack8h(v0, v1);
                    }
                }
                asm volatile("" ::: "memory");
            }
    }
};
struct EpiSwaIn {
    static constexpr bool PERM = true, AFTER_DRAIN = false;
    half_t* Q; half_t* KV; const float* rope;
    __device__ __forceinline__ void operator()(const f32x4 (&acc)[2][2][4][2], const Unit& u, int wr, int wc, int fr, int fq) const {
        asm volatile("" : "+v"(fr), "+v"(fq));
        const int pn = u.pn;
#pragma unroll
        for (int ai = 0; ai < 2; ++ai)
#pragma unroll
            for (int m = 0; m < 4; ++m) {
                const int tok = u.pm * BM + ai * HALF + wr * 64 + m * 16 + fr, b = tok >> 11, s = tok & 2047;
                const float* rt = rope + (size_t)tok * 64;
#pragma unroll
                for (int bj = 0; bj < 2; ++bj) {
                    const int cit = bj * HALF + wc * 32 + 8 * fq, hh = cit >> 6, jj0 = cit & 63;
                    const f32x4 v0 = acc[ai][bj][m][0], v1 = acc[ai][bj][m][1];
                    if (pn < 4) { f32x4 o1, o2; rope8(v0, v1, rt, jj0 >> 1, C2, o1, o2);
                        half_t* p = Q + (size_t)tok * D + pn * 256 + hh * 64 + (jj0 >> 1);
                        *(u32x2*)p = pack4h(o1); *(u32x2*)(p + 32) = pack4h(o2);
                    } else if (bj == 0) {
                        half_t* base = KV + ((size_t)(b * 2 + hh) * S + s) * 64;
                        f32x4 o1, o2; rope8(v0, v1, rt, jj0 >> 1, 1.0f, o1, o2);
                        *(u32x2*)(base + (jj0 >> 1)) = pack4h(o1); *(u32x2*)(base + 32 + (jj0 >> 1)) = pack4h(o2);
                    } else {
                        half_t* base = KV + (size_t)M * 128 + ((size_t)(b * 2 + (hh - 2)) * S + s) * 64;
                        *(u32x4*)(base + jj0) = pack8h(v0, v1);
                    }
                }
                asm volatile("" ::: "memory");
            }
    }
};
template <class Epi, class Sched, bool ALIGN_EPI = false, bool SP2 = false>
__device__ __forceinline__ void gemm_phase(PG8_LAS unsigned char* lds, const Gemm g, const Sched& S, const Epi& E, int tid_in) {
    int tid_ = tid_in; asm volatile("" : "+v"(tid_));
    const int tid = tid_, wid = __builtin_amdgcn_readfirstlane(tid >> 6), lane = tid & 63, wr = wid >> 2, wc = wid & 3, fr = lane & 15, fq = lane >> 4;
    const int K = g.K, nt = K / BK;
    unsigned voffA[2], voffB[2];
#pragma unroll
    for (int i = 0; i < 2; ++i) { int R, C; stage_rc(tid * 16 + i * 8192, R, C); const int Rb = Epi::PERM ? ((R & ~31) + perm32(R & 31)) : R;
        voffA[i] = (unsigned)(R * g.lda + C) * 2u; voffB[i] = (unsigned)(Rb * K + C) * 2u; }
    const size_t kstep = (size_t)(BK * 2);
    const size_t hstep = (size_t)HALF * K * 2;
    const size_t tstep = 2 * hstep;
    const size_t hstepA = (size_t)HALF * g.lda * 2, tstepA = 2 * hstepA;
    const unsigned ldsw = (unsigned)wid * 1024u;
    const int aoff = lds_byte(wr * 64 + fr, fq * 8), boff = lds_byte(wc * 32 + fr, fq * 8);
#define PG8_SA(b, h) (((b) * 2 + (h)) * HTB)
#define PG8_SB(b, h) ((4 + (b) * 2 + (h)) * HTB)
#define PG8_STAGE(bufoff, gbase, voff) do { _Pragma("unroll") for (int _i = 0; _i < 2; ++_i) \
        __builtin_amdgcn_global_load_lds((const unsigned*)((const char*)(gbase) + (voff)[_i]), (PG8_LAS unsigned*)(lds + (bufoff) + ldsw + _i * 8192), 16, 0, 0); } while (0)
#define PG8_LDA(dst, b, h) do { _Pragma("unroll") for (int m = 0; m < 4; ++m) _Pragma("unroll") for (int k = 0; k < 2; ++k) dst[m][k] = *(const PG8_LAS bf16x8*)(lds + PG8_SA(b, h) + aoff + m * 2048 + k * 1024); } while (0)
#define PG8_LDB(dst, b, h) do { _Pragma("unroll") for (int n = 0; n < 2; ++n) _Pragma("unroll") for (int k = 0; k < 2; ++k) dst[n][k] = *(const PG8_LAS bf16x8*)(lds + PG8_SB(b, h) + boff + n * 2048 + k * 1024); } while (0)
#define PG8_MMA(ai, bj, At, Bt) do { __builtin_amdgcn_s_setprio(1); _Pragma("unroll") for (int m = 0; m < 4; ++m) _Pragma("unroll") for (int n = 0; n < 2; ++n) _Pragma("unroll") for (int k = 0; k < 2; ++k) \
        acc[ai][bj][m][n] = __builtin_amdgcn_mfma_f32_16x16x32_f16(Bt[n][k], At[m][k], acc[ai][bj][m][n], 0, 0, 0); __builtin_amdgcn_s_setprio(0); } while (0)
#define PG8_WAIT_V(n) asm volatile("s_waitcnt vmcnt(" #n ")" ::: "memory")
#define PG8_WAIT_L(n) asm volatile("s_waitcnt lgkmcnt(" #n ")" ::: "memory")
#define PG8_BAR __builtin_amdgcn_s_barrier()
#define PG8_SCHED __builtin_amdgcn_sched_barrier(0)
    Unit cur, nxt; int ui = 0;
    if (!S.next(0, cur)) return;
    f32x4 acc[2][2][4][2];
#pragma unroll
    for (int a = 0; a < 2; ++a)
#pragma unroll
        for (int b = 0; b < 2; ++b)
#pragma unroll
            for (int m = 0; m < 4; ++m)
#pragma unroll
                for (int n = 0; n < 2; ++n) acc[a][b][m][n] = (f32x4){0.f, 0.f, 0.f, 0.f};
    bf16x8 At[4][2], B0[2][2], B1[2][2];
    const char* cA = (const char*)g.A + (size_t)cur.pm * tstepA; const char* cB = (const char*)g.Bt + (size_t)cur.pn * tstep;
    S.a_ready(cur);
    static_assert(SP2, "only the SP2 loop is kept in this file");
    {
        PG8_STAGE(PG8_SB(0, 0), cB, voffB); PG8_STAGE(PG8_SB(0, 1), cB + hstep, voffB); PG8_STAGE(PG8_SA(0, 0), cA, voffA); PG8_STAGE(PG8_SA(0, 1), cA + hstepA, voffA);
        if (wr == 1) PG8_BAR;
        PG8_WAIT_V(2); PG8_BAR;
        PG8_STAGE(PG8_SB(1, 0), cB + kstep, voffB); PG8_STAGE(PG8_SA(1, 0), cA + kstep, voffA); PG8_STAGE(PG8_SB(1, 1), cB + hstep + kstep, voffB);
        PG8_WAIT_V(6); PG8_BAR;
    }
    for (;;) {
        const bool has_next = S.next(ui + 1, nxt);
        const char* nA = has_next ? (const char*)g.A + (size_t)nxt.pm * tstepA : cA; const char* nB = has_next ? (const char*)g.Bt + (size_t)nxt.pn * tstep : cB;
        for (int t = 0; t < nt; t += 2) {
            const bool last = (t == nt - 2);
            const char* a1 = cA + (size_t)(t + 1) * kstep;
            const char* a2 = last ? nA : cA + (size_t)(t + 2) * kstep; const char* b2 = last ? nB : cB + (size_t)(t + 2) * kstep;
            const char* a3 = a2 + kstep; const char* b3 = b2 + kstep;
            if (last && has_next) S.a_ready(nxt);
            {
            PG8_LDB(B0, 0, 0); PG8_LDB(B1, 0, 1); PG8_SCHED; PG8_LDA(At, 0, 0); PG8_STAGE(PG8_SA(1, 1), a1 + hstepA, voffA);
            PG8_WAIT_V(8); PG8_WAIT_L(0); PG8_BAR; PG8_MMA(0, 0, At, B0); PG8_MMA(0, 1, At, B1); PG8_BAR; PG8_SCHED;
            PG8_LDA(At, 0, 1); PG8_STAGE(PG8_SB(0, 0), b2, voffB); PG8_STAGE(PG8_SB(0, 1), b2 + hstep, voffB); PG8_STAGE(PG8_SA(0, 0), a2, voffA);
            PG8_WAIT_V(8); PG8_WAIT_L(0); PG8_BAR; PG8_MMA(1, 0, At, B0); PG8_MMA(1, 1, At, B1); PG8_BAR; PG8_SCHED;
            PG8_LDB(B0, 1, 0); PG8_LDB(B1, 1, 1); PG8_SCHED; PG8_LDA(At, 1, 0); PG8_STAGE(PG8_SA(0, 1), a2 + hstepA, voffA);
            PG8_WAIT_V(8); PG8_WAIT_L(0); PG8_BAR; PG8_MMA(0, 0, At, B0); PG8_MMA(0, 1, At, B1); PG8_BAR; PG8_SCHED;
            PG8_LDA(At, 1, 1); PG8_STAGE(PG8_SB(1, 0), b3, voffB); PG8_STAGE(PG8_SB(1, 1), b3 + hstep, voffB); PG8_STAGE(PG8_SA(1, 0), a3, voffA);
            PG8_WAIT_V(8); PG8_WAIT_L(0); PG8_BAR; PG8_MMA(1, 0, At, B0); PG8_MMA(1, 1, At, B1); PG8_BAR; PG8_SCHED;
            }
        }
        if constexpr (ALIGN_EPI) { if (wr == 0) PG8_BAR; }
        if constexpr (!Epi::AFTER_DRAIN) { E(acc, cur, wr, wc, fr, fq); S.done(cur); }
        if (!has_next) break;
#pragma unroll
        for (int a = 0; a < 2; ++a)
#pragma unroll
            for (int b = 0; b < 2; ++b)
#pragma unroll
                for (int m = 0; m < 4; ++m)
#pragma unroll
                    for (int n = 0; n < 2; ++n) acc[a][b][m][n] = (f32x4){0.f, 0.f, 0.f, 0.f};
        cur = nxt; cA = nA; cB = nB; ++ui;
        if constexpr (ALIGN_EPI) { if (wr == 1) PG8_BAR; }
    }
    PG8_WAIT_V(0);
    if constexpr (!ALIGN_EPI) { if (wr == 0) PG8_BAR; }
    PG8_BAR;
    if constexpr (Epi::AFTER_DRAIN) { E.fused(acc, cur, wr, wc, fr, fq, lds, wid, lane); S.done(cur); }
#undef PG8_SA
#undef PG8_SB
#undef PG8_STAGE
#undef PG8_LDA
#undef PG8_LDB
#undef PG8_MMA
#undef PG8_WAIT_V
#undef PG8_WAIT_L
#undef PG8_BAR
#undef PG8_SCHED
}
}

#define XB_TMO      128
#define XB_XCNT(j)  (256  + 64 * (j))
#define XB_XSUB(j)  (1280 + 64 * (j))
#define XB_XGEN(j)  (2304 + 64 * (j))
#define XB_TOP      3328
#define XB_TOPGEN   3392
#define XCD_BAR_WORDS 3456
#define XB_SPIN_CAP (1u << 18)

__device__ __forceinline__ unsigned xb_ld(unsigned* p)              { return __hip_atomic_load(p, __ATOMIC_RELAXED, __HIP_MEMORY_SCOPE_AGENT); }
__device__ __forceinline__ unsigned xb_add(unsigned* p, unsigned v) { return __hip_atomic_fetch_add(p, v, __ATOMIC_RELAXED, __HIP_MEMORY_SCOPE_AGENT); }
__device__ __forceinline__ unsigned xb_xcc_id() { return (unsigned)__builtin_amdgcn_s_getreg((3 << 11) | 20) & 0xFu; }
#define XB_SPIN(cond, bar) do { unsigned _sp = 0; while (cond) { __builtin_amdgcn_s_sleep(1); \
    if ((++_sp & 255u) == 0u) { if (xb_ld(&(bar)[XB_TMO])) break; if (_sp > XB_SPIN_CAP) { atomicAdd(&(bar)[XB_TMO], 1u); break; } } } } while (0)

struct XcdBarrier {
    unsigned* bar; unsigned x;
    volatile LAS unsigned* st;
};

__device__ __forceinline__ XcdBarrier xcd_barrier_post(unsigned* bar, volatile LAS unsigned* st) {
    XcdBarrier b; b.bar = bar; b.x = xb_xcc_id(); b.st = st;
    if (threadIdx.x == 0) (void)xb_add(&bar[XB_XCNT(b.x)], 1u);
    return b;
}
__device__ __forceinline__ void xcd_barrier_complete(unsigned* bar, unsigned x, unsigned& nloc, unsigned& nx) {
    const unsigned G = gridDim.x * gridDim.y * gridDim.z;
    asm volatile("" : "+s"(x));
    unsigned sum, cnt, mine, sp = 0u;
    for (;;) {
        sum = 0u; cnt = 0u; mine = 0u;
#pragma unroll
        for (unsigned j = 0; j < 16; ++j) { const unsigned c = xb_ld(&bar[XB_XCNT(j)]); sum += c; cnt += (c > 0u) ? 1u : 0u; mine = (j == x) ? c : mine; }
        if (sum == G) break;
        __builtin_amdgcn_s_sleep(1);
        if ((++sp & 255u) == 0u) { if (xb_ld(&bar[XB_TMO])) break; if (sp > XB_SPIN_CAP) { atomicAdd(&bar[XB_TMO], 1u); break; } }
    }
    nloc = mine > 0u ? mine : 1u; nx = cnt > 0u ? cnt : 1u;
}

__device__ __forceinline__ void xcd_barrier(const XcdBarrier& b) {
    asm volatile("s_waitcnt vmcnt(0)" ::: "memory");
    __syncthreads();
    if (threadIdx.x == 0) {
        unsigned* bar = b.bar;
        __builtin_amdgcn_s_waitcnt(0);
        unsigned nloc = b.st[0], nx = b.st[1];
        if (nloc == 0u) { xcd_barrier_complete(bar, b.x, nloc, nx); b.st[0] = nloc; b.st[1] = nx; }
        const unsigned old = xb_add(&bar[XB_XSUB(b.x)], 1u);
        const unsigned gen = old / nloc;
        if (old + 1u == (gen + 1u) * nloc) {
            __builtin_amdgcn_fence(__ATOMIC_RELEASE, "agent");
            asm volatile("s_waitcnt vmcnt(0)" ::: "memory");
            const unsigned og = xb_add(&bar[XB_TOP], 1u);
            const unsigned tg = og / nx;
            if (og + 1u == (tg + 1u) * nx) xb_add(&bar[XB_TOPGEN], 1u);
            else XB_SPIN(xb_ld(&bar[XB_TOPGEN]) == tg, bar);
            __builtin_amdgcn_fence(__ATOMIC_ACQUIRE, "agent");
            xb_add(&bar[XB_XGEN(b.x)], 1u);
            asm volatile("s_waitcnt vmcnt(0)" ::: "memory");
        } else {
            XB_SPIN(xb_ld(&bar[XB_XGEN(b.x)]) == gen, bar);
            __builtin_amdgcn_fence(__ATOMIC_ACQUIRE, "agent");
            asm volatile("s_waitcnt vmcnt(0)" ::: "memory");
        }
    }
    __syncthreads();
}

struct Args { const GAS void* in[18]; GAS float* out; GAS unsigned char* ws; int ph_lo, ph_hi; };
typedef const __attribute__((address_space(4))) Args* ArgsP;
struct Ctx {
    LAS unsigned char* lds;
    int tid, lane, wave, G, gw, ngw;
    unsigned char* ws;
};
#define LDS_WAIT() asm volatile("s_waitcnt lgkmcnt(0)" ::: "memory")

__device__ const float INVF[32] = {1.000000000e+00f, 7.498942018e-01f, 5.623413324e-01f, 4.216965139e-01f, 3.162277639e-01f, 2.371373922e-01f, 1.778279394e-01f, 1.333521456e-01f,
    1.000000015e-01f, 7.498941571e-02f, 5.623412877e-02f, 4.216964915e-02f, 3.162277862e-02f, 2.371373586e-02f, 1.778279431e-02f, 1.333521493e-02f,
    9.999999776e-03f, 7.498942316e-03f, 5.623413250e-03f, 4.216964822e-03f, 3.162277862e-03f, 2.371373819e-03f, 1.778279431e-03f, 1.333521446e-03f,
    1.000000047e-03f, 7.498941850e-04f, 5.623413017e-04f, 4.216965463e-04f, 3.162277862e-04f, 2.371373848e-04f, 1.778279402e-04f, 1.333521504e-04f};

__device__ __forceinline__ void sincos_d(double x, double& sn, double& cs) {
    const double k = __builtin_rint(x * 0.63661977236758134308);
    double r = __builtin_fma(-k, 1.57079632679489655800e+00, x); r = __builtin_fma(-k, 6.12323399573676603587e-17, r);
    const double z = r * r;
    double sp = 1.0 / 6227020800.0; sp = sp * z - 1.0 / 39916800.0; sp = sp * z + 1.0 / 362880.0; sp = sp * z - 1.0 / 5040.0; sp = sp * z + 1.0 / 120.0; sp = sp * z - 1.0 / 6.0; sp = sp * z + 1.0;
    const double s0 = sp * r;
    double cp = -1.0 / 87178291200.0; cp = cp * z + 1.0 / 479001600.0; cp = cp * z - 1.0 / 3628800.0; cp = cp * z + 1.0 / 40320.0; cp = cp * z - 1.0 / 720.0; cp = cp * z + 1.0 / 24.0; cp = cp * z - 0.5; cp = cp * z + 1.0;
    const int q = ((int)k) & 3;
    sn = (q == 0) ? s0 : (q == 1) ? cp : (q == 2) ? -s0 : -cp;
    cs = (q == 0) ? cp : (q == 1) ? -s0 : (q == 2) ? -cp : s0;
}

__device__ __forceinline__ int w_rowmap(int mode, int n) {
    if (mode == 0) return n;
    bool rope;
    if (mode == 1) { const int t = n >> 8; rope = (t < 4) || t == 4 || t == 6 || t == 8; }
    else rope = n < 1152;
    if (!rope) return n;
    const int d = n & 63; return (n & ~63) + 2 * (d & 31) + (d >> 5);
}
__device__ __forceinline__ void convert_item(const float* W, int K, int N, half_t* WT, int mode, LAS float* scr, int item, int lane) {
    const int nblk = (N + 31) / 32, kb = item / nblk, nb = item % nblk, k0 = 64 * kb, n0 = 32 * nb;
    const int nn = n0 + (lane & 31);
#pragma unroll 8
    for (int i = 0; i < 32; ++i) { const int kk = 2 * i + (lane >> 5); scr[kk * 33 + (lane & 31)] = (nn < N) ? W[(size_t)(k0 + kk) * N + nn] : 0.f; }
    LDS_WAIT(); asm volatile("" ::: "memory");
    const int c = lane & 7;
#pragma unroll
    for (int j = 0; j < 4; ++j) { const int nl = (lane >> 3) + 8 * j, n = n0 + nl; const LAS float* s = scr + (8 * c) * 33 + nl;
        u32x4 o; o.x = pkh2(s[0 * 33], s[1 * 33]); o.y = pkh2(s[2 * 33], s[3 * 33]); o.z = pkh2(s[4 * 33], s[5 * 33]); o.w = pkh2(s[6 * 33], s[7 * 33]);
        if (n < N) *(u32x4*)(WT + (size_t)w_rowmap(mode, n) * K + k0 + 8 * c) = o; }
    LDS_WAIT(); asm volatile("" ::: "memory");
}
struct WDesc { const float* src; half_t* dst; int K, N, mode; };
__device__ __forceinline__ WDesc wdesc(ArgsP a, int mid) {
    WDesc d; unsigned char* ws = (unsigned char*)a->ws;
    if (mid < 2)       { d.src = (const float*)a->in[6] + (size_t)mid * D * NSA_IN;            d.dst = (half_t*)(ws + WS_WINN) + (size_t)mid * NSA_INP * D;         d.K = D;    d.N = NSA_IN; d.mode = 1; }
    else if (mid < 4)  { d.src = (const float*)a->in[13] + (size_t)(mid - 2) * D * SWA_IN;     d.dst = (half_t*)(ws + WS_WINS) + (size_t)(mid - 2) * SWA_IN * D;    d.K = D;    d.N = SWA_IN; d.mode = 2; }
    else if (mid < 6)  { d.src = (const float*)a->in[7] + (size_t)(mid - 4) * D * D;           d.dst = (half_t*)(ws + WS_WOUT) + (size_t)(2 * (mid - 4)) * D * D;   d.K = D;    d.N = D;      d.mode = 0; }
    else if (mid < 8)  { d.src = (const float*)a->in[14] + (size_t)(mid - 6) * D * D;          d.dst = (half_t*)(ws + WS_WOUT) + (size_t)(2 * (mid - 6) + 1) * D * D; d.K = D;  d.N = D;      d.mode = 0; }
    else if (mid < 12) { d.src = (const float*)a->in[9] + (size_t)(mid - 8) * 2048 * 256;      d.dst = (half_t*)(ws + WS_W1T) + (size_t)(mid - 8) * 256 * 2048;     d.K = 2048; d.N = 256;    d.mode = 0; }
    else if (mid < 16) { d.src = (const float*)a->in[11] + (size_t)(mid - 12) * 256 * 64;      d.dst = (half_t*)(ws + WS_W2T) + (size_t)(mid - 12) * 64 * 256;      d.K = 256;  d.N = 64;     d.mode = 0; }
    else if (mid < 20) { d.src = (const float*)a->in[16] + (size_t)(mid - 16) * D * FF;        d.dst = (half_t*)(ws + WS_WUP) + (size_t)(mid - 16) * FF * D;        d.K = D;    d.N = FF;     d.mode = 0; }
    else               { d.src = (const float*)a->in[17] + (size_t)(mid - 20) * FF * D;        d.dst = (half_t*)(ws + WS_WDN) + (size_t)(mid - 20) * D * FF;        d.K = FF;   d.N = D;      d.mode = 0; }
    return d;
}

__device__ __forceinline__ void phase_prologue(ArgsP a, const Ctx& C) {
    unsigned char* ws = C.ws;
    {
        LAS float* scr = (LAS float*)(C.lds + C.wave * 16384);
        for (int mid = 0; mid < 24; ++mid) { const WDesc d = wdesc(a, mid); const int nit = (d.K / 64) * ((d.N + 31) / 32);
            for (int it = C.gw; it < nit; it += C.ngw) convert_item(d.src, d.K, d.N, d.dst, d.mode, scr, it, C.lane); }
    }
    {
        const int gt = C.gw * 64 + C.lane, ngt = C.ngw * 64;
        for (int i = gt; i < 2 * 208 * 128; i += ngt) { const int mat = i / (208 * 128), r = i % (208 * 128);
            *(u32x4*)((half_t*)(ws + WS_WINN) + (size_t)mat * NSA_INP * D + (size_t)NSA_IN * D + (size_t)r * 8) = (u32x4){0u, 0u, 0u, 0u}; }
        const int* pos = (const int*)a->in[2]; float* rope = (float*)(ws + WS_ROPE);
        for (int i = gt; i < M * 32; i += ngt) { const int tok = i >> 5, fi = i & 31;
            const float ang = (float)pos[tok] * INVF[fi]; double sn, cs; sincos_d((double)ang, sn, cs);
            rope[(size_t)tok * 64 + fi] = (float)cs; rope[(size_t)tok * 64 + 32 + fi] = (float)sn; }
    }
    {
        if (C.gw < 16) { const int lw = C.gw >> 2, j = (C.gw & 3) * 64 + C.lane;
            const float* w1 = (const float*)a->in[9] + (size_t)lw * 2048 * 256; const float* pe = (const float*)a->in[8] + (size_t)lw * 2048;
            float s = ((const float*)a->in[10])[lw * 256 + j];
            for (int k = 0; k < 2048; ++k) s += pe[k] * w1[(size_t)k * 256 + j];
            ((float*)(ws + WS_B1F))[lw * 256 + j] = s; }
    }
    __syncthreads();
    {
        LAS float* cl = (LAS float*)C.lds; const float* cin = (const float*)a->in[1];
        for (int i = C.tid; i < 16 * 1024; i += 512) { const int b = i >> 10, k = i & 1023; const float v = cin[i]; cl[k * 16 + b] = v / (1.0f + __expf(-v)); }
        __syncthreads();
        const float* aw = (const float*)a->in[3]; float* part = (float*)(ws + WS_PART);
        for (int task = C.gw; task < 4 * 8 * 96; task += C.ngw) {
            const int ng = task % 96, lk = task / 96, ks = lk & 7, L = lk >> 3, col = ng * 64 + C.lane;
            const float* wp = aw + ((size_t)L * 1024 + ks * 128) * 6144 + col;
            float acc[16];
#pragma unroll
            for (int b = 0; b < 16; ++b) acc[b] = 0.f;
#pragma unroll 4
            for (int kk = 0; kk < 128; ++kk) { const float w = wp[(size_t)kk * 6144]; const LAS f32x4* cv = (const LAS f32x4*)(cl + (ks * 128 + kk) * 16);
#pragma unroll
                for (int q = 0; q < 4; ++q) { const f32x4 c4 = cv[q]; acc[4 * q] += c4[0] * w; acc[4 * q + 1] += c4[1] * w; acc[4 * q + 2] += c4[2] * w; acc[4 * q + 3] += c4[3] * w; } }
#pragma unroll
            for (int b = 0; b < 16; ++b) part[((size_t)(ks * 4 + L) * 16 + b) * 6144 + col] = acc[b];
        }
    }
}
__device__ __forceinline__ void phase_modfinal(ArgsP a, const Ctx& C) {
    const float* part = (const float*)(C.ws + WS_PART); const float* ab = (const float*)a->in[4]; float* mod = (float*)(C.ws + WS_MOD);
    for (int i = C.gw * 64 + C.lane; i < 4 * 16 * 6144; i += C.ngw * 64) { const int L = i / 98304, rem = i % 98304, n = rem % 6144;
        float s = ab[L * 6144 + n];
#pragma unroll
        for (int ks = 0; ks < 8; ++ks) s += part[(size_t)(ks * 4 + L) * 98304 + rem];
        mod[i] = s; }
}

__device__ __forceinline__ void row_norm_mod(const f32x4 (&v)[4], float rstd, const float* gain, const float* sh, const float* sc, half_t* hrow, int lane) {
#pragma unroll
    for (int j = 0; j < 4; ++j) { const int c = 4 * lane + 256 * j;
        const f32x4 g = *(const f32x4*)(gain + c), s1 = *(const f32x4*)(sc + c), s0 = *(const f32x4*)(sh + c);
        const f32x4 h = (v[j] * rstd * g) * (s1 + 1.0f) + s0;
        *(u32x2*)(hrow + c) = pk4(h); }
}

__device__ __forceinline__ void phase_row_first(ArgsP a, const Ctx& C) {
    const float* x = (const float*)a->in[0]; const float* ng = (const float*)a->in[5]; const float* mod = (const float*)(C.ws + WS_MOD); half_t* H = (half_t*)(C.ws + WS_H);
    for (int row = C.gw; row < M; row += C.ngw) { const int b = row >> 11;
        f32x4 v[4]; float ss = 0.f;
#pragma unroll
        for (int j = 0; j < 4; ++j) { v[j] = *(const f32x4*)(x + (size_t)row * D + 4 * C.lane + 256 * j); ss += (v[j][0] * v[j][0] + v[j][1] * v[j][1]) + (v[j][2] * v[j][2] + v[j][3] * v[j][3]); }
        const float rstd = 1.0f / sqrtf(wave_sum(ss, C.lane) * (1.0f / D) + NORM_EPS);
        const float* mb = mod + (size_t)b * 6144;
        row_norm_mod(v, rstd, ng, mb, mb + 1024, H + (size_t)row * D, C.lane);
    }
}
__device__ __forceinline__ void phase_row_update(ArgsP a, const Ctx& C, int L, int which) {
    const float* ng = (const float*)a->in[5]; const float* mod = (const float*)(C.ws + WS_MOD);
    const half_t* Y = (const half_t*)(C.ws + WS_Y); half_t* H = (half_t*)(C.ws + WS_H);
    const float* xin = (L == 0 && which == 0) ? (const float*)a->in[0] : (const float*)a->out; float* xout = (float*)a->out;
    const float* gy = ng + (size_t)(L * 4 + (which ? 3 : 1)) * D;
    const bool doh = !(which == 1 && L == DEPTH - 1);
    const int Lh = which ? L + 1 : L;
    const float* gh = ng + (size_t)(Lh * 4 + (which ? 0 : 2)) * D;
    for (int row = C.gw; row < M; row += C.ngw) { const int b = row >> 11;
        const float* mg = mod + ((size_t)L * 16 + b) * 6144 + (which ? 5 : 2) * 1024;
        f32x4 y[4], xv[4]; float ss = 0.f;
#pragma unroll
        for (int j = 0; j < 4; ++j) { const int c = 4 * C.lane + 256 * j; const h4 yh = *(const h4*)(Y + (size_t)row * D + c); y[j] = (f32x4){(float)yh[0], (float)yh[1], (float)yh[2], (float)yh[3]};
            xv[j] = *(const f32x4*)(xin + (size_t)row * D + c); ss += (y[j][0] * y[j][0] + y[j][1] * y[j][1]) + (y[j][2] * y[j][2] + y[j][3] * y[j][3]); }
        const float r1 = 1.0f / sqrtf(wave_sum(ss, C.lane) * (1.0f / D) + NORM_EPS);
        float s2 = 0.f;
#pragma unroll
        for (int j = 0; j < 4; ++j) { const int c = 4 * C.lane + 256 * j; const f32x4 g = *(const f32x4*)(gy + c), gt = *(const f32x4*)(mg + c);
            xv[j] = xv[j] + (gt + 1.0f) * (y[j] * r1 * g); *(f32x4*)(xout + (size_t)row * D + c) = xv[j];
            s2 += (xv[j][0] * xv[j][0] + xv[j][1] * xv[j][1]) + (xv[j][2] * xv[j][2] + xv[j][3] * xv[j][3]); }
        if (doh) { const float r2 = 1.0f / sqrtf(wave_sum(s2, C.lane) * (1.0f / D) + NORM_EPS);
            const float* mh = mod + ((size_t)Lh * 16 + b) * 6144 + (which ? 0 : 3) * 1024;
            row_norm_mod(xv, r2, gh, mh, mh + 1024, H + (size_t)row * D, C.lane); }
    }
}

__device__ __forceinline__ void phase_cmp2(ArgsP a, const Ctx& C, int la) {
    const half_t* HC = (const half_t*)(C.ws + WS_HIDC); half_t* KCC = (half_t*)(C.ws + WS_KCC);
    const int r32 = C.lane & 31, hi = C.lane >> 5;
    for (int task = C.gw; task < 512; task += C.ngw) {
        const int R0 = task * 32, which = R0 >> 13;
        const half_t* W2 = (const half_t*)(C.ws + WS_W2T) + (size_t)(la * 2 + which) * 64 * 256;
        const float* b2 = (const float*)a->in[12] + (la * 2 + which) * 64;
        f32x16 acc[2]; acc[0] = (f32x16){}; acc[1] = (f32x16){};
        const half_t* ap = HC + (size_t)(R0 + r32) * 256 + hi * 8;
#pragma unroll 4
        for (int ks = 0; ks < 16; ++ks) {
            const h8 af = *(const h8*)(ap + ks * 16);
            const h8 w0 = *(const h8*)(W2 + (size_t)r32 * 256 + ks * 16 + hi * 8), w1 = *(const h8*)(W2 + (size_t)(32 + r32) * 256 + ks * 16 + hi * 8);
            acc[0] = __builtin_amdgcn_mfma_f32_32x32x16_f16(w0, af, acc[0], 0, 0, 0);
            acc[1] = __builtin_amdgcn_mfma_f32_32x32x16_f16(w1, af, acc[1], 0, 0, 0);
        }
        const int row = R0 + r32; const bool dead = (row & 127) == 127;
#pragma unroll
        for (int ct = 0; ct < 2; ++ct)
#pragma unroll
            for (int rg = 0; rg < 4; ++rg) { const int oc = 32 * ct + 8 * rg + 4 * hi; const f32x4 bb = *(const f32x4*)(b2 + oc);
                f32x4 v = {acc[ct][4 * rg] + bb[0], acc[ct][4 * rg + 1] + bb[1], acc[ct][4 * rg + 2] + bb[2], acc[ct][4 * rg + 3] + bb[3]};
                if (dead) v = (f32x4){0.f, 0.f, 0.f, 0.f};
                *(u32x2*)(KCC + (size_t)row * 64 + oc) = pk4(v); }
    }
}

constexpr int AL_K = 0, AL_V = 16384, AL_PSUM = 32768, AL_W = 65536;
__device__ __forceinline__ int crow(int r, int hi) { return (r & 3) + 8 * (r >> 2) + 4 * hi; }
__device__ __forceinline__ void kv_load(const half_t* Kt, const half_t* Vt, int wave, int lane, u32x4& kr, u32x4& vr) {
    kr = *(const u32x4*)(Kt + (size_t)lane * 64 + wave * 8);
    vr = *(const u32x4*)(Vt + (size_t)(16 * (wave & 3) + (lane >> 2)) * 64 + (wave >> 2) * 32 + (lane & 3) * 8);
}
__device__ __forceinline__ void kv_store(LAS unsigned char* Kb, LAS unsigned char* Vb, int wave, int lane, const u32x4 kr, const u32x4 vr) {
    *(LAS u32x4*)(Kb + wave * 1024 + lane * 16) = kr;
    *(LAS u32x4*)(Vb + (wave >> 2) * 4096 + (16 * (wave & 3) + (lane >> 2)) * 64 + (lane & 3) * 16) = vr;
}
__device__ __forceinline__ void qk_tile(f32x16& p0, f32x16& p1, const LAS unsigned char* Kb, const h8 (&qf)[4], int r32, int hi) {
    p0 = (f32x16){}; p1 = (f32x16){};
#pragma unroll
    for (int d0 = 0; d0 < 4; ++d0) {
        const h8 k0 = *(const LAS h8*)(Kb + (2 * d0 + hi) * 1024 + r32 * 16), k1 = *(const LAS h8*)(Kb + (2 * d0 + hi) * 1024 + (32 + r32) * 16);
        p0 = __builtin_amdgcn_mfma_f32_32x32x16_f16(k0, qf[d0], p0, 0, 0, 0);
        p1 = __builtin_amdgcn_mfma_f32_32x32x16_f16(k1, qf[d0], p1, 0, 0, 0);
    }
}
__device__ __forceinline__ s16x4 tr_read(const LAS unsigned char* p) { return __builtin_amdgcn_ds_read_tr16_b64_v4i16((LAS s16x4*)p); }
__device__ __forceinline__ h8 p8(const f32x16& p, int base) {
    return (h8){(half_t)p[base], (half_t)p[base + 1], (half_t)p[base + 2], (half_t)p[base + 3], (half_t)p[base + 4], (half_t)p[base + 5], (half_t)p[base + 6], (half_t)p[base + 7]};
}
__device__ __forceinline__ void pv_tile(f32x16 (&o)[2], const LAS unsigned char* Vb, const f32x16& p0, const f32x16& p1, int lane) {
    const int hi = lane >> 5;
    const LAS unsigned char* va = Vb + ((lane >> 4) & 1) * 32 + (lane & 3) * 8 + (4 * hi + ((lane & 15) >> 2)) * 64;
    h8 pf[4]; pf[0] = p8(p0, 0); pf[1] = p8(p0, 8); pf[2] = p8(p1, 0); pf[3] = p8(p1, 8);
#pragma unroll
    for (int dh = 0; dh < 2; ++dh)
#pragma unroll
        for (int s = 0; s < 4; ++s) {
            const s16x4 lo = tr_read(va + dh * 4096 + s * 1024), hh = tr_read(va + dh * 4096 + s * 1024 + 512);
            typedef short s16x8 __attribute__((ext_vector_type(8)));
            const s16x8 t8 = {lo[0], lo[1], lo[2], lo[3], hh[0], hh[1], hh[2], hh[3]};
            const h8 vf = __builtin_bit_cast(h8, t8);
            o[dh] = __builtin_amdgcn_mfma_f32_32x32x16_f16(vf, pf[s], o[dh], 0, 0, 0);
        }
}
__device__ __forceinline__ float max16(const f32x16& p) {
    float a = fmaxf(fmaxf(p[0], p[1]), fmaxf(p[2], p[3])), b = fmaxf(fmaxf(p[4], p[5]), fmaxf(p[6], p[7]));
    float c = fmaxf(fmaxf(p[8], p[9]), fmaxf(p[10], p[11])), d = fmaxf(fmaxf(p[12], p[13]), fmaxf(p[14], p[15]));
    return fmaxf(fmaxf(a, b), fmaxf(c, d));
}
__device__ __forceinline__ float sum16(const f32x16& p) {
    return (((p[0] + p[1]) + (p[2] + p[3])) + ((p[4] + p[5]) + (p[6] + p[7]))) + (((p[8] + p[9]) + (p[10] + p[11])) + ((p[12] + p[13]) + (p[14] + p[15])));
}

enum { MODE_WIN = 0, MODE_SEL = 1, MODE_SWA = 2 };
template <int MODE>
__device__ __forceinline__ void attn_unit(const Ctx& C, int b, int hkv, int chunk, const half_t* Q, const half_t* Kh, const half_t* Vh,
                                          const unsigned* selm, const float* Gt, float* Oacc, half_t* O, const float* sinks) {
    constexpr int GH = (MODE == MODE_SWA) ? 8 : 4, TPW = 32 / GH, TPB = 8 * TPW, WIN = (MODE == MODE_SWA) ? 128 : 512;
    const int lane = C.lane, wave = C.wave, r32 = lane & 31, hi = lane >> 5;
    const int t0 = chunk * TPB, tw0 = t0 + wave * TPW, tok = tw0 + r32 / GH, head = hkv * GH + (r32 % GH);
    const size_t gtok = (size_t)b * S + tok;
    LAS unsigned char* lds = C.lds;
    h8 qf[4];
#pragma unroll
    for (int d0 = 0; d0 < 4; ++d0) qf[d0] = *(const h8*)(Q + gtok * D + head * 64 + d0 * 16 + hi * 8);
    const int jlast = (t0 + TPB - 1) >> 6;
    unsigned tiles, msk = 0u, wneed = 0u;
    if (MODE == MODE_SEL) {
        msk = selm[tok]; unsigned x = msk;
#pragma unroll
        for (int o = 1; o < 64; o <<= 1) x |= (unsigned)shxi((int)x, o, lane);
        wneed = (unsigned)__builtin_amdgcn_readfirstlane((int)x);
        LAS unsigned* bw = (LAS unsigned*)(lds + AL_W);
        if (C.tid == 0) bw[0] = 0u;
        __syncthreads();
        if (lane == 0) __hip_atomic_fetch_or(bw, wneed, __ATOMIC_RELAXED, __HIP_MEMORY_SCOPE_WORKGROUP);
        __syncthreads();
        tiles = bw[0];
        tiles = (unsigned)__builtin_amdgcn_readfirstlane((int)tiles);
    } else {
        const int kfirst = t0 - WIN + 1, jlo = (kfirst > 0 ? kfirst : 0) >> 6;
        tiles = (jlast >= 31 ? 0xffffffffu : ((1u << (jlast + 1)) - 1u)) & ~((1u << jlo) - 1u);
    }
    float m = NEG_BIG, l = 0.f; f32x16 o[2]; o[0] = (f32x16){}; o[1] = (f32x16){};
    u32x4 kr, vr; int buf = 0;
    unsigned tm = tiles;
    { const int j = __builtin_ctz(tm); kv_load(Kh + (size_t)j * 4096, Vh + (size_t)j * 4096, wave, lane, kr, vr); kv_store(lds + AL_K, lds + AL_V, wave, lane, kr, vr); }
    __syncthreads();
    while (tm) {
        const int j = __builtin_ctz(tm); tm &= tm - 1u;
        const bool more = tm != 0u;
        if (more) { const int jn = __builtin_ctz(tm); kv_load(Kh + (size_t)jn * 4096, Vh + (size_t)jn * 4096, wave, lane, kr, vr); }
        bool need;
        if (MODE == MODE_SEL) need = (wneed >> j) & 1u;
        else need = (64 * j <= tw0 + TPW - 1) && (64 * j + 63 >= tw0 - WIN + 1);
        if (need) {
            f32x16 p0, p1; qk_tile(p0, p1, lds + AL_K + buf * 8192, qf, r32, hi);
            const bool rowok = (MODE == MODE_SEL) ? (((msk >> j) & 1u) != 0u) : true;
            float tmax = NEG_BIG;
#pragma unroll
            for (int r = 0; r < 16; ++r) { const int k0 = 64 * j + crow(r, hi), k1 = k0 + 32;
                const bool v0 = rowok && (k0 <= tok) && (MODE == MODE_SEL || k0 > tok - WIN), v1 = rowok && (k1 <= tok) && (MODE == MODE_SEL || k1 > tok - WIN);
                p0[r] = v0 ? p0[r] : NEG_BIG; p1[r] = v1 ? p1[r] : NEG_BIG; tmax = fmaxf(tmax, fmaxf(p0[r], p1[r])); }
            tmax = fmaxf(tmax, shx(tmax, 32, lane));
            const float mn = fmaxf(m, tmax), alpha = fast_exp2(m - mn);
            m = mn;
#pragma unroll
            for (int r = 0; r < 16; ++r) { p0[r] = (p0[r] > -1.0e29f) ? fast_exp2(p0[r] - mn) : 0.f; p1[r] = (p1[r] > -1.0e29f) ? fast_exp2(p1[r] - mn) : 0.f; }
            l = l * alpha + (sum16(p0) + sum16(p1));
#pragma unroll
            for (int r = 0; r < 16; ++r) { o[0][r] *= alpha; o[1][r] *= alpha; }
            pv_tile(o, lds + AL_V + buf * 8192, p0, p1, lane);
        }
        if (more) kv_store(lds + AL_K + (buf ^ 1) * 8192, lds + AL_V + (buf ^ 1) * 8192, wave, lane, kr, vr);
        __syncthreads();
        buf ^= 1;
    }
    float lt = l + shx(l, 32, lane);
    if (MODE == MODE_SWA) lt += fast_exp2(sinks[head] * LOG2E - m);
    float sc = 1.0f / lt;
    if (MODE != MODE_SWA) sc *= Gt[gtok * 48 + head * 3 + (MODE == MODE_SEL ? 1 : 2)];
#pragma unroll
    for (int dh = 0; dh < 2; ++dh)
#pragma unroll
        for (int rg = 0; rg < 4; ++rg) { const size_t off = gtok * D + head * 64 + 32 * dh + 8 * rg + 4 * hi;
            f32x4 v = {o[dh][4 * rg] * sc, o[dh][4 * rg + 1] * sc, o[dh][4 * rg + 2] * sc, o[dh][4 * rg + 3] * sc};
            if (MODE == MODE_SEL) { *(f32x4*)(Oacc + off) = *(const f32x4*)(Oacc + off) + v; }
            else { if (MODE == MODE_WIN) v = v + *(const f32x4*)(Oacc + off); *(u32x2*)(O + off) = pk4(v); } }
}

__device__ __forceinline__ void cmp_unit(const Ctx& C, int b, int hkv, int c, const half_t* Q, const half_t* Kc, const half_t* Vc, const float* Gt, float* Oacc, unsigned* selm) {
    const int lane = C.lane, wave = C.wave, r32 = lane & 31, hi = lane >> 5;
    const int t0 = c * 64, tl = wave * 8 + (r32 >> 2), tok = t0 + tl, head = hkv * 4 + (r32 & 3);
    const size_t gtok = (size_t)b * S + tok;
    LAS unsigned char* lds = C.lds;
    h8 qf[4];
#pragma unroll
    for (int d0 = 0; d0 < 4; ++d0) qf[d0] = *(const h8*)(Q + gtok * D + head * 64 + d0 * 16 + hi * 8);
    { u32x4 kr, vr;
      kv_load(Kc, Vc, wave, lane, kr, vr); kv_store(lds + AL_K, lds + AL_V, wave, lane, kr, vr);
      kv_load(Kc + 4096, Vc + 4096, wave, lane, kr, vr); kv_store(lds + AL_K + 8192, lds + AL_V + 8192, wave, lane, kr, vr); }
    __syncthreads();
    f32x16 p[4];
    qk_tile(p[0], p[1], lds + AL_K, qf, r32, hi); qk_tile(p[2], p[3], lds + AL_K + 8192, qf, r32, hi);
    const int nvis = (tok >= 31) ? ((tok - 31) >> 4) + 1 : 0;
    float mx = NEG_BIG;
#pragma unroll
    for (int q = 0; q < 4; ++q)
#pragma unroll
        for (int r = 0; r < 16; ++r) { const int n = 32 * q + crow(r, hi); p[q][r] = (n < nvis) ? p[q][r] : NEG_BIG; mx = fmaxf(mx, p[q][r]); }
    mx = fmaxf(mx, shx(mx, 32, lane));
    float l = 0.f;
#pragma unroll
    for (int q = 0; q < 4; ++q) {
#pragma unroll
        for (int r = 0; r < 16; ++r) p[q][r] = (p[q][r] > -1.0e29f) ? fast_exp2(p[q][r] - mx) : 0.f;
        l += sum16(p[q]); }
    l += shx(l, 32, lane);
    const float inv = (l > 0.f) ? 1.0f / l : 0.f;
#pragma unroll
    for (int q = 0; q < 4; ++q)
#pragma unroll
        for (int r = 0; r < 16; ++r) p[q][r] *= inv;
    f32x16 o[2]; o[0] = (f32x16){}; o[1] = (f32x16){};
    pv_tile(o, lds + AL_V, p[0], p[1], lane); pv_tile(o, lds + AL_V + 8192, p[2], p[3], lane);
    const float g0 = Gt[gtok * 48 + head * 3 + 0];
#pragma unroll
    for (int dh = 0; dh < 2; ++dh)
#pragma unroll
        for (int rg = 0; rg < 4; ++rg) { const size_t off = gtok * D + head * 64 + 32 * dh + 8 * rg + 4 * hi;
            *(f32x4*)(Oacc + off) = (f32x4){o[dh][4 * rg] * g0, o[dh][4 * rg + 1] * g0, o[dh][4 * rg + 2] * g0, o[dh][4 * rg + 3] * g0}; }
    LAS float* ps = (LAS float*)(lds + AL_PSUM);
#pragma unroll
    for (int q = 0; q < 4; ++q)
#pragma unroll
        for (int rg = 0; rg < 4; ++rg) { f32x4 v = {p[q][4 * rg], p[q][4 * rg + 1], p[q][4 * rg + 2], p[q][4 * rg + 3]};
#pragma unroll
            for (int e = 0; e < 4; ++e) { v[e] += shx(v[e], 1, lane); v[e] += shx(v[e], 2, lane); }
            if ((r32 & 3) == 0) *(LAS f32x4*)(ps + tl * 128 + 32 * q + 8 * rg + 4 * hi) = v; }
    __syncthreads();
#pragma unroll 1
    for (int it = 0; it < 4; ++it) {
        const int tl2 = wave * 8 + 2 * it + hi, j = r32; const LAS float* pr = ps + tl2 * 128 + 4 * j;
        const f32x4 q4 = *(const LAS f32x4*)pr; const float pm1 = (j > 0) ? pr[-1] : 0.f;
        const float imp = pm1 + 2.0f * q4[0] + 2.0f * q4[1] + 2.0f * q4[2] + q4[3];
        const bool forced = (j == 0) || (j == c) || (j == c - 1);
        const float val = forced ? __builtin_inff() : ((j <= c) ? imp : -__builtin_inff());
        int rank = 0;
#pragma unroll 8
        for (int jj = 0; jj < 32; ++jj) { const float vv = shidx(val, (lane & 32) + jj); rank += (vv > val || (vv == val && jj < j)) ? 1 : 0; }
        const bool sel = (rank < 8) && (j <= c);
        const unsigned long long bal = __ballot(sel);
        if (r32 == 0) selm[t0 + tl2] = hi ? (unsigned)(bal >> 32) : (unsigned)bal;
    }
    __syncthreads();
}

constexpr int RG_SLOT = 16384;
constexpr int FL_CMPK = 49152, FL_CMPV = 65536, FL_PSUM = 81920, FL_MASK = 114688, FL_WORD = 114944;
constexpr float ATT_THR = 8.0f, M_INIT = -64.0f;
__device__ __forceinline__ void glds16(const void* gsrc, unsigned lds_dst) { unsigned keep;
    asm volatile("s_mov_b32 %0, m0\n\ts_mov_b32 m0, %2\n\ts_nop 0\n\tglobal_load_lds_dwordx4 %1, off\n\ts_mov_b32 m0, %0" : "=&s"(keep) : "v"(gsrc), "s"(lds_dst) : "memory"); }
#define ATT_WAIT_BAR(N) asm volatile("s_waitcnt vmcnt(" #N ") lgkmcnt(0)\n\ts_barrier" ::: "memory")
__device__ __forceinline__ void dma_tile(const half_t* Kt, const half_t* Vt, unsigned slot, int wave, int lane) {
    glds16(Kt + (size_t)lane * 64 + wave * 8, (unsigned)__builtin_amdgcn_readfirstlane((int)(slot + wave * 1024)));
    glds16(Vt + (size_t)(16 * (wave & 3) + (lane >> 2)) * 64 + (wave >> 2) * 32 + (lane & 3) * 8, (unsigned)__builtin_amdgcn_readfirstlane((int)(slot + 8192 + wave * 1024)));
}
__device__ __forceinline__ float swapmax(float v) { auto rr = __builtin_amdgcn_permlane32_swap(__float_as_uint(v), __float_as_uint(v), false, false); return fmaxf(__uint_as_float(rr[0]), __uint_as_float(rr[1])); }
__device__ __forceinline__ float swapsum(float v) { auto rr = __builtin_amdgcn_permlane32_swap(__float_as_uint(v), __float_as_uint(v), false, false); return __uint_as_float(rr[0]) + __uint_as_float(rr[1]); }

__device__ __forceinline__ void tile_step(const bool BOUNDARY, float& m, float& l, f32x16 (&o)[2], const h8 (&qf)[4], const LAS unsigned char* Kb, const LAS unsigned char* Vb,
                                          float rowbias, int kbase, int tok, int win, int lane) {
    const int r32 = lane & 31, hi = lane >> 5;
    const float ci = rowbias - m;
    f32x16 p0, p1;
#pragma unroll
    for (int r = 0; r < 16; ++r) { p0[r] = ci; p1[r] = ci; }
#pragma unroll
    for (int d0 = 0; d0 < 4; ++d0) {
        const h8 k0 = *(const LAS h8*)(Kb + (2 * d0 + hi) * 1024 + r32 * 16), k1 = *(const LAS h8*)(Kb + (2 * d0 + hi) * 1024 + (32 + r32) * 16);
        p0 = __builtin_amdgcn_mfma_f32_32x32x16_f16(k0, qf[d0], p0, 0, 0, 0);
        p1 = __builtin_amdgcn_mfma_f32_32x32x16_f16(k1, qf[d0], p1, 0, 0, 0);
    }
    if (BOUNDARY) {
        const int ub = tok - kbase - 4 * hi, lb = ub - win;
#pragma unroll
        for (int r = 0; r < 16; ++r) { const int cr = (r & 3) + 8 * (r >> 2);
            p0[r] = (cr <= ub && cr > lb) ? p0[r] : NEG_BIG; p1[r] = (cr + 32 <= ub && cr + 32 > lb) ? p1[r] : NEG_BIG; }
    }
    const float tmax = swapmax(fmaxf(max16(p0), max16(p1)));
    if (__any(tmax > ATT_THR)) {
        const float dl = fmaxf(tmax, 0.f), f = fast_exp2(-dl);
        m += dl; l *= f;
#pragma unroll
        for (int r = 0; r < 16; ++r) { o[0][r] *= f; o[1][r] *= f; p0[r] -= dl; p1[r] -= dl; }
    }
#pragma unroll
    for (int r = 0; r < 16; ++r) { p0[r] = fast_exp2(p0[r]); p1[r] = fast_exp2(p1[r]); }
    l += sum16(p0) + sum16(p1);
    pv_tile(o, Vb, p0, p1, lane);
}

__device__ __forceinline__ void nsa_unit(const Ctx& C, int b, int hkv, int c, const half_t* Q, const half_t* KV, const half_t* KCC, const float* Gt, half_t* O) {
    const int lane = C.lane, wave = C.wave, r32 = lane & 31, hi = lane >> 5;
    const int bh = b * 4 + hkv, t0 = c * 64, tw0 = t0 + wave * 8, tl = wave * 8 + (r32 >> 2), tok = t0 + tl, head = hkv * 4 + (r32 & 3);
    const size_t gtok = (size_t)b * S + tok;
    LAS unsigned char* lds = C.lds;
    const unsigned ring = (unsigned)(size_t)lds;
    const half_t* Ks = KV + 2 * KVT + (size_t)bh * S * 64; const half_t* Vs = KV + 3 * KVT + (size_t)bh * S * 64;
    const half_t* Kw = KV + 4 * KVT + (size_t)bh * S * 64; const half_t* Vw = KV + 5 * KVT + (size_t)bh * S * 64;
    const int jlo = (c > 8) ? c - 8 : 0, n_win = c - jlo + 1;
    asm volatile("s_waitcnt vmcnt(0)" ::: "memory");
    dma_tile(Kw + (size_t)jlo * 4096, Vw + (size_t)jlo * 4096, ring, wave, lane);
    if (n_win >= 2) dma_tile(Kw + (size_t)(jlo + 1) * 4096, Vw + (size_t)(jlo + 1) * 4096, ring + RG_SLOT, wave, lane);
    h8 qf[4];
#pragma unroll
    for (int d0 = 0; d0 < 4; ++d0) qf[d0] = *(const h8*)(Q + gtok * D + head * 64 + d0 * 16 + hi * 8);
    const float g_cmp = Gt[gtok * 48 + head * 3 + 0], g_sel = Gt[gtok * 48 + head * 3 + 1], g_win = Gt[gtok * 48 + head * 3 + 2];
    f32x16 oc[2];
    {
        const half_t* Kc = KCC + (size_t)bh * 128 * 64; const half_t* Vc = Kc + (size_t)64 * 128 * 64;
        { u32x4 kr, vr;
          kv_load(Kc, Vc, wave, lane, kr, vr); kv_store(lds + FL_CMPK, lds + FL_CMPV, wave, lane, kr, vr);
          kv_load(Kc + 4096, Vc + 4096, wave, lane, kr, vr); kv_store(lds + FL_CMPK + 8192, lds + FL_CMPV + 8192, wave, lane, kr, vr); }
        if (C.tid == 0) ((LAS unsigned*)(lds + FL_WORD))[0] = 0u;
        __syncthreads();
        f32x16 p[4];
        qk_tile(p[0], p[1], lds + FL_CMPK, qf, r32, hi); qk_tile(p[2], p[3], lds + FL_CMPK + 8192, qf, r32, hi);
        const int nvis = ((tok >= 31) ? ((tok - 31) >> 4) + 1 : 0) - 4 * hi;
        float mx = NEG_BIG;
#pragma unroll
        for (int q = 0; q < 4; ++q)
#pragma unroll
            for (int r = 0; r < 16; ++r) { const int cn = 32 * q + (r & 3) + 8 * (r >> 2); p[q][r] = (cn < nvis) ? p[q][r] : NEG_BIG; mx = fmaxf(mx, p[q][r]); }
        mx = swapmax(mx);
        float l = 0.f;
#pragma unroll
        for (int q = 0; q < 4; ++q) {
#pragma unroll
            for (int r = 0; r < 16; ++r) p[q][r] = (p[q][r] > -1.0e29f) ? fast_exp2(p[q][r] - mx) : 0.f;
            l += sum16(p[q]); }
        l = swapsum(l);
        const float inv = (l > 0.f) ? 1.0f / l : 0.f;
#pragma unroll
        for (int q = 0; q < 4; ++q)
#pragma unroll
            for (int r = 0; r < 16; ++r) p[q][r] *= inv;
        oc[0] = (f32x16){}; oc[1] = (f32x16){};
        pv_tile(oc, lds + FL_CMPV, p[0], p[1], lane); pv_tile(oc, lds + FL_CMPV + 8192, p[2], p[3], lane);
#pragma unroll
        for (int r = 0; r < 16; ++r) { oc[0][r] *= g_cmp; oc[1][r] *= g_cmp; }
        LAS float* ps = (LAS float*)(lds + FL_PSUM);
#pragma unroll
        for (int q = 0; q < 4; ++q)
#pragma unroll
            for (int rg = 0; rg < 4; ++rg) { f32x4 v = {p[q][4 * rg], p[q][4 * rg + 1], p[q][4 * rg + 2], p[q][4 * rg + 3]};
#pragma unroll
                for (int e = 0; e < 4; ++e) { v[e] += shx(v[e], 1, lane); v[e] += shx(v[e], 2, lane); }
                if ((r32 & 3) == 0) *(LAS f32x4*)(ps + tl * 128 + 32 * q + 8 * rg + 4 * hi) = v; }
        __syncthreads();
        LAS unsigned* mk = (LAS unsigned*)(lds + FL_MASK); unsigned wor = 0u;
#pragma unroll 1
        for (int it = 0; it < 4; ++it) {
            const int tl2 = wave * 8 + 2 * it + hi, j = r32; const LAS float* pr = ps + tl2 * 128 + 4 * j;
            const f32x4 q4 = *(const LAS f32x4*)pr; const float pm1 = (j > 0) ? pr[-1] : 0.f;
            const float imp = pm1 + 2.0f * q4[0] + 2.0f * q4[1] + 2.0f * q4[2] + q4[3];
            const bool forced = (j == 0) || (j == c) || (j == c - 1);
            const float val = forced ? __builtin_inff() : ((j <= c) ? imp : -__builtin_inff());
            int rank = 0;
#pragma unroll 8
            for (int jj = 0; jj < 32; ++jj) { const float vv = shidx(val, (lane & 32) + jj); rank += (vv > val || (vv == val && jj < j)) ? 1 : 0; }
            const bool sel = (rank < 8) && (j <= c);
            const unsigned long long bal = __ballot(sel);
            const unsigned mine = hi ? (unsigned)(bal >> 32) : (unsigned)bal;
            if (r32 == 0) mk[tl2] = mine;
            wor |= (unsigned)bal | (unsigned)(bal >> 32);
        }
        if (lane == 0) __hip_atomic_fetch_or((LAS unsigned*)(lds + FL_WORD), wor, __ATOMIC_RELAXED, __HIP_MEMORY_SCOPE_WORKGROUP);
        __syncthreads();
    }
    const unsigned msk = ((const LAS unsigned*)(lds + FL_MASK))[tl];
    unsigned wneed = msk;
#pragma unroll
    for (int o_ = 1; o_ < 64; o_ <<= 1) wneed |= (unsigned)shxi((int)wneed, o_, lane);
    wneed = (unsigned)__builtin_amdgcn_readfirstlane((int)wneed);
    const unsigned bneed = (unsigned)__builtin_amdgcn_readfirstlane((int)((const LAS unsigned*)(lds + FL_WORD))[0]);
    const int n_tot = n_win + __builtin_popcount(bneed);
    unsigned dbits = bneed, cbits = bneed;
    if (n_win < 2 && n_tot >= 2) { const int j = __builtin_ctz(dbits); dbits &= dbits - 1u; dma_tile(Ks + (size_t)j * 4096, Vs + (size_t)j * 4096, ring + RG_SLOT, wave, lane); }
    float m = M_INIT, l = 0.f; f32x16 o[2]; o[0] = (f32x16){}; o[1] = (f32x16){};
    int slot_c = 0, slot_d = 2;
#pragma unroll 1
    for (int e = 0; e < n_tot; ++e) {
        if (e + 1 < n_tot) ATT_WAIT_BAR(2); else ATT_WAIT_BAR(0);
        if (e + 2 < n_tot) {
            if (e + 2 < n_win) { const int j = jlo + e + 2; dma_tile(Kw + (size_t)j * 4096, Vw + (size_t)j * 4096, ring + slot_d * RG_SLOT, wave, lane); }
            else { const int j = __builtin_ctz(dbits); dbits &= dbits - 1u; dma_tile(Ks + (size_t)j * 4096, Vs + (size_t)j * 4096, ring + slot_d * RG_SLOT, wave, lane); }
        }
        const LAS unsigned char* Kb = lds + slot_c * RG_SLOT; const LAS unsigned char* Vb = Kb + 8192;
        const bool is_win = e < n_win;
        int j; bool need, bnd; float rb = 0.f; int win = 512;
        if (is_win) { j = jlo + e; need = (64 * j <= tw0 + 7) && (64 * j + 63 >= tw0 - 511); bnd = (64 * j + 63 > tw0) || (64 * j <= tw0 + 7 - 512); }
        else { j = __builtin_ctz(cbits); cbits &= cbits - 1u; need = (wneed >> j) & 1u; bnd = (j == c); rb = ((msk >> j) & 1u) ? 0.f : NEG_BIG; win = 1 << 20; }
        if (need) {
            tile_step(bnd, m, l, o, qf, Kb, Vb, rb, 64 * j, tok, win, lane);
        }
        if (e == n_win - 1) {
            const float sc = g_win / swapsum(l);
#pragma unroll
            for (int r = 0; r < 16; ++r) { oc[0][r] += o[0][r] * sc; oc[1][r] += o[1][r] * sc; o[0][r] = 0.f; o[1][r] = 0.f; }
            m = M_INIT; l = 0.f;
        }
        slot_c = (slot_c == 2) ? 0 : slot_c + 1; slot_d = (slot_d == 2) ? 0 : slot_d + 1;
    }
    {
        const float sc = g_sel / swapsum(l);
#pragma unroll
        for (int dh = 0; dh < 2; ++dh)
#pragma unroll
            for (int rg = 0; rg < 4; ++rg) { const size_t off = gtok * D + head * 64 + 32 * dh + 8 * rg + 4 * hi;
                const f32x4 v = {oc[dh][4 * rg] + o[dh][4 * rg] * sc, oc[dh][4 * rg + 1] + o[dh][4 * rg + 1] * sc, oc[dh][4 * rg + 2] + o[dh][4 * rg + 2] * sc, oc[dh][4 * rg + 3] + o[dh][4 * rg + 3] * sc};
                *(u32x2*)(O + off) = pk4(v); }
    }
    asm volatile("s_waitcnt lgkmcnt(0)\n\ts_barrier" ::: "memory");
}

__device__ __forceinline__ void swa_unit(const Ctx& C, int b, int hkv, int cc, const half_t* Q, const half_t* Kh, const half_t* Vh, const float* sinks, half_t* O) {
    const int lane = C.lane, wave = C.wave, r32 = lane & 31, hi = lane >> 5;
    const int t0 = cc * 32, tw0 = t0 + 4 * wave, tok = tw0 + (r32 >> 3), head = hkv * 8 + (r32 & 7);
    const size_t gtok = (size_t)b * S + tok;
    LAS unsigned char* lds = C.lds; const unsigned ring = (unsigned)(size_t)lds;
    const int jhi = (t0 + 31) >> 6, jlo = ((t0 > 127) ? (t0 - 127) : 0) >> 6, n_tot = jhi - jlo + 1;
    asm volatile("s_waitcnt vmcnt(0)" ::: "memory");
    dma_tile(Kh + (size_t)jlo * 4096, Vh + (size_t)jlo * 4096, ring, wave, lane);
    if (n_tot >= 2) dma_tile(Kh + (size_t)(jlo + 1) * 4096, Vh + (size_t)(jlo + 1) * 4096, ring + RG_SLOT, wave, lane);
    h8 qf[4];
#pragma unroll
    for (int d0 = 0; d0 < 4; ++d0) qf[d0] = *(const h8*)(Q + gtok * D + head * 64 + d0 * 16 + hi * 8);
    float m = M_INIT, l = 0.f; f32x16 o[2]; o[0] = (f32x16){}; o[1] = (f32x16){};
    const float sk = sinks[head] * LOG2E;
#pragma unroll 1
    for (int e = 0; e < n_tot; ++e) {
        if (e + 1 < n_tot) ATT_WAIT_BAR(2); else ATT_WAIT_BAR(0);
        if (e + 2 < n_tot) dma_tile(Kh + (size_t)(jlo + 2) * 4096, Vh + (size_t)(jlo + 2) * 4096, ring + 2 * RG_SLOT, wave, lane);
        const int jt = jlo + e;
        const LAS unsigned char* Kb = lds + e * RG_SLOT; const LAS unsigned char* Vb = Kb + 8192;
        const bool need = (64 * jt <= tw0 + 3) && (64 * jt + 63 >= tw0 - 127);
        if (need) {
            const bool bnd = (64 * jt + 63 > tw0) || (64 * jt <= tw0 + 3 - 128);
            tile_step(bnd, m, l, o, qf, Kb, Vb, 0.f, 64 * jt, tok, 128, lane);
        }
    }
    const float sc = 1.0f / (swapsum(l) + fast_exp2(sk - m));
#pragma unroll
    for (int dh = 0; dh < 2; ++dh)
#pragma unroll
        for (int rg = 0; rg < 4; ++rg) { const size_t off = gtok * D + head * 64 + 32 * dh + 8 * rg + 4 * hi;
            const f32x4 v = {o[dh][4 * rg] * sc, o[dh][4 * rg + 1] * sc, o[dh][4 * rg + 2] * sc, o[dh][4 * rg + 3] * sc};
            *(u32x2*)(O + off) = pk4(v); }
    asm volatile("s_waitcnt lgkmcnt(0)\n\ts_barrier" ::: "memory");
}

#ifndef EN_PRO
#define EN_PRO 1
#endif
#ifndef EN_ROW
#define EN_ROW 1
#endif
#ifndef EN_INPROJ
#define EN_INPROJ 1
#endif
#ifndef EN_CMP1
#define EN_CMP1 1
#endif
#ifndef EN_CMP2
#define EN_CMP2 1
#endif
#ifndef EN_CMPATT
#define EN_CMPATT 1
#endif
#ifndef EN_SEL
#define EN_SEL 1
#endif
#ifndef EN_WIN
#define EN_WIN 1
#endif
#ifndef EN_SWA
#define EN_SWA 1
#endif
#ifndef EN_OUT
#define EN_OUT 1
#endif
#ifndef EN_UP
#define EN_UP 1
#endif
#ifndef EN_DOWN
#define EN_DOWN 1
#endif
constexpr int NPHASE = 3 + 11 * DEPTH;
__host__ __device__ constexpr bool phase_exists(int p) { return p < 3 ? true : (((p - 3) / 11) % 2 == 0 ? !(((p - 3) % 11) == 4 || ((p - 3) % 11) == 5) : !(((p - 3) % 11) >= 1 && ((p - 3) % 11) <= 4)); }

__global__ void __launch_bounds__(512, 2) mk_fwd(Args a) {
    extern __shared__ __attribute__((aligned(16))) unsigned char lds_raw[];
    Ctx C;
    C.lds = (LAS unsigned char*)lds_raw;
    const int wave0 = __builtin_amdgcn_readfirstlane((int)(threadIdx.x >> 6));
    C.lane = (int)__builtin_amdgcn_mbcnt_hi(~0u, __builtin_amdgcn_mbcnt_lo(~0u, 0u)); C.wave = wave0; C.tid = wave0 * 64 + C.lane;
    C.G = gridDim.x; C.gw = blockIdx.x * 8 + C.wave; C.ngw = C.G * 8; C.ws = (unsigned char*)a.ws;
    GAS unsigned char* ws = a.ws;
    for (int u = C.tid; u < (LDS_BYTES - LDSCTL_OFF) / 4; u += 512) ((LAS unsigned*)(C.lds + LDSCTL_OFF))[u] = 0u;
    __syncthreads();
#if MK_ONE_LAUNCH
    XcdBarrier bar = xcd_barrier_post((unsigned*)(ws + WS_CTL) + CW_BAR, (volatile LAS unsigned*)(C.lds + MISC_OFF) + 8);
#define SEAM() xcd_barrier(bar)
#else
#define SEAM() do { } while (0)
#endif
    const int lo = a.ph_lo, hi = a.ph_hi;
#define RUN(p) (lo <= (p) && (p) < hi)
#define FRESH() Ctx Cp = C; ArgsP ap = (ArgsP)__builtin_amdgcn_kernarg_segment_ptr(); { int w_ = wave0; asm volatile("" : "+s"(w_), "+s"(ap)); int l_; asm volatile("v_mbcnt_lo_u32_b32 %0, -1, 0\n\tv_mbcnt_hi_u32_b32 %0, -1, %0" : "=v"(l_)); Cp.tid = w_ * 64 + l_; Cp.lane = l_; Cp.wave = w_; Cp.gw = blockIdx.x * 8 + w_; } GAS unsigned char* const wsx = ap->ws; Cp.ws = (unsigned char*)wsx; (void)wsx;
#define Hb ((half_t*)(wsx + WS_H))
#define Yb ((half_t*)(wsx + WS_Y))
#define Qb ((half_t*)(wsx + WS_Q))
#define KVb ((half_t*)(wsx + WS_KV))
#define Ob ((half_t*)(wsx + WS_O))
#define Gb ((float*)(wsx + WS_G))
#define HIDb ((half_t*)(wsx + WS_BIG))
#define ropeb ((const float*)(wsx + WS_ROPE))

    if (EN_PRO && RUN(0)) { FRESH(); phase_prologue(ap, Cp); SEAM(); }
    if (EN_PRO && RUN(1)) { FRESH(); phase_modfinal(ap, Cp); SEAM(); }
    if (EN_ROW && RUN(2)) { FRESH(); phase_row_first(ap, Cp); SEAM(); }

#pragma unroll 1
    for (int L = 0; L < DEPTH; ++L) {
        const int pb = 3 + 11 * L, la = L >> 1; const bool nsa = (L & 1) == 0;
        if (EN_INPROJ && RUN(pb + 0)) { FRESH();
            if (nsa) { pg8::Gemm g{Hb, (const half_t*)(wsx + WS_WINN) + (size_t)la * NSA_INP * D, M, NSA_INP, D, D}; pg8::StaticOrder So; So.init(M, NSA_INP, C.G, (int)blockIdx.x);
                pg8::EpiNsaIn E{Qb, KVb, Gb, ropeb};
                pg8::gemm_phase<pg8::EpiNsaIn, pg8::StaticOrder, true, true>(C.lds, g, So, E, Cp.tid);
            } else { pg8::Gemm g{Hb, (const half_t*)(wsx + WS_WINS) + (size_t)la * SWA_IN * D, M, SWA_IN, D, D}; pg8::StaticOrder So; So.init(M, SWA_IN, C.G, (int)blockIdx.x);
                pg8::EpiSwaIn E{Qb, KVb, ropeb};
                pg8::gemm_phase<pg8::EpiSwaIn, pg8::StaticOrder, true, true>(C.lds, g, So, E, Cp.tid);
            }
            SEAM();
        }
        if (nsa) {
            if (EN_CMP1 && RUN(pb + 1)) { FRESH();
                pg8::Gemm g{KVb, (const half_t*)(wsx + WS_W1T) + (size_t)la * 512 * 2048, 16384, 512, 2048, 1024}; pg8::CmpOrder So{C.G, (int)blockIdx.x};
                pg8::EpiF16<2> E{(half_t*)(wsx + WS_HIDC), 256, (const float*)(wsx + WS_B1F) + la * 512};
                pg8::gemm_phase<pg8::EpiF16<2>, pg8::CmpOrder, true, true>(C.lds, g, So, E, Cp.tid);
                SEAM();
            }
            if (EN_CMP2 && RUN(pb + 2)) { FRESH(); phase_cmp2(ap, Cp, la); SEAM(); }
            if (EN_CMPATT && RUN(pb + 3)) { FRESH();
                for (int u = blockIdx.x; u < NB * 4 * 32; u += C.G) { const int k = u & 255, i = u >> 8, bh = k >> 2, s_ = k & 3, a_ = 3 - (i >> 1), c = (i & 1) ? (8 * a_ + s_) : (8 * a_ + 7 - s_);
                    nsa_unit(Cp, bh >> 2, bh & 3, c, Qb, KVb, (const half_t*)(wsx + WS_KCC), Gb, Ob); }
                SEAM();
            }
        } else {
            if (EN_SWA && RUN(pb + 5)) { FRESH();
                const float* sinks = (const float*)ap->in[15] + la * 16;
                for (int u = blockIdx.x; u < NB * 2 * 64; u += C.G) { const int j = 63 - (u & 63), bh = u >> 6;
                    swa_unit(Cp, bh >> 1, bh & 1, j, Qb, KVb + (size_t)bh * S * 64, KVb + (size_t)M * 128 + (size_t)bh * S * 64, sinks, Ob); }
                SEAM();
            }
        }
        if (EN_OUT && RUN(pb + 6)) { FRESH();
            pg8::Gemm g{Ob, (const half_t*)(wsx + WS_WOUT) + (size_t)L * D * D, M, D, D, D}; pg8::StaticOrder So; So.init(M, D, C.G, (int)blockIdx.x);
            pg8::EpiF16<0> E{Yb, D, nullptr};
            pg8::gemm_phase<pg8::EpiF16<0>, pg8::StaticOrder, true, true>(C.lds, g, So, E, Cp.tid);
            SEAM();
        }
        if (EN_ROW && RUN(pb + 7)) { FRESH(); phase_row_update(ap, Cp, L, 0); SEAM(); }
        if (EN_UP && RUN(pb + 8)) { FRESH();
            pg8::Gemm g{Hb, (const half_t*)(wsx + WS_WUP) + (size_t)L * FF * D, M, FF, D, D}; pg8::StaticOrder So; So.init(M, FF, C.G, (int)blockIdx.x);
            pg8::EpiF16<1> E{HIDb, FF, nullptr};
            pg8::gemm_phase<pg8::EpiF16<1>, pg8::StaticOrder, true, true>(C.lds, g, So, E, Cp.tid);
            SEAM();
        }
        if (EN_DOWN && RUN(pb + 9)) { FRESH();
            pg8::Gemm g{HIDb, (const half_t*)(wsx + WS_WDN) + (size_t)L * D * FF, M, D, FF, FF}; pg8::StaticOrder So; So.init(M, D, C.G, (int)blockIdx.x);
            pg8::EpiF16<0> E{Yb, D, nullptr};
            pg8::gemm_phase<pg8::EpiF16<0>, pg8::StaticOrder, true, true>(C.lds, g, So, E, Cp.tid);
            SEAM();
        }
        if (EN_ROW && RUN(pb + 10)) { FRESH(); phase_row_update(ap, Cp, L, 1); if (L + 1 < DEPTH) SEAM(); }
    }
#undef RUN
#undef Hb
#undef Yb
#undef Qb
#undef KVb
#undef Ob
#undef Gb
#undef HIDb
#undef ropeb
#undef SEAM
}

extern "C" void kernel_launch(void* const* d_in, const int* in_sizes, int n_in, void* d_out, int out_size, void* d_ws, size_t ws_size, hipStream_t stream) {
    static int grid = 0;
    if (grid == 0) {
        if (n_in != 18 || in_sizes[0] != M * D || out_size != M * D || ws_size < WS_END) {
            fprintf(stderr, "kernel_launch: built for 18 inputs, x/out of %d floats, >= %zu bytes of workspace; got n_in %d, in0 %d, out %d, ws %zu; nothing launched\n", M * D, (size_t)WS_END, n_in, n_in > 0 ? in_sizes[0] : -1, out_size, ws_size);
            grid = -1; return; }
        int dev = 0, cus = 0, per_cu = 0;
        if (hipGetDevice(&dev) != hipSuccess || hipDeviceGetAttribute(&cus, hipDeviceAttributeMultiprocessorCount, dev) != hipSuccess) { fprintf(stderr, "kernel_launch: device query failed\n"); grid = -1; return; }
        if (hipFuncSetAttribute((const void*)mk_fwd, hipFuncAttributeMaxDynamicSharedMemorySize, LDS_BYTES) != hipSuccess) { fprintf(stderr, "kernel_launch: hipFuncSetAttribute failed\n"); grid = -1; return; }
        if (hipOccupancyMaxActiveBlocksPerMultiprocessor(&per_cu, (const void*)mk_fwd, 512, LDS_BYTES) != hipSuccess || per_cu < 1)
            fprintf(stderr, "kernel_launch: note: occupancy query reports %d workgroups per CU\n", per_cu);
        (void)hipGetLastError();
        grid = cus;
    }
    if (grid < 0) return;
    if (hipMemsetAsync((char*)d_ws + WS_CTL, 0, CTL_ZERO_BYTES, stream) != hipSuccess) { fprintf(stderr, "kernel_launch: memset failed\n"); return; }
    Args a{};
    for (int i = 0; i < 18; ++i) a.in[i] = (const GAS void*)d_in[i];
    a.out = (GAS float*)d_out; a.ws = (GAS unsigned char*)d_ws;
#if MK_ONE_LAUNCH
    a.ph_lo = 0; a.ph_hi = NPHASE;
    hipLaunchKernelGGL(mk_fwd, dim3(grid), dim3(512), LDS_BYTES, stream, a);
#else
    for (int p = 0; p < NPHASE; ++p) { if (!phase_exists(p)) continue;
        a.ph_lo = p; a.ph_hi = p + 1;
        hipLaunchKernelGGL(mk_fwd, dim3(grid), dim3(512), LDS_BYTES, stream, a); }
#endif
    const hipError_t le = hipPeekAtLastError();
    if (le != hipSuccess) fprintf(stderr, "kernel_launch: launch failed: %s\n", hipGetErrorName(le));
}
```

```cpp
#include <hip/hip_runtime.h>
#include <cstdio>
#include <cstdint>

#ifndef MK_ONE_LAUNCH
#define MK_ONE_LAUNCH 1
#endif

#define LAS __attribute__((address_space(3)))
#define GAS __attribute__((address_space(1)))
typedef _Float16 half_t;
typedef _Float16 h8 __attribute__((ext_vector_type(8)));
typedef _Float16 h4 __attribute__((ext_vector_type(4)));
typedef _Float16 h2 __attribute__((ext_vector_type(2)));
typedef float f32x2 __attribute__((ext_vector_type(2)));
typedef float f32x4 __attribute__((ext_vector_type(4)));
typedef float f32x16 __attribute__((ext_vector_type(16)));
typedef unsigned u32x2 __attribute__((ext_vector_type(2)));
typedef unsigned u32x4 __attribute__((ext_vector_type(4)));
typedef short s16x4 __attribute__((ext_vector_type(4)));

constexpr int D = 1024, NB = 16, S = 2048, M = NB * S, DEPTH = 4, HD = 64, FF = 4096;
constexpr int NSA_IN = 2608, NSA_INP = 2816, SWA_IN = 1280;
constexpr int NCMP = 127;
constexpr float NORM_EPS = 1e-6f;
constexpr float LOG2E = 1.4426950408889634f;
constexpr float C2 = 0.125f * LOG2E;
constexpr float NEG_BIG = -1.0e30f;

constexpr size_t MiB = 1u << 20;
constexpr size_t WS_CTL = 0, CTL_ZERO_BYTES = 1 * MiB;
constexpr size_t WS_MOD  = 1 * MiB;
constexpr size_t WS_B1F  = 3 * MiB;
constexpr size_t WS_W2T  = 3 * MiB + 65536;
constexpr size_t WS_B1P  = 3 * MiB + 262144;
constexpr size_t WS_ROPE = 4 * MiB;
constexpr size_t WS_PART = 12 * MiB;
constexpr size_t WS_WINN = 24 * MiB;
constexpr size_t WS_WINS = 36 * MiB;
constexpr size_t WS_WOUT = 41 * MiB;
constexpr size_t WS_W1T  = 49 * MiB;
constexpr size_t WS_WUP  = 53 * MiB;
constexpr size_t WS_WDN  = 85 * MiB;
constexpr size_t WS_Y    = 117 * MiB;
constexpr size_t WS_H    = 181 * MiB;
constexpr size_t WS_OACC = 117 * MiB;
constexpr size_t WS_BIG  = 245 * MiB;
constexpr size_t WS_Q    = 245 * MiB;
constexpr size_t WS_KV   = 309 * MiB;
constexpr size_t WS_O    = 405 * MiB;
constexpr size_t WS_G    = 469 * MiB;
constexpr size_t WS_HIDC = 475 * MiB;
constexpr size_t WS_KCC  = 483 * MiB;
constexpr size_t WS_SELM = 485 * MiB;
constexpr size_t WS_END  = 501 * MiB;
constexpr size_t KVT = (size_t)M * 256;

constexpr int CW_BAR = 4096;

constexpr int RING_BYTES = 131072;
constexpr int LDSCTL_OFF = RING_BYTES, MISC_OFF = LDSCTL_OFF + 320;
constexpr int LDS_BYTES = 147456;

__device__ __forceinline__ unsigned pkh2(float lo, float hi) { h2 p = {(half_t)lo, (half_t)hi}; return __builtin_bit_cast(unsigned, p); }
__device__ __forceinline__ u32x2 pk4(const f32x4 v) { u32x2 w; w.x = pkh2(v[0], v[1]); w.y = pkh2(v[2], v[3]); return w; }
__device__ __forceinline__ float fast_exp2(float x) { return __builtin_amdgcn_exp2f(x); }
__device__ __forceinline__ float fast_rcp(float x) { return __builtin_amdgcn_rcpf(x); }
__device__ __forceinline__ float shx(float v, int o, int lane) { return __builtin_bit_cast(float, __builtin_amdgcn_ds_bpermute((lane ^ o) << 2, __builtin_bit_cast(int, v))); }
__device__ __forceinline__ int shxi(int v, int o, int lane) { return __builtin_amdgcn_ds_bpermute((lane ^ o) << 2, v); }
__device__ __forceinline__ float shidx(float v, int src) { return __builtin_bit_cast(float, __builtin_amdgcn_ds_bpermute(src << 2, __builtin_bit_cast(int, v))); }
__device__ __forceinline__ float wave_sum(float v, int lane) {
#pragma unroll
    for (int o = 1; o < 64; o <<= 1) v += shx(v, o, lane);
    return v;
}

namespace pg8 {
#define PG8_LAS __attribute__((address_space(3)))
typedef _Float16 bf16_t;
typedef _Float16 bf16x8 __attribute__((ext_vector_type(8)));
typedef float f32x4 __attribute__((ext_vector_type(4)));
typedef unsigned u32x4 __attribute__((ext_vector_type(4)));
constexpr int BM = 256, BK = 64, HALF = 128, HTB = HALF * BK * 2  , STAGE_BYTES = 8 * HTB, NXCD = 8, WGM = 8;

__host__ __device__ __forceinline__ int lds_byte(int r, int c) { const int st = (r >> 4) * 2 + (c >> 5), rr = r & 15, cc = c & 31, ob = rr * 64 + cc * 2; return st * 1024 + (ob ^ (((ob >> 9) & 1) << 5)); }
__host__ __device__ __forceinline__ void stage_rc(int b, int& R, int& C) { const int st = b / 1024, sb = b % 1024, swz = sb ^ (((sb >> 9) & 1) << 5); R = (st >> 1) * 16 + swz / 64; C = (st & 1) * 32 + (swz % 64) / 2; }
__host__ __device__ __forceinline__ int perm32(int rho) { const int n = rho >> 4, i = rho & 15; return 8 * (i >> 2) + 4 * n + (i & 3); }

struct Unit { int pm, pn; };
struct Gemm { const bf16_t* A; const bf16_t* Bt; int M, N, K, lda; };

struct StaticOrder {
    int nM, nN, nwg, G, c;
    __host__ __device__ void init(int M, int N, int G_, int c_) { nM = M / BM; nN = N / BM; nwg = nM * nN; G = G_; c = c_; }
    __host__ __device__ bool next(int i, Unit& u) const {
        const long L = (long)i * G + c; if (L >= nwg) return false;
        int wgid = (int)L; { const int q = nwg / NXCD, r = nwg % NXCD, xcd = wgid % NXCD, off = wgid / NXCD; wgid = (xcd < r ? xcd * (q + 1) : r * (q + 1) + (xcd - r) * q) + off; }
        const int nig = WGM * nN, gid = wgid / nig, fm = gid * WGM, gsz = (nM - fm) < WGM ? (nM - fm) : WGM;
        u.pm = fm + ((wgid % nig) % gsz); u.pn = (wgid % nig) / gsz; return true;
    }
    __device__ __forceinline__ void a_ready(const Unit&) const {}
    __device__ __forceinline__ void done(const Unit&) const {}
};


struct CmpOrder {
    int G, c;
    __device__ bool next(int i, Unit& u) const { const int L = i * G + c; if (L >= 64) return false; u.pm = L; u.pn = L >> 5; return true; }
    __device__ __forceinline__ void a_ready(const Unit&) const {}
    __device__ __forceinline__ void done(const Unit&) const {}
};

__device__ __forceinline__ u32x4 pack8h(const f32x4 v0, const f32x4 v1) { u32x4 w; w.x = pkh2(v0[0], v0[1]); w.y = pkh2(v0[2], v0[3]); w.z = pkh2(v1[0], v1[1]); w.w = pkh2(v1[2], v1[3]); return w; }
__device__ __forceinline__ float gelu_tanh(float v) {
    const float u2 = 1.5957691216057308f * (v + 0.044715f * v * v * v);
    return v * fast_rcp(1.0f + fast_exp2(-u2 * LOG2E));
}
template <int ACT> struct EpiF16 {
    static constexpr bool PERM = true, AFTER_DRAIN = false;
    half_t* O; int ldc; const float* bias;
    __device__ __forceinline__ void operator()(const f32x4 (&acc)[2][2][4][2], const Unit& u, int wr, int wc, int fr, int fq) const {
        asm volatile("" : "+v"(fr), "+v"(fq));
        const int row0 = u.pm * BM + wr * 64 + fr;
        const int col0 = (ACT == 2 ? 0 : u.pn * BM) + wc * 32 + 8 * fq, bcol0 = u.pn * BM + wc * 32 + 8 * fq;
        f32x4 bv[2][2];
#pragma unroll
        for (int bj = 0; bj < 2; ++bj)
#pragma unroll
            for (int n = 0; n < 2; ++n) bv[bj][n] = (ACT == 2) ? *(const f32x4*)(bias + bcol0 + bj * HALF + 4 * n) : (f32x4){0.f, 0.f, 0.f, 0.f};
#pragma unroll
        for (int ai = 0; ai < 2; ++ai)
#pragma unroll
            for (int m = 0; m < 4; ++m) { half_t* rowp = O + (size_t)(row0 + ai * HALF + m * 16) * ldc + col0;
#pragma unroll
                for (int bj = 0; bj < 2; ++bj) { f32x4 v0 = acc[ai][bj][m][0], v1 = acc[ai][bj][m][1];
                    if (ACT == 1) {
#pragma unroll
                        for (int e = 0; e < 4; ++e) { const float a = fmaxf(v0[e], 0.f), b = fmaxf(v1[e], 0.f); v0[e] = a * a; v1[e] = b * b; } }
                    if (ACT == 2) { v0 = v0 + bv[bj][0]; v1 = v1 + bv[bj][1];
#pragma unroll
                        for (int e = 0; e < 4; ++e) { v0[e] = gelu_tanh(v0[e]); v1[e] = gelu_tanh(v1[e]); } }
                    *(u32x4*)(rowp + bj * HALF) = pack8h(v0, v1); } }
    }
};

__device__ __forceinline__ void rope8(const f32x4 v0, const f32x4 v1, const float* ropetok, int i0, float sc, f32x4& o1, f32x4& o2) {
    const f32x4 c = *(const f32x4*)(ropetok + i0), s = *(const f32x4*)(ropetok + 32 + i0);
    const f32x4 x1 = {v0[0], v0[2], v1[0], v1[2]}, x2 = {v0[1], v0[3], v1[1], v1[3]};
    o1 = (x1 * c - x2 * s) * sc; o2 = (x2 * c + x1 * s) * sc;
}
__device__ __forceinline__ u32x2 pack4h(const f32x4 v) { u32x2 w; w.x = pkh2(v[0], v[1]); w.y = pkh2(v[2], v[3]); return w; }

struct EpiNsaIn {
    static constexpr bool PERM = true, AFTER_DRAIN = false;
    half_t* Q; half_t* KV; float* G; const float* rope;
    __device__ __forceinline__ void operator()(const f32x4 (&acc)[2][2][4][2], const Unit& u, int wr, int wc, int fr, int fq) const {
        asm volatile("" : "+v"(fr), "+v"(fq));
        const int pn = u.pn;
#pragma unroll
        for (int ai = 0; ai < 2; ++ai)
#pragma unroll
            for (int m = 0; m < 4; ++m) {
                const int tok = u.pm * BM + ai * HALF + wr * 64 + m * 16 + fr, b = tok >> 11, s = tok & 2047;
                const float* rt = rope + (size_t)tok * 64;
#pragma unroll
                for (int bj = 0; bj < 2; ++bj) {
                    const int cit = bj * HALF + wc * 32 + 8 * fq, hh = cit >> 6, jj0 = cit & 63;
                    const f32x4 v0 = acc[ai][bj][m][0], v1 = acc[ai][bj][m][1];
                    if (pn < 4) { f32x4 o1, o2; rope8(v0, v1, rt, jj0 >> 1, C2, o1, o2);
                        half_t* p = Q + (size_t)tok * D + pn * 256 + hh * 64 + (jj0 >> 1);
                        *(u32x2*)p = pack4h(o1); *(u32x2*)(p + 32) = pack4h(o2);
                    } else if (pn == 10) {
                        if (cit < 48) { f32x4 g0, g1;
#pragma unroll
                            for (int e = 0; e < 4; ++e) { g0[e] = fast_rcp(1.0f + fast_exp2(-v0[e] * LOG2E)); g1[e] = fast_rcp(1.0f + fast_exp2(-v1[e] * LOG2E)); }
                            float* p = G + (size_t)tok * 48 + cit; *(f32x4*)p = g0; *(f32x4*)(p + 4) = g1; }
                    } else {
                        const int t = pn - 4;
                        half_t* base = KV + (size_t)t * KVT + ((size_t)(b * 4 + hh) * S + s) * 64;
                        if ((t & 1) == 0) { f32x4 o1, o2; rope8(v0, v1, rt, jj0 >> 1, 1.0f, o1, o2);
                            *(u32x2*)(base + (jj0 >> 1)) = pack4h(o1); *(u32x2*)(base + 32 + (jj0 >> 1)) = pack4h(o2);
                        } else *(u32x4*)(base + jj0) = pack8h(v0, v1);
                    }
                }
                asm volatile("" ::: "memory");
            }
    }
};
struct EpiSwaIn {
    static constexpr bool PERM = true, AFTER_DRAIN = false;
    half_t* Q; half_t* KV; const float* rope;
    __device__ __forceinline__ void operator()(const f32x4 (&acc)[2][2][4][2], const Unit& u, int wr, int wc, int fr, int fq) const {
        asm volatile("" : "+v"(fr), "+v"(fq));
        const int pn = u.pn;
#pragma unroll
        for (int ai = 0; ai < 2; ++ai)
#pragma unroll
            for (int m = 0; m < 4; ++m) {
                const int tok = u.pm * BM + ai * HALF + wr * 64 + m * 16 + fr, b = tok >> 11, s = tok & 2047;
                const float* rt = rope + (size_t)tok * 64;
#pragma unroll
                for (int bj = 0; bj < 2; ++bj) {
                    const int cit = bj * HALF + wc * 32 + 8 * fq, hh = cit >> 6, jj0 = cit & 63;
                    const f32x4 v0 = acc[ai][bj][m][0], v1 = acc[ai][bj][m][1];
                    if (pn < 4) { f32x4 o1, o2; rope8(v0, v1, rt, jj0 >> 1, C2, o1, o2);
                        half_t* p = Q + (size_t)tok * D + pn * 256 + hh * 64 + (jj0 >> 1);
                        *(u32x2*)p = pack4h(o1); *(u32x2*)(p + 32) = pack4h(o2);
                    } else if (bj == 0) {
                        half_t* base = KV + ((size_t)(b * 2 + hh) * S + s) * 64;
                        f32x4 o1, o2; rope8(v0, v1, rt, jj0 >> 1, 1.0f, o1, o2);
                        *(u32x2*)(base + (jj0 >> 1)) = pack4h(o1); *(u32x2*)(base + 32 + (jj0 >> 1)) = pack4h(o2);
                    } else {
                        half_t* base = KV + (size_t)M * 128 + ((size_t)(b * 2 + (hh - 2)) * S + s) * 64;
                        *(u32x4*)(base + jj0) = pack8h(v0, v1);
                    }
                }
                asm volatile("" ::: "memory");
            }
    }
};
template <class Epi, class Sched, bool ALIGN_EPI = false, bool SP2 = false>
__device__ __forceinline__ void gemm_phase(PG8_LAS unsigned char* lds, const Gemm g, const Sched& S, const Epi& E, int tid_in) {
    int tid_ = tid_in; asm volatile("" : "+v"(tid_));
    const int tid = tid_, wid = __builtin_amdgcn_readfirstlane(tid >> 6), lane = tid & 63, wr = wid >> 2, wc = wid & 3, fr = lane & 15, fq = lane >> 4;
    const int K = g.K, nt = K / BK;
    unsigned voffA[2], voffB[2];
#pragma unroll
    for (int i = 0; i < 2; ++i) { int R, C; stage_rc(tid * 16 + i * 8192, R, C); const int Rb = Epi::PERM ? ((R & ~31) + perm32(R & 31)) : R;
        voffA[i] = (unsigned)(R * g.lda + C) * 2u; voffB[i] = (unsigned)(Rb * K + C) * 2u; }
    const size_t kstep = (size_t)(BK * 2);
    const size_t hstep = (size_t)HALF * K * 2;
    const size_t tstep = 2 * hstep;
    const size_t hstepA = (size_t)HALF * g.lda * 2, tstepA = 2 * hstepA;
    const unsigned ldsw = (unsigned)wid * 1024u;
    const int aoff = lds_byte(wr * 64 + fr, fq * 8), boff = lds_byte(wc * 32 + fr, fq * 8);
#define PG8_SA(b, h) (((b) * 2 + (h)) * HTB)
#define PG8_SB(b, h) ((4 + (b) * 2 + (h)) * HTB)
#define PG8_STAGE(bufoff, gbase, voff) do { _Pragma("unroll") for (int _i = 0; _i < 2; ++_i) \
        __builtin_amdgcn_global_load_lds((const unsigned*)((const char*)(gbase) + (voff)[_i]), (PG8_LAS unsigned*)(lds + (bufoff) + ldsw + _i * 8192), 16, 0, 0); } while (0)
#define PG8_LDA(dst, b, h) do { _Pragma("unroll") for (int m = 0; m < 4; ++m) _Pragma("unroll") for (int k = 0; k < 2; ++k) dst[m][k] = *(const PG8_LAS bf16x8*)(lds + PG8_SA(b, h) + aoff + m * 2048 + k * 1024); } while (0)
#define PG8_LDB(dst, b, h) do { _Pragma("unroll") for (int n = 0; n < 2; ++n) _Pragma("unroll") for (int k = 0; k < 2; ++k) dst[n][k] = *(const PG8_LAS bf16x8*)(lds + PG8_SB(b, h) + boff + n * 2048 + k * 1024); } while (0)
#define PG8_MMA(ai, bj, At, Bt) do { __builtin_amdgcn_s_setprio(1); _Pragma("unroll") for (int m = 0; m < 4; ++m) _Pragma("unroll") for (int n = 0; n < 2; ++n) _Pragma("unroll") for (int k = 0; k < 2; ++k) \
        acc[ai][bj][m][n] = __builtin_amdgcn_mfma_f32_16x16x32_f16(Bt[n][k], At[m][k], acc[ai][bj][m][n], 0, 0, 0); __builtin_amdgcn_s_setprio(0); } while (0)
#define PG8_WAIT_V(n) asm volatile("s_waitcnt vmcnt(" #n ")" ::: "memory")
#define PG8_WAIT_L(n) asm volatile("s_waitcnt lgkmcnt(" #n ")" ::: "memory")
#define PG8_BAR __builtin_amdgcn_s_barrier()
#define PG8_SCHED __builtin_amdgcn_sched_barrier(0)
    Unit cur, nxt; int ui = 0;
    if (!S.next(0, cur)) return;
    f32x4 acc[2][2][4][2];
#pragma unroll
    for (int a = 0; a < 2; ++a)
#pragma unroll
        for (int b = 0; b < 2; ++b)
#pragma unroll
            for (int m = 0; m < 4; ++m)
#pragma unroll
                for (int n = 0; n < 2; ++n) acc[a][b][m][n] = (f32x4){0.f, 0.f, 0.f, 0.f};
    bf16x8 At[4][2], B0[2][2], B1[2][2];
    const char* cA = (const char*)g.A + (size_t)cur.pm * tstepA; const char* cB = (const char*)g.Bt + (size_t)cur.pn * tstep;
    S.a_ready(cur);
    static_assert(SP2, "only the SP2 loop is kept in this file");
    {
        PG8_STAGE(PG8_SB(0, 0), cB, voffB); PG8_STAGE(PG8_SB(0, 1), cB + hstep, voffB); PG8_STAGE(PG8_SA(0, 0), cA, voffA); PG8_STAGE(PG8_SA(0, 1), cA + hstepA, voffA);
        if (wr == 1) PG8_BAR;
        PG8_WAIT_V(2); PG8_BAR;
        PG8_STAGE(PG8_SB(1, 0), cB + kstep, voffB); PG8_STAGE(PG8_SA(1, 0), cA + kstep, voffA); PG8_STAGE(PG8_SB(1, 1), cB + hstep + kstep, voffB);
        PG8_WAIT_V(6); PG8_BAR;
    }
    for (;;) {
        const bool has_next = S.next(ui + 1, nxt);
        const char* nA = has_next ? (const char*)g.A + (size_t)nxt.pm * tstepA : cA; const char* nB = has_next ? (const char*)g.Bt + (size_t)nxt.pn * tstep : cB;
        for (int t = 0; t < nt; t += 2) {
            const bool last = (t == nt - 2);
            const char* a1 = cA + (size_t)(t + 1) * kstep;
            const char* a2 = last ? nA : cA + (size_t)(t + 2) * kstep; const char* b2 = last ? nB : cB + (size_t)(t + 2) * kstep;
            const char* a3 = a2 + kstep; const char* b3 = b2 + kstep;
            if (last && has_next) S.a_ready(nxt);
            {
            PG8_LDB(B0, 0, 0); PG8_LDB(B1, 0, 1); PG8_SCHED; PG8_LDA(At, 0, 0); PG8_STAGE(PG8_SA(1, 1), a1 + hstepA, voffA);
            PG8_WAIT_V(8); PG8_WAIT_L(0); PG8_BAR; PG8_MMA(0, 0, At, B0); PG8_MMA(0, 1, At, B1); PG8_BAR; PG8_SCHED;
            PG8_LDA(At, 0, 1); PG8_STAGE(PG8_SB(0, 0), b2, voffB); PG8_STAGE(PG8_SB(0, 1), b2 + hstep, voffB); PG8_STAGE(PG8_SA(0, 0), a2, voffA);
            PG8_WAIT_V(8); PG8_WAIT_L(0); PG8_BAR; PG8_MMA(1, 0, At, B0); PG8_MMA(1, 1, At, B1); PG8_BAR; PG8_SCHED;
            PG8_LDB(B0, 1, 0); PG8_LDB(B1, 1, 1); PG8_SCHED; PG8_LDA(At, 1, 0); PG8_STAGE(PG8_SA(0, 1), a2 + hstepA, voffA);
            PG8_WAIT_V(8); PG8_WAIT_L(0); PG8_BAR; PG8_MMA(0, 0, At, B0); PG8_MMA(0, 1, At, B1); PG8_BAR; PG8_SCHED;
            PG8_LDA(At, 1, 1); PG8_STAGE(PG8_SB(1, 0), b3, voffB); PG8_STAGE(PG8_SB(1, 1), b3 + hstep, voffB); PG8_STAGE(PG8_SA(1, 0), a3, voffA);
            PG8_WAIT_V(8); PG8_WAIT_L(0); PG8_BAR; PG8_MMA(1, 0, At, B0); PG8_MMA(1, 1, At, B1); PG8_BAR; PG8_SCHED;
            }
        }
        if constexpr (ALIGN_EPI) { if (wr == 0) PG8_BAR; }
        if constexpr (!Epi::AFTER_DRAIN) { E(acc, cur, wr, wc, fr, fq); S.done(cur); }
        if (!has_next) break;
#pragma unroll
        for (int a = 0; a < 2; ++a)
#pragma unroll
            for (int b = 0; b < 2; ++b)
#pragma unroll
                for (int m = 0; m < 4; ++m)
#pragma unroll
                    for (int n = 0; n < 2; ++n) acc[a][b][m][n] = (f32x4){0.f, 0.f, 0.f, 0.f};
        cur = nxt; cA = nA; cB = nB; ++ui;
        if constexpr (ALIGN_EPI) { if (wr == 1) PG8_BAR; }
    }
    PG8_WAIT_V(0);
    if constexpr (!ALIGN_EPI) { if (wr == 0) PG8_BAR; }
    PG8_BAR;
    if constexpr (Epi::AFTER_DRAIN) { E.fused(acc, cur, wr, wc, fr, fq, lds, wid, lane); S.done(cur); }
#undef PG8_SA
#undef PG8_SB
#undef PG8_STAGE
#undef PG8_LDA
#undef PG8_LDB
#undef PG8_MMA
#undef PG8_WAIT_V
#undef PG8_WAIT_L
#undef PG8_BAR
#undef PG8_SCHED
}
}

#define XB_TMO      128
#define XB_XCNT(j)  (256  + 64 * (j))
#define XB_XSUB(j)  (1280 + 64 * (j))
#define XB_XGEN(j)  (2304 + 64 * (j))
#define XB_TOP      3328
#define XB_TOPGEN   3392
#define XCD_BAR_WORDS 3456
#define XB_SPIN_CAP (1u << 18)

__device__ __forceinline__ unsigned xb_ld(unsigned* p)              { return __hip_atomic_load(p, __ATOMIC_RELAXED, __HIP_MEMORY_SCOPE_AGENT); }
__device__ __forceinline__ unsigned xb_add(unsigned* p, unsigned v) { return __hip_atomic_fetch_add(p, v, __ATOMIC_RELAXED, __HIP_MEMORY_SCOPE_AGENT); }
__device__ __forceinline__ unsigned xb_xcc_id() { return (unsigned)__builtin_amdgcn_s_getreg((3 << 11) | 20) & 0xFu; }
#define XB_SPIN(cond, bar) do { unsigned _sp = 0; while (cond) { __builtin_amdgcn_s_sleep(1); \
    if ((++_sp & 255u) == 0u) { if (xb_ld(&(bar)[XB_TMO])) break; if (_sp > XB_SPIN_CAP) { atomicAdd(&(bar)[XB_TMO], 1u); break; } } } } while (0)

struct XcdBarrier {
    unsigned* bar; unsigned x;
    volatile LAS unsigned* st;
};

__device__ __forceinline__ XcdBarrier xcd_barrier_post(unsigned* bar, volatile LAS unsigned* st) {
    XcdBarrier b; b.bar = bar; b.x = xb_xcc_id(); b.st = st;
    if (threadIdx.x == 0) (void)xb_add(&bar[XB_XCNT(b.x)], 1u);
    return b;
}
__device__ __forceinline__ void xcd_barrier_complete(unsigned* bar, unsigned x, unsigned& nloc, unsigned& nx) {
    const unsigned G = gridDim.x * gridDim.y * gridDim.z;
    asm volatile("" : "+s"(x));
    unsigned sum, cnt, mine, sp = 0u;
    for (;;) {
        sum = 0u; cnt = 0u; mine = 0u;
#pragma unroll
        for (unsigned j = 0; j < 16; ++j) { const unsigned c = xb_ld(&bar[XB_XCNT(j)]); sum += c; cnt += (c > 0u) ? 1u : 0u; mine = (j == x) ? c : mine; }
        if (sum == G) break;
        __builtin_amdgcn_s_sleep(1);
        if ((++sp & 255u) == 0u) { if (xb_ld(&bar[XB_TMO])) break; if (sp > XB_SPIN_CAP) { atomicAdd(&bar[XB_TMO], 1u); break; } }
    }
    nloc = mine > 0u ? mine : 1u; nx = cnt > 0u ? cnt : 1u;
}

__device__ __forceinline__ void xcd_barrier(const XcdBarrier& b) {
    asm volatile("s_waitcnt vmcnt(0)" ::: "memory");
    __syncthreads();
    if (threadIdx.x == 0) {
        unsigned* bar = b.bar;
        __builtin_amdgcn_s_waitcnt(0);
        unsigned nloc = b.st[0], nx = b.st[1];
        if (nloc == 0u) { xcd_barrier_complete(bar, b.x, nloc, nx); b.st[0] = nloc; b.st[1] = nx; }
        const unsigned old = xb_add(&bar[XB_XSUB(b.x)], 1u);
        const unsigned gen = old / nloc;
        if (old + 1u == (gen + 1u) * nloc) {
            __builtin_amdgcn_fence(__ATOMIC_RELEASE, "agent");
            asm volatile("s_waitcnt vmcnt(0)" ::: "memory");
            const unsigned og = xb_add(&bar[XB_TOP], 1u);
            const unsigned tg = og / nx;
            if (og + 1u == (tg + 1u) * nx) xb_add(&bar[XB_TOPGEN], 1u);
            else XB_SPIN(xb_ld(&bar[XB_TOPGEN]) == tg, bar);
            __builtin_amdgcn_fence(__ATOMIC_ACQUIRE, "agent");
            xb_add(&bar[XB_XGEN(b.x)], 1u);
            asm volatile("s_waitcnt vmcnt(0)" ::: "memory");
        } else {
            XB_SPIN(xb_ld(&bar[XB_XGEN(b.x)]) == gen, bar);
            __builtin_amdgcn_fence(__ATOMIC_ACQUIRE, "agent");
            asm volatile("s_waitcnt vmcnt(0)" ::: "memory");
        }
    }
    __syncthreads();
}

#ifndef REP_PRO_A
#define REP_PRO_A 1
#endif
#ifndef REP_PRO_D
#define REP_PRO_D 1
#endif
#ifndef REP_PRO_C
#define REP_PRO_C 1
#endif
#define REPEAT(n) _Pragma("unroll 1") for (int rep_ = 0; rep_ < (n); ++rep_)
struct Args { const GAS void* in[18]; GAS float* out; GAS unsigned char* ws; int ph_lo, ph_hi; };
typedef const __attribute__((address_space(4))) Args* ArgsP;
struct Ctx {
    LAS unsigned char* lds;
    int tid, lane, wave, G, gw, ngw;
    unsigned char* ws;
};
#define LDS_WAIT() asm volatile("s_waitcnt lgkmcnt(0)" ::: "memory")

__device__ const float INVF[32] = {1.000000000e+00f, 7.498942018e-01f, 5.623413324e-01f, 4.216965139e-01f, 3.162277639e-01f, 2.371373922e-01f, 1.778279394e-01f, 1.333521456e-01f,
    1.000000015e-01f, 7.498941571e-02f, 5.623412877e-02f, 4.216964915e-02f, 3.162277862e-02f, 2.371373586e-02f, 1.778279431e-02f, 1.333521493e-02f,
    9.999999776e-03f, 7.498942316e-03f, 5.623413250e-03f, 4.216964822e-03f, 3.162277862e-03f, 2.371373819e-03f, 1.778279431e-03f, 1.333521446e-03f,
    1.000000047e-03f, 7.498941850e-04f, 5.623413017e-04f, 4.216965463e-04f, 3.162277862e-04f, 2.371373848e-04f, 1.778279402e-04f, 1.333521504e-04f};

__device__ __forceinline__ void sincos_d(double x, double& sn, double& cs) {
    const double k = __builtin_rint(x * 0.63661977236758134308);
    double r = __builtin_fma(-k, 1.57079632679489655800e+00, x); r = __builtin_fma(-k, 6.12323399573676603587e-17, r);
    const double z = r * r;
    double sp = 1.0 / 6227020800.0; sp = sp * z - 1.0 / 39916800.0; sp = sp * z + 1.0 / 362880.0; sp = sp * z - 1.0 / 5040.0; sp = sp * z + 1.0 / 120.0; sp = sp * z - 1.0 / 6.0; sp = sp * z + 1.0;
    const double s0 = sp * r;
    double cp = -1.0 / 87178291200.0; cp = cp * z + 1.0 / 479001600.0; cp = cp * z - 1.0 / 3628800.0; cp = cp * z + 1.0 / 40320.0; cp = cp * z - 1.0 / 720.0; cp = cp * z + 1.0 / 24.0; cp = cp * z - 0.5; cp = cp * z + 1.0;
    const int q = ((int)k) & 3;
    sn = (q == 0) ? s0 : (q == 1) ? cp : (q == 2) ? -s0 : -cp;
    cs = (q == 0) ? cp : (q == 1) ? -s0 : (q == 2) ? -cp : s0;
}

__device__ __forceinline__ int w_rowmap(int mode, int n) {
    if (mode == 0) return n;
    bool rope;
    if (mode == 1) { const int t = n >> 8; rope = (t < 4) || t == 4 || t == 6 || t == 8; }
    else rope = n < 1152;
    if (!rope) return n;
    const int d = n & 63; return (n & ~63) + 2 * (d & 31) + (d >> 5);
}
__device__ __forceinline__ void convert_item(const float* W, int K, int N, half_t* WT, int mode, LAS float* scr, int item, int lane) {
    const int nblk = (N + 31) / 32, kb = item / nblk, nb = item % nblk, k0 = 64 * kb, n0 = 32 * nb;
    const int nn = n0 + (lane & 31);
    float t[32];
#pragma unroll
    for (int i = 0; i < 32; ++i) { const int kk = 2 * i + (lane >> 5); t[i] = (nn < N) ? W[(size_t)(k0 + kk) * N + nn] : 0.f; }
#pragma unroll
    for (int i = 0; i < 32; ++i) { const int kk = 2 * i + (lane >> 5); scr[kk * 33 + (lane & 31)] = t[i]; }
    LDS_WAIT(); asm volatile("" ::: "memory");
    const int c = lane & 7;
#pragma unroll
    for (int j = 0; j < 4; ++j) { const int nl = (lane >> 3) + 8 * j, n = n0 + nl; const LAS float* s = scr + (8 * c) * 33 + nl;
        u32x4 o; o.x = pkh2(s[0 * 33], s[1 * 33]); o.y = pkh2(s[2 * 33], s[3 * 33]); o.z = pkh2(s[4 * 33], s[5 * 33]); o.w = pkh2(s[6 * 33], s[7 * 33]);
        if (n < N) *(u32x4*)(WT + (size_t)w_rowmap(mode, n) * K + k0 + 8 * c) = o; }
    LDS_WAIT(); asm volatile("" ::: "memory");
}
struct WDesc { const float* src; half_t* dst; int K, N, mode; };
__device__ __forceinline__ WDesc wdesc(ArgsP a, int mid) {
    WDesc d; unsigned char* ws = (unsigned char*)a->ws;
    if (mid < 2)       { d.src = (const float*)a->in[6] + (size_t)mid * D * NSA_IN;            d.dst = (half_t*)(ws + WS_WINN) + (size_t)mid * NSA_INP * D;         d.K = D;    d.N = NSA_IN; d.mode = 1; }
    else if (mid < 4)  { d.src = (const float*)a->in[13] + (size_t)(mid - 2) * D * SWA_IN;     d.dst = (half_t*)(ws + WS_WINS) + (size_t)(mid - 2) * SWA_IN * D;    d.K = D;    d.N = SWA_IN; d.mode = 2; }
    else if (mid < 6)  { d.src = (const float*)a->in[7] + (size_t)(mid - 4) * D * D;           d.dst = (half_t*)(ws + WS_WOUT) + (size_t)(2 * (mid - 4)) * D * D;   d.K = D;    d.N = D;      d.mode = 0; }
    else if (mid < 8)  { d.src = (const float*)a->in[14] + (size_t)(mid - 6) * D * D;          d.dst = (half_t*)(ws + WS_WOUT) + (size_t)(2 * (mid - 6) + 1) * D * D; d.K = D;  d.N = D;      d.mode = 0; }
    else if (mid < 12) { d.src = (const float*)a->in[9] + (size_t)(mid - 8) * 2048 * 256;      d.dst = (half_t*)(ws + WS_W1T) + (size_t)(mid - 8) * 256 * 2048;     d.K = 2048; d.N = 256;    d.mode = 0; }
    else if (mid < 16) { d.src = (const float*)a->in[11] + (size_t)(mid - 12) * 256 * 64;      d.dst = (half_t*)(ws + WS_W2T) + (size_t)(mid - 12) * 64 * 256;      d.K = 256;  d.N = 64;     d.mode = 0; }
    else if (mid < 20) { d.src = (const float*)a->in[16] + (size_t)(mid - 16) * D * FF;        d.dst = (half_t*)(ws + WS_WUP) + (size_t)(mid - 16) * FF * D;        d.K = D;    d.N = FF;     d.mode = 0; }
    else               { d.src = (const float*)a->in[17] + (size_t)(mid - 20) * FF * D;        d.dst = (half_t*)(ws + WS_WDN) + (size_t)(mid - 20) * D * FF;        d.K = FF;   d.N = D;      d.mode = 0; }
    return d;
}

__device__ __forceinline__ void phase_prologue(ArgsP a, const Ctx& C) {
    unsigned char* ws = C.ws;
    {
        LAS float* scr = (LAS float*)(C.lds + C.wave * 16384);
        REPEAT(REP_PRO_A) for (int mid = 0; mid < 24; ++mid) { const WDesc d = wdesc(a, mid); const int nit = (d.K / 64) * ((d.N + 31) / 32);
            for (int it = C.gw; it < nit; it += C.ngw) convert_item(d.src, d.K, d.N, d.dst, d.mode, scr, it, C.lane); }
    }
    {
        const int gt = C.gw * 64 + C.lane, ngt = C.ngw * 64;
        for (int i = gt; i < 2 * 208 * 128; i += ngt) { const int mat = i / (208 * 128), r = i % (208 * 128);
            *(u32x4*)((half_t*)(ws + WS_WINN) + (size_t)mat * NSA_INP * D + (size_t)NSA_IN * D + (size_t)r * 8) = (u32x4){0u, 0u, 0u, 0u}; }
        const int* pos = (const int*)a->in[2]; float* rope = (float*)(ws + WS_ROPE);
        REPEAT(REP_PRO_C) for (int i = gt; i < M * 32; i += ngt) { const int tok = i >> 5, fi = i & 31;
            const float ang = (float)pos[tok] * INVF[fi]; double sn, cs; sincos_d((double)ang, sn, cs);
            rope[(size_t)tok * 64 + fi] = (float)cs; rope[(size_t)tok * 64 + 32 + fi] = (float)sn; }
    }
    {
        float* b1p = (float*)(ws + WS_B1P);
        for (int task = C.gw; task < 4 * 4 * 32; task += C.ngw) { const int ks = task & 31, cg = (task >> 5) & 3, lw = task >> 7, j = cg * 64 + C.lane;
            const float* w1 = (const float*)a->in[9] + ((size_t)lw * 2048 + ks * 64) * 256 + j; const float* pe = (const float*)a->in[8] + (size_t)lw * 2048 + ks * 64;
            float s = 0.f;
#pragma unroll 16
            for (int k = 0; k < 64; ++k) s += pe[k] * w1[(size_t)k * 256];
            b1p[ks * 1024 + lw * 256 + j] = s; }
    }
    __syncthreads();
    {
        LAS float* cl = (LAS float*)C.lds; const float* cin = (const float*)a->in[1];
        for (int i = C.tid; i < 16 * 1024; i += 512) { const int b = i >> 10, k = i & 1023; const float v = cin[i]; cl[k * 16 + b] = v / (1.0f + __expf(-v)); }
        __syncthreads();
        const float* aw = (const float*)a->in[3]; float* part = (float*)(ws + WS_PART);
        REPEAT(REP_PRO_D) for (int task = C.gw; task < 4 * 8 * 96; task += C.ngw) {
            const int ng = task % 96, lk = task / 96, ks = lk & 7, L = lk >> 3, col = ng * 64 + C.lane;
            const float* wp = aw + ((size_t)L * 1024 + ks * 128) * 6144 + col;
            float acc[16];
#pragma unroll
            for (int b = 0; b < 16; ++b) acc[b] = 0.f;
#pragma unroll 8
            for (int kk = 0; kk < 128; ++kk) { const float w = wp[(size_t)kk * 6144]; const LAS f32x4* cv = (const LAS f32x4*)(cl + (ks * 128 + kk) * 16);
#pragma unroll
                for (int q = 0; q < 4; ++q) { const f32x4 c4 = cv[q]; acc[4 * q] += c4[0] * w; acc[4 * q + 1] += c4[1] * w; acc[4 * q + 2] += c4[2] * w; acc[4 * q + 3] += c4[3] * w; } }
#pragma unroll
            for (int b = 0; b < 16; ++b) part[((size_t)(ks * 4 + L) * 16 + b) * 6144 + col] = acc[b];
        }
    }
}
__device__ __forceinline__ void phase_modfinal(ArgsP a, const Ctx& C) {
    const float* part = (const float*)(C.ws + WS_PART); const float* ab = (const float*)a->in[4]; float* mod = (float*)(C.ws + WS_MOD);
    for (int i = C.gw * 64 + C.lane; i < 4 * 16 * 6144; i += C.ngw * 64) { const int L = i / 98304, rem = i % 98304, n = rem % 6144;
        float s = ab[L * 6144 + n];
#pragma unroll
        for (int ks = 0; ks < 8; ++ks) s += part[(size_t)(ks * 4 + L) * 98304 + rem];
        mod[i] = s; }
    const float* b1p = (const float*)(C.ws + WS_B1P); const float* b1 = (const float*)a->in[10]; float* b1f = (float*)(C.ws + WS_B1F);
    for (int i = C.gw * 64 + C.lane; i < 1024; i += C.ngw * 64) { float s = b1[i];
#pragma unroll 8
        for (int ks = 0; ks < 32; ++ks) s += b1p[ks * 1024 + i];
        b1f[i] = s; }
}

__device__ __forceinline__ void row_norm_mod(const f32x4 (&v)[4], float rstd, const float* gain, const float* sh, const float* sc, half_t* hrow, int lane) {
#pragma unroll
    for (int j = 0; j < 4; ++j) { const int c = 4 * lane + 256 * j;
        const f32x4 g = *(const f32x4*)(gain + c), s1 = *(const f32x4*)(sc + c), s0 = *(const f32x4*)(sh + c);
        const f32x4 h = (v[j] * rstd * g) * (s1 + 1.0f) + s0;
        *(u32x2*)(hrow + c) = pk4(h); }
}

__device__ __forceinline__ void phase_row_first(ArgsP a, const Ctx& C) {
    const float* x = (const float*)a->in[0]; const float* ng = (const float*)a->in[5]; const float* mod = (const float*)(C.ws + WS_MOD); half_t* H = (half_t*)(C.ws + WS_H);
    for (int row = C.gw; row < M; row += C.ngw) { const int b = row >> 11;
        f32x4 v[4]; float ss = 0.f;
#pragma unroll
        for (int j = 0; j < 4; ++j) { v[j] = *(const f32x4*)(x + (size_t)row * D + 4 * C.lane + 256 * j); ss += (v[j][0] * v[j][0] + v[j][1] * v[j][1]) + (v[j][2] * v[j][2] + v[j][3] * v[j][3]); }
        const float rstd = 1.0f / sqrtf(wave_sum(ss, C.lane) * (1.0f / D) + NORM_EPS);
        const float* mb = mod + (size_t)b * 6144;
        row_norm_mod(v, rstd, ng, mb, mb + 1024, H + (size_t)row * D, C.lane);
    }
}
__device__ __forceinline__ void phase_row_update(ArgsP a, const Ctx& C, int L, int which) {
    const float* ng = (const float*)a->in[5]; const float* mod = (const float*)(C.ws + WS_MOD);
    const half_t* Y = (const half_t*)(C.ws + WS_Y); half_t* H = (half_t*)(C.ws + WS_H);
    const float* xin = (L == 0 && which == 0) ? (const float*)a->in[0] : (const float*)a->out; float* xout = (float*)a->out;
    const float* gy = ng + (size_t)(L * 4 + (which ? 3 : 1)) * D;
    const bool doh = !(which == 1 && L == DEPTH - 1);
    const int Lh = which ? L + 1 : L;
    const float* gh = ng + (size_t)(Lh * 4 + (which ? 0 : 2)) * D;
    for (int row = C.gw; row < M; row += C.ngw) { const int b = row >> 11;
        const float* mg = mod + ((size_t)L * 16 + b) * 6144 + (which ? 5 : 2) * 1024;
        f32x4 y[4], xv[4]; float ss = 0.f;
#pragma unroll
        for (int j = 0; j < 4; ++j) { const int c = 4 * C.lane + 256 * j; const h4 yh = *(const h4*)(Y + (size_t)row * D + c); y[j] = (f32x4){(float)yh[0], (float)yh[1], (float)yh[2], (float)yh[3]};
            xv[j] = *(const f32x4*)(xin + (size_t)row * D + c); ss += (y[j][0] * y[j][0] + y[j][1] * y[j][1]) + (y[j][2] * y[j][2] + y[j][3] * y[j][3]); }
        const float r1 = 1.0f / sqrtf(wave_sum(ss, C.lane) * (1.0f / D) + NORM_EPS);
        float s2 = 0.f;
#pragma unroll
        for (int j = 0; j < 4; ++j) { const int c = 4 * C.lane + 256 * j; const f32x4 g = *(const f32x4*)(gy + c), gt = *(const f32x4*)(mg + c);
            xv[j] = xv[j] + (gt + 1.0f) * (y[j] * r1 * g); *(f32x4*)(xout + (size_t)row * D + c) = xv[j];
            s2 += (xv[j][0] * xv[j][0] + xv[j][1] * xv[j][1]) + (xv[j][2] * xv[j][2] + xv[j][3] * xv[j][3]); }
        if (doh) { const float r2 = 1.0f / sqrtf(wave_sum(s2, C.lane) * (1.0f / D) + NORM_EPS);
            const float* mh = mod + ((size_t)Lh * 16 + b) * 6144 + (which ? 0 : 3) * 1024;
            row_norm_mod(xv, r2, gh, mh, mh + 1024, H + (size_t)row * D, C.lane); }
    }
}

__device__ __forceinline__ void phase_cmp2(ArgsP a, const Ctx& C, int la) {
    const half_t* HC = (const half_t*)(C.ws + WS_HIDC); half_t* KCC = (half_t*)(C.ws + WS_KCC);
    const int r32 = C.lane & 31, hi = C.lane >> 5;
    for (int task = C.gw; task < 512; task += C.ngw) {
        const int R0 = task * 32, which = R0 >> 13;
        const half_t* W2 = (const half_t*)(C.ws + WS_W2T) + (size_t)(la * 2 + which) * 64 * 256;
        const float* b2 = (const float*)a->in[12] + (la * 2 + which) * 64;
        f32x16 acc[2]; acc[0] = (f32x16){}; acc[1] = (f32x16){};
        const half_t* ap = HC + (size_t)(R0 + r32) * 256 + hi * 8;
#pragma unroll 4
        for (int ks = 0; ks < 16; ++ks) {
            const h8 af = *(const h8*)(ap + ks * 16);
            const h8 w0 = *(const h8*)(W2 + (size_t)r32 * 256 + ks * 16 + hi * 8), w1 = *(const h8*)(W2 + (size_t)(32 + r32) * 256 + ks * 16 + hi * 8);
            acc[0] = __builtin_amdgcn_mfma_f32_32x32x16_f16(w0, af, acc[0], 0, 0, 0);
            acc[1] = __builtin_amdgcn_mfma_f32_32x32x16_f16(w1, af, acc[1], 0, 0, 0);
        }
        const int row = R0 + r32; const bool dead = (row & 127) == 127;
#pragma unroll
        for (int ct = 0; ct < 2; ++ct)
#pragma unroll
            for (int rg = 0; rg < 4; ++rg) { const int oc = 32 * ct + 8 * rg + 4 * hi; const f32x4 bb = *(const f32x4*)(b2 + oc);
                f32x4 v = {acc[ct][4 * rg] + bb[0], acc[ct][4 * rg + 1] + bb[1], acc[ct][4 * rg + 2] + bb[2], acc[ct][4 * rg + 3] + bb[3]};
                if (dead) v = (f32x4){0.f, 0.f, 0.f, 0.f};
                *(u32x2*)(KCC + (size_t)row * 64 + oc) = pk4(v); }
    }
}

constexpr int AL_K = 0, AL_V = 16384, AL_PSUM = 32768, AL_W = 65536;
__device__ __forceinline__ int crow(int r, int hi) { return (r & 3) + 8 * (r >> 2) + 4 * hi; }
__device__ __forceinline__ void kv_load(const half_t* Kt, const half_t* Vt, int wave, int lane, u32x4& kr, u32x4& vr) {
    kr = *(const u32x4*)(Kt + (size_t)lane * 64 + wave * 8);
    vr = *(const u32x4*)(Vt + (size_t)(16 * (wave & 3) + (lane >> 2)) * 64 + (wave >> 2) * 32 + (lane & 3) * 8);
}
__device__ __forceinline__ void kv_store(LAS unsigned char* Kb, LAS unsigned char* Vb, int wave, int lane, const u32x4 kr, const u32x4 vr) {
    *(LAS u32x4*)(Kb + wave * 1024 + lane * 16) = kr;
    *(LAS u32x4*)(Vb + (wave >> 2) * 4096 + (16 * (wave & 3) + (lane >> 2)) * 64 + (lane & 3) * 16) = vr;
}
__device__ __forceinline__ void qk_tile(f32x16& p0, f32x16& p1, const LAS unsigned char* Kb, const h8 (&qf)[4], int r32, int hi) {
    p0 = (f32x16){}; p1 = (f32x16){};
#pragma unroll
    for (int d0 = 0; d0 < 4; ++d0) {
        const h8 k0 = *(const LAS h8*)(Kb + (2 * d0 + hi) * 1024 + r32 * 16), k1 = *(const LAS h8*)(Kb + (2 * d0 + hi) * 1024 + (32 + r32) * 16);
        p0 = __builtin_amdgcn_mfma_f32_32x32x16_f16(k0, qf[d0], p0, 0, 0, 0);
        p1 = __builtin_amdgcn_mfma_f32_32x32x16_f16(k1, qf[d0], p1, 0, 0, 0);
    }
}
__device__ __forceinline__ s16x4 tr_read(const LAS unsigned char* p) { return __builtin_amdgcn_ds_read_tr16_b64_v4i16((LAS s16x4*)p); }
__device__ __forceinline__ h8 p8(const f32x16& p, int base) {
    return (h8){(half_t)p[base], (half_t)p[base + 1], (half_t)p[base + 2], (half_t)p[base + 3], (half_t)p[base + 4], (half_t)p[base + 5], (half_t)p[base + 6], (half_t)p[base + 7]};
}
__device__ __forceinline__ void pv_tile(f32x16 (&o)[2], const LAS unsigned char* Vb, const f32x16& p0, const f32x16& p1, int lane) {
    const int hi = lane >> 5;
    const LAS unsigned char* va = Vb + ((lane >> 4) & 1) * 32 + (lane & 3) * 8 + (4 * hi + ((lane & 15) >> 2)) * 64;
    h8 pf[4]; pf[0] = p8(p0, 0); pf[1] = p8(p0, 8); pf[2] = p8(p1, 0); pf[3] = p8(p1, 8);
#pragma unroll
    for (int dh = 0; dh < 2; ++dh)
#pragma unroll
        for (int s = 0; s < 4; ++s) {
            const s16x4 lo = tr_read(va + dh * 4096 + s * 1024), hh = tr_read(va + dh * 4096 + s * 1024 + 512);
            typedef short s16x8 __attribute__((ext_vector_type(8)));
            const s16x8 t8 = {lo[0], lo[1], lo[2], lo[3], hh[0], hh[1], hh[2], hh[3]};
            const h8 vf = __builtin_bit_cast(h8, t8);
            o[dh] = __builtin_amdgcn_mfma_f32_32x32x16_f16(vf, pf[s], o[dh], 0, 0, 0);
        }
}
__device__ __forceinline__ float max16(const f32x16& p) {
    float a = fmaxf(fmaxf(p[0], p[1]), fmaxf(p[2], p[3])), b = fmaxf(fmaxf(p[4], p[5]), fmaxf(p[6], p[7]));
    float c = fmaxf(fmaxf(p[8], p[9]), fmaxf(p[10], p[11])), d = fmaxf(fmaxf(p[12], p[13]), fmaxf(p[14], p[15]));
    return fmaxf(fmaxf(a, b), fmaxf(c, d));
}
__device__ __forceinline__ float sum16(const f32x16& p) {
    return (((p[0] + p[1]) + (p[2] + p[3])) + ((p[4] + p[5]) + (p[6] + p[7]))) + (((p[8] + p[9]) + (p[10] + p[11])) + ((p[12] + p[13]) + (p[14] + p[15])));
}

enum { MODE_WIN = 0, MODE_SEL = 1, MODE_SWA = 2 };
template <int MODE>
__device__ __forceinline__ void attn_unit(const Ctx& C, int b, int hkv, int chunk, const half_t* Q, const half_t* Kh, const half_t* Vh,
                                          const unsigned* selm, const float* Gt, float* Oacc, half_t* O, const float* sinks) {
    constexpr int GH = (MODE == MODE_SWA) ? 8 : 4, TPW = 32 / GH, TPB = 8 * TPW, WIN = (MODE == MODE_SWA) ? 128 : 512;
    const int lane = C.lane, wave = C.wave, r32 = lane & 31, hi = lane >> 5;
    const int t0 = chunk * TPB, tw0 = t0 + wave * TPW, tok = tw0 + r32 / GH, head = hkv * GH + (r32 % GH);
    const size_t gtok = (size_t)b * S + tok;
    LAS unsigned char* lds = C.lds;
    h8 qf[4];
#pragma unroll
    for (int d0 = 0; d0 < 4; ++d0) qf[d0] = *(const h8*)(Q + gtok * D + head * 64 + d0 * 16 + hi * 8);
    const int jlast = (t0 + TPB - 1) >> 6;
    unsigned tiles, msk = 0u, wneed = 0u;
    if (MODE == MODE_SEL) {
        msk = selm[tok]; unsigned x = msk;
#pragma unroll
        for (int o = 1; o < 64; o <<= 1) x |= (unsigned)shxi((int)x, o, lane);
        wneed = (unsigned)__builtin_amdgcn_readfirstlane((int)x);
        LAS unsigned* bw = (LAS unsigned*)(lds + AL_W);
        if (C.tid == 0) bw[0] = 0u;
        __syncthreads();
        if (lane == 0) __hip_atomic_fetch_or(bw, wneed, __ATOMIC_RELAXED, __HIP_MEMORY_SCOPE_WORKGROUP);
        __syncthreads();
        tiles = bw[0];
        tiles = (unsigned)__builtin_amdgcn_readfirstlane((int)tiles);
    } else {
        const int kfirst = t0 - WIN + 1, jlo = (kfirst > 0 ? kfirst : 0) >> 6;
        tiles = (jlast >= 31 ? 0xffffffffu : ((1u << (jlast + 1)) - 1u)) & ~((1u << jlo) - 1u);
    }
    float m = NEG_BIG, l = 0.f; f32x16 o[2]; o[0] = (f32x16){}; o[1] = (f32x16){};
    u32x4 kr, vr; int buf = 0;
    unsigned tm = tiles;
    { const int j = __builtin_ctz(tm); kv_load(Kh + (size_t)j * 4096, Vh + (size_t)j * 4096, wave, lane, kr, vr); kv_store(lds + AL_K, lds + AL_V, wave, lane, kr, vr); }
    __syncthreads();
    while (tm) {
        const int j = __builtin_ctz(tm); tm &= tm - 1u;
        const bool more = tm != 0u;
        if (more) { const int jn = __builtin_ctz(tm); kv_load(Kh + (size_t)jn * 4096, Vh + (size_t)jn * 4096, wave, lane, kr, vr); }
        bool need;
        if (MODE == MODE_SEL) need = (wneed >> j) & 1u;
        else need = (64 * j <= tw0 + TPW - 1) && (64 * j + 63 >= tw0 - WIN + 1);
        if (need) {
            f32x16 p0, p1; qk_tile(p0, p1, lds + AL_K + buf * 8192, qf, r32, hi);
            const bool rowok = (MODE == MODE_SEL) ? (((msk >> j) & 1u) != 0u) : true;
            float tmax = NEG_BIG;
#pragma unroll
            for (int r = 0; r < 16; ++r) { const int k0 = 64 * j + crow(r, hi), k1 = k0 + 32;
                const bool v0 = rowok && (k0 <= tok) && (MODE == MODE_SEL || k0 > tok - WIN), v1 = rowok && (k1 <= tok) && (MODE == MODE_SEL || k1 > tok - WIN);
                p0[r] = v0 ? p0[r] : NEG_BIG; p1[r] = v1 ? p1[r] : NEG_BIG; tmax = fmaxf(tmax, fmaxf(p0[r], p1[r])); }
            tmax = fmaxf(tmax, shx(tmax, 32, lane));
            const float mn = fmaxf(m, tmax), alpha = fast_exp2(m - mn);
            m = mn;
#pragma unroll
            for (int r = 0; r < 16; ++r) { p0[r] = (p0[r] > -1.0e29f) ? fast_exp2(p0[r] - mn) : 0.f; p1[r] = (p1[r] > -1.0e29f) ? fast_exp2(p1[r] - mn) : 0.f; }
            l = l * alpha + (sum16(p0) + sum16(p1));
#pragma unroll
            for (int r = 0; r < 16; ++r) { o[0][r] *= alpha; o[1][r] *= alpha; }
            pv_tile(o, lds + AL_V + buf * 8192, p0, p1, lane);
        }
        if (more) kv_store(lds + AL_K + (buf ^ 1) * 8192, lds + AL_V + (buf ^ 1) * 8192, wave, lane, kr, vr);
        __syncthreads();
        buf ^= 1;
    }
    float lt = l + shx(l, 32, lane);
    if (MODE == MODE_SWA) lt += fast_exp2(sinks[head] * LOG2E - m);
    float sc = 1.0f / lt;
    if (MODE != MODE_SWA) sc *= Gt[gtok * 48 + head * 3 + (MODE == MODE_SEL ? 1 : 2)];
#pragma unroll
    for (int dh = 0; dh < 2; ++dh)
#pragma unroll
        for (int rg = 0; rg < 4; ++rg) { const size_t off = gtok * D + head * 64 + 32 * dh + 8 * rg + 4 * hi;
            f32x4 v = {o[dh][4 * rg] * sc, o[dh][4 * rg + 1] * sc, o[dh][4 * rg + 2] * sc, o[dh][4 * rg + 3] * sc};
            if (MODE == MODE_SEL) { *(f32x4*)(Oacc + off) = *(const f32x4*)(Oacc + off) + v; }
            else { if (MODE == MODE_WIN) v = v + *(const f32x4*)(Oacc + off); *(u32x2*)(O + off) = pk4(v); } }
}

__device__ __forceinline__ void cmp_unit(const Ctx& C, int b, int hkv, int c, const half_t* Q, const half_t* Kc, const half_t* Vc, const float* Gt, float* Oacc, unsigned* selm) {
    const int lane = C.lane, wave = C.wave, r32 = lane & 31, hi = lane >> 5;
    const int t0 = c * 64, tl = wave * 8 + (r32 >> 2), tok = t0 + tl, head = hkv * 4 + (r32 & 3);
    const size_t gtok = (size_t)b * S + tok;
    LAS unsigned char* lds = C.lds;
    h8 qf[4];
#pragma unroll
    for (int d0 = 0; d0 < 4; ++d0) qf[d0] = *(const h8*)(Q + gtok * D + head * 64 + d0 * 16 + hi * 8);
    { u32x4 kr, vr;
      kv_load(Kc, Vc, wave, lane, kr, vr); kv_store(lds + AL_K, lds + AL_V, wave, lane, kr, vr);
      kv_load(Kc + 4096, Vc + 4096, wave, lane, kr, vr); kv_store(lds + AL_K + 8192, lds + AL_V + 8192, wave, lane, kr, vr); }
    __syncthreads();
    f32x16 p[4];
    qk_tile(p[0], p[1], lds + AL_K, qf, r32, hi); qk_tile(p[2], p[3], lds + AL_K + 8192, qf, r32, hi);
    const int nvis = (tok >= 31) ? ((tok - 31) >> 4) + 1 : 0;
    float mx = NEG_BIG;
#pragma unroll
    for (int q = 0; q < 4; ++q)
#pragma unroll
        for (int r = 0; r < 16; ++r) { const int n = 32 * q + crow(r, hi); p[q][r] = (n < nvis) ? p[q][r] : NEG_BIG; mx = fmaxf(mx, p[q][r]); }
    mx = fmaxf(mx, shx(mx, 32, lane));
    float l = 0.f;
#pragma unroll
    for (int q = 0; q < 4; ++q) {
#pragma unroll
        for (int r = 0; r < 16; ++r) p[q][r] = (p[q][r] > -1.0e29f) ? fast_exp2(p[q][r] - mx) : 0.f;
        l += sum16(p[q]); }
    l += shx(l, 32, lane);
    const float inv = (l > 0.f) ? 1.0f / l : 0.f;
#pragma unroll
    for (int q = 0; q < 4; ++q)
#pragma unroll
        for (int r = 0; r < 16; ++r) p[q][r] *= inv;
    f32x16 o[2]; o[0] = (f32x16){}; o[1] = (f32x16){};
    pv_tile(o, lds + AL_V, p[0], p[1], lane); pv_tile(o, lds + AL_V + 8192, p[2], p[3], lane);
    const float g0 = Gt[gtok * 48 + head * 3 + 0];
#pragma unroll
    for (int dh = 0; dh < 2; ++dh)
#pragma unroll
        for (int rg = 0; rg < 4; ++rg) { const size_t off = gtok * D + head * 64 + 32 * dh + 8 * rg + 4 * hi;
            *(f32x4*)(Oacc + off) = (f32x4){o[dh][4 * rg] * g0, o[dh][4 * rg + 1] * g0, o[dh][4 * rg + 2] * g0, o[dh][4 * rg + 3] * g0}; }
    LAS float* ps = (LAS float*)(lds + AL_PSUM);
#pragma unroll
    for (int q = 0; q < 4; ++q)
#pragma unroll
        for (int rg = 0; rg < 4; ++rg) { f32x4 v = {p[q][4 * rg], p[q][4 * rg + 1], p[q][4 * rg + 2], p[q][4 * rg + 3]};
#pragma unroll
            for (int e = 0; e < 4; ++e) { v[e] += shx(v[e], 1, lane); v[e] += shx(v[e], 2, lane); }
            if ((r32 & 3) == 0) *(LAS f32x4*)(ps + tl * 128 + 32 * q + 8 * rg + 4 * hi) = v; }
    __syncthreads();
#pragma unroll 1
    for (int it = 0; it < 4; ++it) {
        const int tl2 = wave * 8 + 2 * it + hi, j = r32; const LAS float* pr = ps + tl2 * 128 + 4 * j;
        const f32x4 q4 = *(const LAS f32x4*)pr; const float pm1 = (j > 0) ? pr[-1] : 0.f;
        const float imp = pm1 + 2.0f * q4[0] + 2.0f * q4[1] + 2.0f * q4[2] + q4[3];
        const bool forced = (j == 0) || (j == c) || (j == c - 1);
        const float val = forced ? __builtin_inff() : ((j <= c) ? imp : -__builtin_inff());
        int rank = 0;
#pragma unroll 8
        for (int jj = 0; jj < 32; ++jj) { const float vv = shidx(val, (lane & 32) + jj); rank += (vv > val || (vv == val && jj < j)) ? 1 : 0; }
        const bool sel = (rank < 8) && (j <= c);
        const unsigned long long bal = __ballot(sel);
        if (r32 == 0) selm[t0 + tl2] = hi ? (unsigned)(bal >> 32) : (unsigned)bal;
    }
    __syncthreads();
}

constexpr int RG_SLOT = 16384;
constexpr int FL_CMPK = 49152, FL_CMPV = 65536, FL_PSUM = 81920, FL_MASK = 114688, FL_WORD = 114944;
constexpr float ATT_THR = 8.0f, M_INIT = -64.0f;
__device__ __forceinline__ void glds16(const void* gsrc, unsigned lds_dst) { unsigned keep;
    asm volatile("s_mov_b32 %0, m0\n\ts_mov_b32 m0, %2\n\ts_nop 0\n\tglobal_load_lds_dwordx4 %1, off\n\ts_mov_b32 m0, %0" : "=&s"(keep) : "v"(gsrc), "s"(lds_dst) : "memory"); }
#define ATT_WAIT_BAR(N) asm volatile("s_waitcnt vmcnt(" #N ") lgkmcnt(0)\n\ts_barrier" ::: "memory")
__device__ __forceinline__ void dma_tile(const half_t* Kt, const half_t* Vt, unsigned slot, int wave, int lane) {
    glds16(Kt + (size_t)lane * 64 + wave * 8, (unsigned)__builtin_amdgcn_readfirstlane((int)(slot + wave * 1024)));
    glds16(Vt + (size_t)(16 * (wave & 3) + (lane >> 2)) * 64 + (wave >> 2) * 32 + (lane & 3) * 8, (unsigned)__builtin_amdgcn_readfirstlane((int)(slot + 8192 + wave * 1024)));
}
__device__ __forceinline__ float swapmax(float v) { auto rr = __builtin_amdgcn_permlane32_swap(__float_as_uint(v), __float_as_uint(v), false, false); return fmaxf(__uint_as_float(rr[0]), __uint_as_float(rr[1])); }
__device__ __forceinline__ float swapsum(float v) { auto rr = __builtin_amdgcn_permlane32_swap(__float_as_uint(v), __float_as_uint(v), false, false); return __uint_as_float(rr[0]) + __uint_as_float(rr[1]); }

__device__ __forceinline__ void tile_step(const bool BOUNDARY, float& m, float& l, f32x16 (&o)[2], const h8 (&qf)[4], const LAS unsigned char* Kb, const LAS unsigned char* Vb,
                                          float rowbias, int kbase, int tok, int win, int lane) {
    const int r32 = lane & 31, hi = lane >> 5;
    const float ci = rowbias - m;
    f32x16 p0, p1;
#pragma unroll
    for (int r = 0; r < 16; ++r) { p0[r] = ci; p1[r] = ci; }
#pragma unroll
    for (int d0 = 0; d0 < 4; ++d0) {
        const h8 k0 = *(const LAS h8*)(Kb + (2 * d0 + hi) * 1024 + r32 * 16), k1 = *(const LAS h8*)(Kb + (2 * d0 + hi) * 1024 + (32 + r32) * 16);
        p0 = __builtin_amdgcn_mfma_f32_32x32x16_f16(k0, qf[d0], p0, 0, 0, 0);
        p1 = __builtin_amdgcn_mfma_f32_32x32x16_f16(k1, qf[d0], p1, 0, 0, 0);
    }
    if (BOUNDARY) {
        const int ub = tok - kbase - 4 * hi, lb = ub - win;
#pragma unroll
        for (int r = 0; r < 16; ++r) { const int cr = (r & 3) + 8 * (r >> 2);
            p0[r] = (cr <= ub && cr > lb) ? p0[r] : NEG_BIG; p1[r] = (cr + 32 <= ub && cr + 32 > lb) ? p1[r] : NEG_BIG; }
    }
    const float tmax = swapmax(fmaxf(max16(p0), max16(p1)));
    if (__any(tmax > ATT_THR)) {
        const float dl = fmaxf(tmax, 0.f), f = fast_exp2(-dl);
        m += dl; l *= f;
#pragma unroll
        for (int r = 0; r < 16; ++r) { o[0][r] *= f; o[1][r] *= f; p0[r] -= dl; p1[r] -= dl; }
    }
#pragma unroll
    for (int r = 0; r < 16; ++r) { p0[r] = fast_exp2(p0[r]); p1[r] = fast_exp2(p1[r]); }
    l += sum16(p0) + sum16(p1);
    pv_tile(o, Vb, p0, p1, lane);
}

__device__ __forceinline__ void nsa_unit(const Ctx& C, int b, int hkv, int c, const half_t* Q, const half_t* KV, const half_t* KCC, const float* Gt, half_t* O) {
    const int lane = C.lane, wave = C.wave, r32 = lane & 31, hi = lane >> 5;
    const int bh = b * 4 + hkv, t0 = c * 64, tw0 = t0 + wave * 8, tl = wave * 8 + (r32 >> 2), tok = t0 + tl, head = hkv * 4 + (r32 & 3);
    const size_t gtok = (size_t)b * S + tok;
    LAS unsigned char* lds = C.lds;
    const unsigned ring = (unsigned)(size_t)lds;
    const half_t* Ks = KV + 2 * KVT + (size_t)bh * S * 64; const half_t* Vs = KV + 3 * KVT + (size_t)bh * S * 64;
    const half_t* Kw = KV + 4 * KVT + (size_t)bh * S * 64; const half_t* Vw = KV + 5 * KVT + (size_t)bh * S * 64;
    const int jlo = (c > 8) ? c - 8 : 0, n_win = c - jlo + 1;
    asm volatile("s_waitcnt vmcnt(0)" ::: "memory");
    dma_tile(Kw + (size_t)jlo * 4096, Vw + (size_t)jlo * 4096, ring, wave, lane);
    if (n_win >= 2) dma_tile(Kw + (size_t)(jlo + 1) * 4096, Vw + (size_t)(jlo + 1) * 4096, ring + RG_SLOT, wave, lane);
    h8 qf[4];
#pragma unroll
    for (int d0 = 0; d0 < 4; ++d0) qf[d0] = *(const h8*)(Q + gtok * D + head * 64 + d0 * 16 + hi * 8);
    const float g_cmp = Gt[gtok * 48 + head * 3 + 0], g_sel = Gt[gtok * 48 + head * 3 + 1], g_win = Gt[gtok * 48 + head * 3 + 2];
    f32x16 oc[2];
    {
        const half_t* Kc = KCC + (size_t)bh * 128 * 64; const half_t* Vc = Kc + (size_t)64 * 128 * 64;
        { u32x4 kr, vr;
          kv_load(Kc, Vc, wave, lane, kr, vr); kv_store(lds + FL_CMPK, lds + FL_CMPV, wave, lane, kr, vr);
          kv_load(Kc + 4096, Vc + 4096, wave, lane, kr, vr); kv_store(lds + FL_CMPK + 8192, lds + FL_CMPV + 8192, wave, lane, kr, vr); }
        if (C.tid == 0) ((LAS unsigned*)(lds + FL_WORD))[0] = 0u;
        __syncthreads();
        f32x16 p[4];
        qk_tile(p[0], p[1], lds + FL_CMPK, qf, r32, hi); qk_tile(p[2], p[3], lds + FL_CMPK + 8192, qf, r32, hi);
        const int nvis = ((tok >= 31) ? ((tok - 31) >> 4) + 1 : 0) - 4 * hi;
        float mx = NEG_BIG;
#pragma unroll
        for (int q = 0; q < 4; ++q)
#pragma unroll
            for (int r = 0; r < 16; ++r) { const int cn = 32 * q + (r & 3) + 8 * (r >> 2); p[q][r] = (cn < nvis) ? p[q][r] : NEG_BIG; mx = fmaxf(mx, p[q][r]); }
        mx = swapmax(mx);
        float l = 0.f;
#pragma unroll
        for (int q = 0; q < 4; ++q) {
#pragma unroll
            for (int r = 0; r < 16; ++r) p[q][r] = (p[q][r] > -1.0e29f) ? fast_exp2(p[q][r] - mx) : 0.f;
            l += sum16(p[q]); }
        l = swapsum(l);
        const float inv = (l > 0.f) ? 1.0f / l : 0.f;
#pragma unroll
        for (int q = 0; q < 4; ++q)
#pragma unroll
            for (int r = 0; r < 16; ++r) p[q][r] *= inv;
        oc[0] = (f32x16){}; oc[1] = (f32x16){};
        pv_tile(oc, lds + FL_CMPV, p[0], p[1], lane); pv_tile(oc, lds + FL_CMPV + 8192, p[2], p[3], lane);
#pragma unroll
        for (int r = 0; r < 16; ++r) { oc[0][r] *= g_cmp; oc[1][r] *= g_cmp; }
        LAS float* ps = (LAS float*)(lds + FL_PSUM);
#pragma unroll
        for (int q = 0; q < 4; ++q)
#pragma unroll
            for (int rg = 0; rg < 4; ++rg) { f32x4 v = {p[q][4 * rg], p[q][4 * rg + 1], p[q][4 * rg + 2], p[q][4 * rg + 3]};
#pragma unroll
                for (int e = 0; e < 4; ++e) { v[e] += shx(v[e], 1, lane); v[e] += shx(v[e], 2, lane); }
                if ((r32 & 3) == 0) *(LAS f32x4*)(ps + tl * 128 + 32 * q + 8 * rg + 4 * hi) = v; }
        __syncthreads();
        LAS unsigned* mk = (LAS unsigned*)(lds + FL_MASK); unsigned wor = 0u;
#pragma unroll 1
        for (int it = 0; it < 4; ++it) {
            const int tl2 = wave * 8 + 2 * it + hi, j = r32; const LAS float* pr = ps + tl2 * 128 + 4 * j;
            const f32x4 q4 = *(const LAS f32x4*)pr; const float pm1 = (j > 0) ? pr[-1] : 0.f;
            const float imp = pm1 + 2.0f * q4[0] + 2.0f * q4[1] + 2.0f * q4[2] + q4[3];
            const bool forced = (j == 0) || (j == c) || (j == c - 1);
            const float val = forced ? __builtin_inff() : ((j <= c) ? imp : -__builtin_inff());
            int rank = 0;
#pragma unroll 8
            for (int jj = 0; jj < 32; ++jj) { const float vv = shidx(val, (lane & 32) + jj); rank += (vv > val || (vv == val && jj < j)) ? 1 : 0; }
            const bool sel = (rank < 8) && (j <= c);
            const unsigned long long bal = __ballot(sel);
            const unsigned mine = hi ? (unsigned)(bal >> 32) : (unsigned)bal;
            if (r32 == 0) mk[tl2] = mine;
            wor |= (unsigned)bal | (unsigned)(bal >> 32);
        }
        if (lane == 0) __hip_atomic_fetch_or((LAS unsigned*)(lds + FL_WORD), wor, __ATOMIC_RELAXED, __HIP_MEMORY_SCOPE_WORKGROUP);
        __syncthreads();
    }
    const unsigned msk = ((const LAS unsigned*)(lds + FL_MASK))[tl];
    unsigned wneed = msk;
#pragma unroll
    for (int o_ = 1; o_ < 64; o_ <<= 1) wneed |= (unsigned)shxi((int)wneed, o_, lane);
    wneed = (unsigned)__builtin_amdgcn_readfirstlane((int)wneed);
    const unsigned bneed = (unsigned)__builtin_amdgcn_readfirstlane((int)((const LAS unsigned*)(lds + FL_WORD))[0]);
    const int n_tot = n_win + __builtin_popcount(bneed);
    unsigned dbits = bneed, cbits = bneed;
    if (n_win < 2 && n_tot >= 2) { const int j = __builtin_ctz(dbits); dbits &= dbits - 1u; dma_tile(Ks + (size_t)j * 4096, Vs + (size_t)j * 4096, ring + RG_SLOT, wave, lane); }
    float m = M_INIT, l = 0.f; f32x16 o[2]; o[0] = (f32x16){}; o[1] = (f32x16){};
    int slot_c = 0, slot_d = 2;
#pragma unroll 1
    for (int e = 0; e < n_tot; ++e) {
        if (e + 1 < n_tot) ATT_WAIT_BAR(2); else ATT_WAIT_BAR(0);
        if (e + 2 < n_tot) {
            if (e + 2 < n_win) { const int j = jlo + e + 2; dma_tile(Kw + (size_t)j * 4096, Vw + (size_t)j * 4096, ring + slot_d * RG_SLOT, wave, lane); }
            else { const int j = __builtin_ctz(dbits); dbits &= dbits - 1u; dma_tile(Ks + (size_t)j * 4096, Vs + (size_t)j * 4096, ring + slot_d * RG_SLOT, wave, lane); }
        }
        const LAS unsigned char* Kb = lds + slot_c * RG_SLOT; const LAS unsigned char* Vb = Kb + 8192;
        const bool is_win = e < n_win;
        int j; bool need, bnd; float rb = 0.f; int win = 512;
        if (is_win) { j = jlo + e; need = (64 * j <= tw0 + 7) && (64 * j + 63 >= tw0 - 511); bnd = (64 * j + 63 > tw0) || (64 * j <= tw0 + 7 - 512); }
        else { j = __builtin_ctz(cbits); cbits &= cbits - 1u; need = (wneed >> j) & 1u; bnd = (j == c); rb = ((msk >> j) & 1u) ? 0.f : NEG_BIG; win = 1 << 20; }
        if (need) {
            tile_step(bnd, m, l, o, qf, Kb, Vb, rb, 64 * j, tok, win, lane);
        }
        if (e == n_win - 1) {
            const float sc = g_win / swapsum(l);
#pragma unroll
            for (int r = 0; r < 16; ++r) { oc[0][r] += o[0][r] * sc; oc[1][r] += o[1][r] * sc; o[0][r] = 0.f; o[1][r] = 0.f; }
            m = M_INIT; l = 0.f;
        }
        slot_c = (slot_c == 2) ? 0 : slot_c + 1; slot_d = (slot_d == 2) ? 0 : slot_d + 1;
    }
    {
        const float sc = g_sel / swapsum(l);
#pragma unroll
        for (int dh = 0; dh < 2; ++dh)
#pragma unroll
            for (int rg = 0; rg < 4; ++rg) { const size_t off = gtok * D + head * 64 + 32 * dh + 8 * rg + 4 * hi;
                const f32x4 v = {oc[dh][4 * rg] + o[dh][4 * rg] * sc, oc[dh][4 * rg + 1] + o[dh][4 * rg + 1] * sc, oc[dh][4 * rg + 2] + o[dh][4 * rg + 2] * sc, oc[dh][4 * rg + 3] + o[dh][4 * rg + 3] * sc};
                *(u32x2*)(O + off) = pk4(v); }
    }
    asm volatile("s_waitcnt lgkmcnt(0)\n\ts_barrier" ::: "memory");
}

__device__ __forceinline__ void swa_unit(const Ctx& C, int b, int hkv, int cc, const half_t* Q, const half_t* Kh, const half_t* Vh, const float* sinks, half_t* O) {
    const int lane = C.lane, wave = C.wave, r32 = lane & 31, hi = lane >> 5;
    const int t0 = cc * 32, tw0 = t0 + 4 * wave, tok = tw0 + (r32 >> 3), head = hkv * 8 + (r32 & 7);
    const size_t gtok = (size_t)b * S + tok;
    LAS unsigned char* lds = C.lds; const unsigned ring = (unsigned)(size_t)lds;
    const int jhi = (t0 + 31) >> 6, jlo = ((t0 > 127) ? (t0 - 127) : 0) >> 6, n_tot = jhi - jlo + 1;
    asm volatile("s_waitcnt vmcnt(0)" ::: "memory");
    dma_tile(Kh + (size_t)jlo * 4096, Vh + (size_t)jlo * 4096, ring, wave, lane);
    if (n_tot >= 2) dma_tile(Kh + (size_t)(jlo + 1) * 4096, Vh + (size_t)(jlo + 1) * 4096, ring + RG_SLOT, wave, lane);
    h8 qf[4];
#pragma unroll
    for (int d0 = 0; d0 < 4; ++d0) qf[d0] = *(const h8*)(Q + gtok * D + head * 64 + d0 * 16 + hi * 8);
    float m = M_INIT, l = 0.f; f32x16 o[2]; o[0] = (f32x16){}; o[1] = (f32x16){};
    const float sk = sinks[head] * LOG2E;
#pragma unroll 1
    for (int e = 0; e < n_tot; ++e) {
        if (e + 1 < n_tot) ATT_WAIT_BAR(2); else ATT_WAIT_BAR(0);
        if (e + 2 < n_tot) dma_tile(Kh + (size_t)(jlo + 2) * 4096, Vh + (size_t)(jlo + 2) * 4096, ring + 2 * RG_SLOT, wave, lane);
        const int jt = jlo + e;
        const LAS unsigned char* Kb = lds + e * RG_SLOT; const LAS unsigned char* Vb = Kb + 8192;
        const bool need = (64 * jt <= tw0 + 3) && (64 * jt + 63 >= tw0 - 127);
        if (need) {
            const bool bnd = (64 * jt + 63 > tw0) || (64 * jt <= tw0 + 3 - 128);
            tile_step(bnd, m, l, o, qf, Kb, Vb, 0.f, 64 * jt, tok, 128, lane);
        }
    }
    const float sc = 1.0f / (swapsum(l) + fast_exp2(sk - m));
#pragma unroll
    for (int dh = 0; dh < 2; ++dh)
#pragma unroll
        for (int rg = 0; rg < 4; ++rg) { const size_t off = gtok * D + head * 64 + 32 * dh + 8 * rg + 4 * hi;
            const f32x4 v = {o[dh][4 * rg] * sc, o[dh][4 * rg + 1] * sc, o[dh][4 * rg + 2] * sc, o[dh][4 * rg + 3] * sc};
            *(u32x2*)(O + off) = pk4(v); }
    asm volatile("s_waitcnt lgkmcnt(0)\n\ts_barrier" ::: "memory");
}

#ifndef EN_PRO
#define EN_PRO 1
#endif
#ifndef EN_ROW
#define EN_ROW 1
#endif
#ifndef EN_INPROJ
#define EN_INPROJ 1
#endif
#ifndef EN_CMP1
#define EN_CMP1 1
#endif
#ifndef EN_CMP2
#define EN_CMP2 1
#endif
#ifndef EN_CMPATT
#define EN_CMPATT 1
#endif
#ifndef EN_SEL
#define EN_SEL 1
#endif
#ifndef EN_WIN
#define EN_WIN 1
#endif
#ifndef EN_SWA
#define EN_SWA 1
#endif
#ifndef EN_OUT
#define EN_OUT 1
#endif
#ifndef EN_UP
#define EN_UP 1
#endif
#ifndef EN_DOWN
#define EN_DOWN 1
#endif
#ifndef REP_PRO
#define REP_PRO 1
#endif
#ifndef REP_ROWF
#define REP_ROWF 1
#endif
#ifndef REP_INPROJ
#define REP_INPROJ 1
#endif
#ifndef REP_CMP1
#define REP_CMP1 1
#endif
#ifndef REP_CMP2
#define REP_CMP2 1
#endif
#ifndef REP_NSA
#define REP_NSA 1
#endif
#ifndef REP_SWA
#define REP_SWA 1
#endif
#ifndef REP_OUT
#define REP_OUT 1
#endif
#ifndef REP_UP
#define REP_UP 1
#endif
#ifndef REP_DOWN
#define REP_DOWN 1
#endif
constexpr int NPHASE = 3 + 11 * DEPTH;
__host__ __device__ constexpr bool phase_exists(int p) { return p < 3 ? true : (((p - 3) / 11) % 2 == 0 ? !(((p - 3) % 11) == 4 || ((p - 3) % 11) == 5) : !(((p - 3) % 11) >= 1 && ((p - 3) % 11) <= 4)); }

__global__ void __launch_bounds__(512, 2) mk_fwd(Args a) {
    extern __shared__ __attribute__((aligned(16))) unsigned char lds_raw[];
    Ctx C;
    C.lds = (LAS unsigned char*)lds_raw;
    const int wave0 = __builtin_amdgcn_readfirstlane((int)(threadIdx.x >> 6));
    C.lane = (int)__builtin_amdgcn_mbcnt_hi(~0u, __builtin_amdgcn_mbcnt_lo(~0u, 0u)); C.wave = wave0; C.tid = wave0 * 64 + C.lane;
    C.G = gridDim.x; C.gw = blockIdx.x * 8 + C.wave; C.ngw = C.G * 8; C.ws = (unsigned char*)a.ws;
    GAS unsigned char* ws = a.ws;
    for (int u = C.tid; u < (LDS_BYTES - LDSCTL_OFF) / 4; u += 512) ((LAS unsigned*)(C.lds + LDSCTL_OFF))[u] = 0u;
    __syncthreads();
#if MK_ONE_LAUNCH
    XcdBarrier bar = xcd_barrier_post((unsigned*)(ws + WS_CTL) + CW_BAR, (volatile LAS unsigned*)(C.lds + MISC_OFF) + 8);
#define SEAM() xcd_barrier(bar)
#else
#define SEAM() do { } while (0)
#endif
    const int lo = a.ph_lo, hi = a.ph_hi;
#define RUN(p) (lo <= (p) && (p) < hi)
#define FRESH() Ctx Cp = C; ArgsP ap = (ArgsP)__builtin_amdgcn_kernarg_segment_ptr(); { int w_ = wave0; asm volatile("" : "+s"(w_), "+s"(ap)); int l_; asm volatile("v_mbcnt_lo_u32_b32 %0, -1, 0\n\tv_mbcnt_hi_u32_b32 %0, -1, %0" : "=v"(l_)); Cp.tid = w_ * 64 + l_; Cp.lane = l_; Cp.wave = w_; Cp.gw = blockIdx.x * 8 + w_; } GAS unsigned char* const wsx = ap->ws; Cp.ws = (unsigned char*)wsx; (void)wsx;
#define Hb ((half_t*)(wsx + WS_H))
#define Yb ((half_t*)(wsx + WS_Y))
#define Qb ((half_t*)(wsx + WS_Q))
#define KVb ((half_t*)(wsx + WS_KV))
#define Ob ((half_t*)(wsx + WS_O))
#define Gb ((float*)(wsx + WS_G))
#define HIDb ((half_t*)(wsx + WS_BIG))
#define ropeb ((const float*)(wsx + WS_ROPE))

    if (EN_PRO && RUN(0)) { FRESH(); REPEAT(REP_PRO) { phase_prologue(ap, Cp); __syncthreads(); } SEAM(); }
    if (EN_PRO && RUN(1)) { FRESH(); phase_modfinal(ap, Cp); SEAM(); }
    if (EN_ROW && RUN(2)) { FRESH(); REPEAT(REP_ROWF) phase_row_first(ap, Cp); SEAM(); }

#pragma unroll 1
    for (int L = 0; L < DEPTH; ++L) {
        const int pb = 3 + 11 * L, la = L >> 1; const bool nsa = (L & 1) == 0;
        if (EN_INPROJ && RUN(pb + 0)) { FRESH();
            if (nsa) { pg8::Gemm g{Hb, (const half_t*)(wsx + WS_WINN) + (size_t)la * NSA_INP * D, M, NSA_INP, D, D}; pg8::StaticOrder So; So.init(M, NSA_INP, C.G, (int)blockIdx.x);
                pg8::EpiNsaIn E{Qb, KVb, Gb, ropeb};
                REPEAT(REP_INPROJ) pg8::gemm_phase<pg8::EpiNsaIn, pg8::StaticOrder, true, true>(C.lds, g, So, E, Cp.tid);
            } else { pg8::Gemm g{Hb, (const half_t*)(wsx + WS_WINS) + (size_t)la * SWA_IN * D, M, SWA_IN, D, D}; pg8::StaticOrder So; So.init(M, SWA_IN, C.G, (int)blockIdx.x);
                pg8::EpiSwaIn E{Qb, KVb, ropeb};
                REPEAT(REP_INPROJ) pg8::gemm_phase<pg8::EpiSwaIn, pg8::StaticOrder, true, true>(C.lds, g, So, E, Cp.tid);
            }
            SEAM();
        }
        if (nsa) {
            if (EN_CMP1 && RUN(pb + 1)) { FRESH();
                pg8::Gemm g{KVb, (const half_t*)(wsx + WS_W1T) + (size_t)la * 512 * 2048, 16384, 512, 2048, 1024}; pg8::CmpOrder So{C.G, (int)blockIdx.x};
                pg8::EpiF16<2> E{(half_t*)(wsx + WS_HIDC), 256, (const float*)(wsx + WS_B1F) + la * 512};
                REPEAT(REP_CMP1) pg8::gemm_phase<pg8::EpiF16<2>, pg8::CmpOrder, true, true>(C.lds, g, So, E, Cp.tid);
                SEAM();
            }
            if (EN_CMP2 && RUN(pb + 2)) { FRESH(); REPEAT(REP_CMP2) phase_cmp2(ap, Cp, la); SEAM(); }
            if (EN_CMPATT && RUN(pb + 3)) { FRESH();
                REPEAT(REP_NSA) for (int u = blockIdx.x; u < NB * 4 * 32; u += C.G) { const int k = u & 255, i = u >> 8, bh = k >> 2, s_ = k & 3, a_ = 3 - (i >> 1), c = (i & 1) ? (8 * a_ + s_) : (8 * a_ + 7 - s_);
                    nsa_unit(Cp, bh >> 2, bh & 3, c, Qb, KVb, (const half_t*)(wsx + WS_KCC), Gb, Ob); }
                SEAM();
            }
        } else {
            if (EN_SWA && RUN(pb + 5)) { FRESH();
                const float* sinks = (const float*)ap->in[15] + la * 16;
                REPEAT(REP_SWA) for (int u = blockIdx.x; u < NB * 2 * 64; u += C.G) { const int j = 63 - (u & 63), bh = u >> 6;
                    swa_unit(Cp, bh >> 1, bh & 1, j, Qb, KVb + (size_t)bh * S * 64, KVb + (size_t)M * 128 + (size_t)bh * S * 64, sinks, Ob); }
                SEAM();
            }
        }
        if (EN_OUT && RUN(pb + 6)) { FRESH();
            pg8::Gemm g{Ob, (const half_t*)(wsx + WS_WOUT) + (size_t)L * D * D, M, D, D, D}; pg8::StaticOrder So; So.init(M, D, C.G, (int)blockIdx.x);
            pg8::EpiF16<0> E{Yb, D, nullptr};
            REPEAT(REP_OUT) pg8::gemm_phase<pg8::EpiF16<0>, pg8::StaticOrder, true, true>(C.lds, g, So, E, Cp.tid);
            SEAM();
        }
        if (EN_ROW && RUN(pb + 7)) { FRESH(); phase_row_update(ap, Cp, L, 0); SEAM(); }
        if (EN_UP && RUN(pb + 8)) { FRESH();
            pg8::Gemm g{Hb, (const half_t*)(wsx + WS_WUP) + (size_t)L * FF * D, M, FF, D, D}; pg8::StaticOrder So; So.init(M, FF, C.G, (int)blockIdx.x);
            pg8::EpiF16<1> E{HIDb, FF, nullptr};
            REPEAT(REP_UP) pg8::gemm_phase<pg8::EpiF16<1>, pg8::StaticOrder, true, true>(C.lds, g, So, E, Cp.tid);
            SEAM();
        }
        if (EN_DOWN && RUN(pb + 9)) { FRESH();
            pg8::Gemm g{HIDb, (const half_t*)(wsx + WS_WDN) + (size_t)L * D * FF, M, D, FF, FF}; pg8::StaticOrder So; So.init(M, D, C.G, (int)blockIdx.x);
            pg8::EpiF16<0> E{Yb, D, nullptr};
            REPEAT(REP_DOWN) pg8::gemm_phase<pg8::EpiF16<0>, pg8::StaticOrder, true, true>(C.lds, g, So, E, Cp.tid);
            SEAM();
        }
        if (EN_ROW && RUN(pb + 10)) { FRESH(); phase_row_update(ap, Cp, L, 1); if (L + 1 < DEPTH) SEAM(); }
    }
#undef RUN
#undef Hb
#undef Yb
#undef Qb
#undef KVb
#undef Ob
#undef Gb
#undef HIDb
#undef ropeb
#undef SEAM
}

extern "C" void kernel_launch(void* const* d_in, const int* in_sizes, int n_in, void* d_out, int out_size, void* d_ws, size_t ws_size, hipStream_t stream) {
    static int grid = 0;
    if (grid == 0) {
        if (n_in != 18 || in_sizes[0] != M * D || out_size != M * D || ws_size < WS_END) {
            fprintf(stderr, "kernel_launch: built for 18 inputs, x/out of %d floats, >= %zu bytes of workspace; got n_in %d, in0 %d, out %d, ws %zu; nothing launched\n", M * D, (size_t)WS_END, n_in, n_in > 0 ? in_sizes[0] : -1, out_size, ws_size);
            grid = -1; return; }
        int dev = 0, cus = 0, per_cu = 0;
        if (hipGetDevice(&dev) != hipSuccess || hipDeviceGetAttribute(&cus, hipDeviceAttributeMultiprocessorCount, dev) != hipSuccess) { fprintf(stderr, "kernel_launch: device query failed\n"); grid = -1; return; }
        if (hipFuncSetAttribute((const void*)mk_fwd, hipFuncAttributeMaxDynamicSharedMemorySize, LDS_BYTES) != hipSuccess) { fprintf(stderr, "kernel_launch: hipFuncSetAttribute failed\n"); grid = -1; return; }
        if (hipOccupancyMaxActiveBlocksPerMultiprocessor(&per_cu, (const void*)mk_fwd, 512, LDS_BYTES) != hipSuccess || per_cu < 1)
            fprintf(stderr, "kernel_launch: note: occupancy query reports %d workgroups per CU\n", per_cu);
        (void)hipGetLastError();
        grid = cus;
    }
    if (grid < 0) return;
    if (hipMemsetAsync((char*)d_ws + WS_CTL, 0, CTL_ZERO_BYTES, stream) != hipSuccess) { fprintf(stderr, "kernel_launch: memset failed\n"); return; }
    Args a{};
    for (int i = 0; i < 18; ++i) a.in[i] = (const GAS void*)d_in[i];
    a.out = (GAS float*)d_out; a.ws = (GAS unsigned char*)d_ws;
#if MK_ONE_LAUNCH
    a.ph_lo = 0; a.ph_hi = NPHASE;
    hipLaunchKernelGGL(mk_fwd, dim3(grid), dim3(512), LDS_BYTES, stream, a);
#else
    for (int p = 0; p < NPHASE; ++p) { if (!phase_exists(p)) continue;
        a.ph_lo = p; a.ph_hi = p + 1;
        hipLaunchKernelGGL(mk_fwd, dim3(grid), dim3(512), LDS_BYTES, stream, a); }
#endif
    const hipError_t le = hipPeekAtLastError();
    if (le != hipSuccess) fprintf(stderr, "kernel_launch: launch failed: %s\n", hipGetErrorName(le));
}
```

```cpp
#include <hip/hip_runtime.h>
#include <cstdio>
#include <cstdint>

#ifndef MK_ONE_LAUNCH
#define MK_ONE_LAUNCH 1
#endif

#define LAS __attribute__((address_space(3)))
#define GAS __attribute__((address_space(1)))
typedef _Float16 half_t;
typedef _Float16 h8 __attribute__((ext_vector_type(8)));
typedef _Float16 h4 __attribute__((ext_vector_type(4)));
typedef _Float16 h2 __attribute__((ext_vector_type(2)));
typedef float f32x2 __attribute__((ext_vector_type(2)));
typedef float f32x4 __attribute__((ext_vector_type(4)));
typedef float f32x16 __attribute__((ext_vector_type(16)));
typedef unsigned u32x2 __attribute__((ext_vector_type(2)));
typedef unsigned u32x4 __attribute__((ext_vector_type(4)));
typedef short s16x4 __attribute__((ext_vector_type(4)));

constexpr int D = 1024, NB = 16, S = 2048, M = NB * S, DEPTH = 4, HD = 64, FF = 4096;
constexpr int NSA_IN = 2608, NSA_INP = 2816, SWA_IN = 1280;
constexpr int NCMP = 127;
constexpr float NORM_EPS = 1e-6f;
constexpr float LOG2E = 1.4426950408889634f;
constexpr float C2 = 0.125f * LOG2E;
constexpr float NEG_BIG = -1.0e30f;

constexpr size_t MiB = 1u << 20;
constexpr size_t WS_CTL = 0, CTL_ZERO_BYTES = 1 * MiB;
constexpr size_t WS_MOD  = 1 * MiB;
constexpr size_t WS_B1F  = 3 * MiB;
constexpr size_t WS_W2T  = 3 * MiB + 65536;
constexpr size_t WS_B1P  = 3 * MiB + 262144;
constexpr size_t WS_ROPE = 4 * MiB;
constexpr size_t WS_PART = 12 * MiB;
constexpr size_t WS_WINN = 24 * MiB;
constexpr size_t WS_WINS = 36 * MiB;
constexpr size_t WS_WOUT = 41 * MiB;
constexpr size_t WS_W1T  = 49 * MiB;
constexpr size_t WS_WUP  = 53 * MiB;
constexpr size_t WS_WDN  = 85 * MiB;
constexpr size_t WS_X16  = 117 * MiB;
constexpr size_t WS_Y    = 245 * MiB;
constexpr size_t WS_Y2   = 181 * MiB;
constexpr size_t WS_H    = 181 * MiB;
constexpr size_t WS_BIG  = 245 * MiB;
constexpr size_t WS_Q    = 245 * MiB;
constexpr size_t WS_KV   = 309 * MiB;
constexpr size_t WS_O    = 405 * MiB;
constexpr size_t WS_G    = 469 * MiB;
constexpr size_t WS_HIDC = 475 * MiB;
constexpr size_t WS_KCC  = 483 * MiB;
constexpr size_t WS_SELM = 485 * MiB;
constexpr size_t WS_END  = 501 * MiB;
constexpr size_t KVT = (size_t)M * 256;

constexpr int CW_BAR = 4096;

constexpr int RING_BYTES = 131072;
constexpr int LDSCTL_OFF = RING_BYTES, MISC_OFF = LDSCTL_OFF + 320;
constexpr int LDS_BYTES = 147456;

__device__ __forceinline__ unsigned pkh2(float lo, float hi) { h2 p = {(half_t)lo, (half_t)hi}; return __builtin_bit_cast(unsigned, p); }
__device__ __forceinline__ u32x2 pk4(const f32x4 v) { u32x2 w; w.x = pkh2(v[0], v[1]); w.y = pkh2(v[2], v[3]); return w; }
__device__ __forceinline__ float fast_exp2(float x) { return __builtin_amdgcn_exp2f(x); }
__device__ __forceinline__ float fast_rcp(float x) { return __builtin_amdgcn_rcpf(x); }
__device__ __forceinline__ float shx(float v, int o, int lane) { return __builtin_bit_cast(float, __builtin_amdgcn_ds_bpermute((lane ^ o) << 2, __builtin_bit_cast(int, v))); }
__device__ __forceinline__ int shxi(int v, int o, int lane) { return __builtin_amdgcn_ds_bpermute((lane ^ o) << 2, v); }
__device__ __forceinline__ float shidx(float v, int src) { return __builtin_bit_cast(float, __builtin_amdgcn_ds_bpermute(src << 2, __builtin_bit_cast(int, v))); }
__device__ __forceinline__ float wave_sum(float v, int lane) {
#pragma unroll
    for (int o = 1; o < 64; o <<= 1) v += shx(v, o, lane);
    return v;
}

namespace pg8 {
#define PG8_LAS __attribute__((address_space(3)))
typedef _Float16 bf16_t;
typedef _Float16 bf16x8 __attribute__((ext_vector_type(8)));
typedef float f32x4 __attribute__((ext_vector_type(4)));
typedef unsigned u32x4 __attribute__((ext_vector_type(4)));
constexpr int BM = 256, BK = 64, HALF = 128, HTB = HALF * BK * 2  , STAGE_BYTES = 8 * HTB, NXCD = 8, WGM = 8;

__host__ __device__ __forceinline__ int lds_byte(int r, int c) { const int st = (r >> 4) * 2 + (c >> 5), rr = r & 15, cc = c & 31, ob = rr * 64 + cc * 2; return st * 1024 + (ob ^ (((ob >> 9) & 1) << 5)); }
__host__ __device__ __forceinline__ void stage_rc(int b, int& R, int& C) { const int st = b / 1024, sb = b % 1024, swz = sb ^ (((sb >> 9) & 1) << 5); R = (st >> 1) * 16 + swz / 64; C = (st & 1) * 32 + (swz % 64) / 2; }
__host__ __device__ __forceinline__ int perm32(int rho) { const int n = rho >> 4, i = rho & 15; return 8 * (i >> 2) + 4 * n + (i & 3); }

struct Unit { int pm, pn; };
struct Gemm { const bf16_t* A; const bf16_t* Bt; int M, N, K, lda; };

struct StaticOrder {
    int nM, nN, nwg, G, c;
    __host__ __device__ void init(int M, int N, int G_, int c_) { nM = M / BM; nN = N / BM; nwg = nM * nN; G = G_; c = c_; }
    __host__ __device__ bool next(int i, Unit& u) const {
        const long L = (long)i * G + c; if (L >= nwg) return false;
        int wgid = (int)L; { const int q = nwg / NXCD, r = nwg % NXCD, xcd = wgid % NXCD, off = wgid / NXCD; wgid = (xcd < r ? xcd * (q + 1) : r * (q + 1) + (xcd - r) * q) + off; }
        const int nig = WGM * nN, gid = wgid / nig, fm = gid * WGM, gsz = (nM - fm) < WGM ? (nM - fm) : WGM;
        u.pm = fm + ((wgid % nig) % gsz); u.pn = (wgid % nig) / gsz; return true;
    }
    __device__ __forceinline__ void a_ready(const Unit&) const {}
    __device__ __forceinline__ void done(const Unit&) const {}
};


struct CmpOrder {
    int G, c;
    __device__ bool next(int i, Unit& u) const { const int L = i * G + c; if (L >= 64) return false; u.pm = L; u.pn = L >> 5; return true; }
    __device__ __forceinline__ void a_ready(const Unit&) const {}
    __device__ __forceinline__ void done(const Unit&) const {}
};

__device__ __forceinline__ u32x4 pack8h(const f32x4 v0, const f32x4 v1) { u32x4 w; w.x = pkh2(v0[0], v0[1]); w.y = pkh2(v0[2], v0[3]); w.z = pkh2(v1[0], v1[1]); w.w = pkh2(v1[2], v1[3]); return w; }
__device__ __forceinline__ float gelu_tanh(float v) {
    const float u2 = 1.5957691216057308f * (v + 0.044715f * v * v * v);
    return v * fast_rcp(1.0f + fast_exp2(-u2 * LOG2E));
}
template <int ACT> struct EpiF16 {
    static constexpr bool PERM = true, AFTER_DRAIN = false;
    half_t* O; int ldc; const float* bias;
    __device__ __forceinline__ void operator()(const f32x4 (&acc)[2][2][4][2], const Unit& u, int wr, int wc, int fr, int fq) const {
        asm volatile("" : "+v"(fr), "+v"(fq));
        const int row0 = u.pm * BM + wr * 64 + fr;
        const int col0 = (ACT == 2 ? 0 : u.pn * BM) + wc * 32 + 8 * fq, bcol0 = u.pn * BM + wc * 32 + 8 * fq;
        f32x4 bv[2][2];
#pragma unroll
        for (int bj = 0; bj < 2; ++bj)
#pragma unroll
            for (int n = 0; n < 2; ++n) bv[bj][n] = (ACT == 2) ? *(const f32x4*)(bias + bcol0 + bj * HALF + 4 * n) : (f32x4){0.f, 0.f, 0.f, 0.f};
#pragma unroll
        for (int ai = 0; ai < 2; ++ai)
#pragma unroll
            for (int m = 0; m < 4; ++m) { half_t* rowp = O + (size_t)(row0 + ai * HALF + m * 16) * ldc + col0;
#pragma unroll
                for (int bj = 0; bj < 2; ++bj) { f32x4 v0 = acc[ai][bj][m][0], v1 = acc[ai][bj][m][1];
                    if (ACT == 1) {
#pragma unroll
                        for (int e = 0; e < 4; ++e) { const float a = fmaxf(v0[e], 0.f), b = fmaxf(v1[e], 0.f); v0[e] = a * a; v1[e] = b * b; } }
                    if (ACT == 2) { v0 = v0 + bv[bj][0]; v1 = v1 + bv[bj][1];
#pragma unroll
                        for (int e = 0; e < 4; ++e) { v0[e] = gelu_tanh(v0[e]); v1[e] = gelu_tanh(v1[e]); } }
                    *(u32x4*)(rowp + bj * HALF) = pack8h(v0, v1); } }
    }
};

__device__ __forceinline__ void rope8(const f32x4 v0, const f32x4 v1, const float* ropetok, int i0, float sc, f32x4& o1, f32x4& o2) {
    const f32x4 c = *(const f32x4*)(ropetok + i0), s = *(const f32x4*)(ropetok + 32 + i0);
    const f32x4 x1 = {v0[0], v0[2], v1[0], v1[2]}, x2 = {v0[1], v0[3], v1[1], v1[3]};
    o1 = (x1 * c - x2 * s) * sc; o2 = (x2 * c + x1 * s) * sc;
}
__device__ __forceinline__ u32x2 pack4h(const f32x4 v) { u32x2 w; w.x = pkh2(v[0], v[1]); w.y = pkh2(v[2], v[3]); return w; }

struct EpiNsaIn {
    static constexpr bool PERM = true, AFTER_DRAIN = false;
    half_t* Q; half_t* KV; float* G; const float* rope;
    __device__ __forceinline__ void operator()(const f32x4 (&acc)[2][2][4][2], const Unit& u, int wr, int wc, int fr, int fq) const {
        asm volatile("" : "+v"(fr), "+v"(fq));
        const int pn = u.pn;
#pragma unroll
        for (int ai = 0; ai < 2; ++ai)
#pragma unroll
            for (int m = 0; m < 4; ++m) {
                const int tok = u.pm * BM + ai * HALF + wr * 64 + m * 16 + fr, b = tok >> 11, s = tok & 2047;
                const float* rt = rope + (size_t)tok * 64;
#pragma unroll
                for (int bj = 0; bj < 2; ++bj) {
                    const int cit = bj * HALF + wc * 32 + 8 * fq, hh = cit >> 6, jj0 = cit & 63;
                    const f32x4 v0 = acc[ai][bj][m][0], v1 = acc[ai][bj][m][1];
                    if (pn < 4) { f32x4 o1, o2; rope8(v0, v1, rt, jj0 >> 1, C2, o1, o2);
                        half_t* p = Q + (size_t)tok * D + pn * 256 + hh * 64 + (jj0 >> 1);
                        *(u32x2*)p = pack4h(o1); *(u32x2*)(p + 32) = pack4h(o2);
                    } else if (pn == 10) {
                        if (cit < 48) { f32x4 g0, g1;
#pragma unroll
                            for (int e = 0; e < 4; ++e) { g0[e] = fast_rcp(1.0f + fast_exp2(-v0[e] * LOG2E)); g1[e] = fast_rcp(1.0f + fast_exp2(-v1[e] * LOG2E)); }
                            float* p = G + (size_t)tok * 48 + cit; *(f32x4*)p = g0; *(f32x4*)(p + 4) = g1; }
                    } else {
                        const int t = pn - 4;
                        half_t* base = KV + (size_t)t * KVT + ((size_t)(b * 4 + hh) * S + s) * 64;
                        if ((t & 1) == 0) { f32x4 o1, o2; rope8(v0, v1, rt, jj0 >> 1, 1.0f, o1, o2);
                            *(u32x2*)(base + (jj0 >> 1)) = pack4h(o1); *(u32x2*)(base + 32 + (jj0 >> 1)) = pack4h(o2);
                        } else *(u32x4*)(base + jj0) = pack8h(v0, v1);
                    }
                }
                asm volatile("" ::: "memory");
            }
    }
};
struct EpiSwaIn {
    static constexpr bool PERM = true, AFTER_DRAIN = false;
    half_t* Q; half_t* KV; const float* rope;
    __device__ __forceinline__ void operator()(const f32x4 (&acc)[2][2][4][2], const Unit& u, int wr, int wc, int fr, int fq) const {
        asm volatile("" : "+v"(fr), "+v"(fq));
        const int pn = u.pn;
#pragma unroll
        for (int ai = 0; ai < 2; ++ai)
#pragma unroll
            for (int m = 0; m < 4; ++m) {
                const int tok = u.pm * BM + ai * HALF + wr * 64 + m * 16 + fr, b = tok >> 11, s = tok & 2047;
                const float* rt = rope + (size_t)tok * 64;
#pragma unroll
                for (int bj = 0; bj < 2; ++bj) {
                    const int cit = bj * HALF + wc * 32 + 8 * fq, hh = cit >> 6, jj0 = cit & 63;
                    const f32x4 v0 = acc[ai][bj][m][0], v1 = acc[ai][bj][m][1];
                    if (pn < 4) { f32x4 o1, o2; rope8(v0, v1, rt, jj0 >> 1, C2, o1, o2);
                        half_t* p = Q + (size_t)tok * D + pn * 256 + hh * 64 + (jj0 >> 1);
                        *(u32x2*)p = pack4h(o1); *(u32x2*)(p + 32) = pack4h(o2);
                    } else if (bj == 0) {
                        half_t* base = KV + ((size_t)(b * 2 + hh) * S + s) * 64;
                        f32x4 o1, o2; rope8(v0, v1, rt, jj0 >> 1, 1.0f, o1, o2);
                        *(u32x2*)(base + (jj0 >> 1)) = pack4h(o1); *(u32x2*)(base + 32 + (jj0 >> 1)) = pack4h(o2);
                    } else {
                        half_t* base = KV + (size_t)M * 128 + ((size_t)(b * 2 + (hh - 2)) * S + s) * 64;
                        *(u32x4*)(base + jj0) = pack8h(v0, v1);
                    }
                }
                asm volatile("" ::: "memory");
            }
    }
};
template <class Epi, class Sched, bool ALIGN_EPI = false, bool SP2 = false>
__device__ __forceinline__ void gemm_phase(PG8_LAS unsigned char* lds, const Gemm g, const Sched& S, const Epi& E, int tid_in) {
    int tid_ = tid_in; asm volatile("" : "+v"(tid_));
    const int tid = tid_, wid = __builtin_amdgcn_readfirstlane(tid >> 6), lane = tid & 63, wr = wid >> 2, wc = wid & 3, fr = lane & 15, fq = lane >> 4;
    const int K = g.K, nt = K / BK;
    unsigned voffA[2], voffB[2];
#pragma unroll
    for (int i = 0; i < 2; ++i) { int R, C; stage_rc(tid * 16 + i * 8192, R, C); const int Rb = Epi::PERM ? ((R & ~31) + perm32(R & 31)) : R;
        voffA[i] = (unsigned)(R * g.lda + C) * 2u; voffB[i] = (unsigned)(Rb * K + C) * 2u; }
    const size_t kstep = (size_t)(BK * 2);
    const size_t hstep = (size_t)HALF * K * 2;
    const size_t tstep = 2 * hstep;
    const size_t hstepA = (size_t)HALF * g.lda * 2, tstepA = 2 * hstepA;
    const unsigned ldsw = (unsigned)wid * 1024u;
    const int aoff = lds_byte(wr * 64 + fr, fq * 8), boff = lds_byte(wc * 32 + fr, fq * 8);
#define PG8_SA(b, h) (((b) * 2 + (h)) * HTB)
#define PG8_SB(b, h) ((4 + (b) * 2 + (h)) * HTB)
#define PG8_STAGE(bufoff, gbase, voff) do { _Pragma("unroll") for (int _i = 0; _i < 2; ++_i) \
        __builtin_amdgcn_global_load_lds((const unsigned*)((const char*)(gbase) + (voff)[_i]), (PG8_LAS unsigned*)(lds + (bufoff) + ldsw + _i * 8192), 16, 0, 0); } while (0)
#define PG8_LDA(dst, b, h) do { _Pragma("unroll") for (int m = 0; m < 4; ++m) _Pragma("unroll") for (int k = 0; k < 2; ++k) dst[m][k] = *(const PG8_LAS bf16x8*)(lds + PG8_SA(b, h) + aoff + m * 2048 + k * 1024); } while (0)
#define PG8_LDB(dst, b, h) do { _Pragma("unroll") for (int n = 0; n < 2; ++n) _Pragma("unroll") for (int k = 0; k < 2; ++k) dst[n][k] = *(const PG8_LAS bf16x8*)(lds + PG8_SB(b, h) + boff + n * 2048 + k * 1024); } while (0)
#define PG8_MMA(ai, bj, At, Bt) do { __builtin_amdgcn_s_setprio(1); _Pragma("unroll") for (int m = 0; m < 4; ++m) _Pragma("unroll") for (int n = 0; n < 2; ++n) _Pragma("unroll") for (int k = 0; k < 2; ++k) \
        acc[ai][bj][m][n] = __builtin_amdgcn_mfma_f32_16x16x32_f16(Bt[n][k], At[m][k], acc[ai][bj][m][n], 0, 0, 0); __builtin_amdgcn_s_setprio(0); } while (0)
#define PG8_WAIT_V(n) asm volatile("s_waitcnt vmcnt(" #n ")" ::: "memory")
#define PG8_WAIT_L(n) asm volatile("s_waitcnt lgkmcnt(" #n ")" ::: "memory")
#define PG8_BAR __builtin_amdgcn_s_barrier()
#define PG8_SCHED __builtin_amdgcn_sched_barrier(0)
    Unit cur, nxt; int ui = 0;
    if (!S.next(0, cur)) return;
    f32x4 acc[2][2][4][2];
#pragma unroll
    for (int a = 0; a < 2; ++a)
#pragma unroll
        for (int b = 0; b < 2; ++b)
#pragma unroll
            for (int m = 0; m < 4; ++m)
#pragma unroll
                for (int n = 0; n < 2; ++n) acc[a][b][m][n] = (f32x4){0.f, 0.f, 0.f, 0.f};
    bf16x8 At[4][2], B0[2][2], B1[2][2];
    const char* cA = (const char*)g.A + (size_t)cur.pm * tstepA; const char* cB = (const char*)g.Bt + (size_t)cur.pn * tstep;
    S.a_ready(cur);
    static_assert(SP2, "only the SP2 loop is kept in this file");
    {
        PG8_STAGE(PG8_SB(0, 0), cB, voffB); PG8_STAGE(PG8_SB(0, 1), cB + hstep, voffB); PG8_STAGE(PG8_SA(0, 0), cA, voffA); PG8_STAGE(PG8_SA(0, 1), cA + hstepA, voffA);
        if (wr == 1) PG8_BAR;
        PG8_WAIT_V(2); PG8_BAR;
        PG8_STAGE(PG8_SB(1, 0), cB + kstep, voffB); PG8_STAGE(PG8_SA(1, 0), cA + kstep, voffA); PG8_STAGE(PG8_SB(1, 1), cB + hstep + kstep, voffB);
        PG8_WAIT_V(6); PG8_BAR;
    }
    for (;;) {
        const bool has_next = S.next(ui + 1, nxt);
        const char* nA = has_next ? (const char*)g.A + (size_t)nxt.pm * tstepA : cA; const char* nB = has_next ? (const char*)g.Bt + (size_t)nxt.pn * tstep : cB;
        for (int t = 0; t < nt; t += 2) {
            const bool last = (t == nt - 2);
            const char* a1 = cA + (size_t)(t + 1) * kstep;
            const char* a2 = last ? nA : cA + (size_t)(t + 2) * kstep; const char* b2 = last ? nB : cB + (size_t)(t + 2) * kstep;
            const char* a3 = a2 + kstep; const char* b3 = b2 + kstep;
            if (last && has_next) S.a_ready(nxt);
            {
            PG8_LDB(B0, 0, 0); PG8_LDB(B1, 0, 1); PG8_SCHED; PG8_LDA(At, 0, 0); PG8_STAGE(PG8_SA(1, 1), a1 + hstepA, voffA);
            PG8_WAIT_V(8); PG8_WAIT_L(0); PG8_BAR; PG8_MMA(0, 0, At, B0); PG8_MMA(0, 1, At, B1); PG8_BAR; PG8_SCHED;
            PG8_LDA(At, 0, 1); PG8_STAGE(PG8_SB(0, 0), b2, voffB); PG8_STAGE(PG8_SB(0, 1), b2 + hstep, voffB); PG8_STAGE(PG8_SA(0, 0), a2, voffA);
            PG8_WAIT_V(8); PG8_WAIT_L(0); PG8_BAR; PG8_MMA(1, 0, At, B0); PG8_MMA(1, 1, At, B1); PG8_BAR; PG8_SCHED;
            PG8_LDB(B0, 1, 0); PG8_LDB(B1, 1, 1); PG8_SCHED; PG8_LDA(At, 1, 0); PG8_STAGE(PG8_SA(0, 1), a2 + hstepA, voffA);
            PG8_WAIT_V(8); PG8_WAIT_L(0); PG8_BAR; PG8_MMA(0, 0, At, B0); PG8_MMA(0, 1, At, B1); PG8_BAR; PG8_SCHED;
            PG8_LDA(At, 1, 1); PG8_STAGE(PG8_SB(1, 0), b3, voffB); PG8_STAGE(PG8_SB(1, 1), b3 + hstep, voffB); PG8_STAGE(PG8_SA(1, 0), a3, voffA);
            PG8_WAIT_V(8); PG8_WAIT_L(0); PG8_BAR; PG8_MMA(1, 0, At, B0); PG8_MMA(1, 1, At, B1); PG8_BAR; PG8_SCHED;
            }
        }
        if constexpr (ALIGN_EPI) { if (wr == 0) PG8_BAR; }
        if constexpr (!Epi::AFTER_DRAIN) { E(acc, cur, wr, wc, fr, fq); S.done(cur); }
        if (!has_next) break;
#pragma unroll
        for (int a = 0; a < 2; ++a)
#pragma unroll
            for (int b = 0; b < 2; ++b)
#pragma unroll
                for (int m = 0; m < 4; ++m)
#pragma unroll
                    for (int n = 0; n < 2; ++n) acc[a][b][m][n] = (f32x4){0.f, 0.f, 0.f, 0.f};
        cur = nxt; cA = nA; cB = nB; ++ui;
        if constexpr (ALIGN_EPI) { if (wr == 1) PG8_BAR; }
    }
    PG8_WAIT_V(0);
    if constexpr (!ALIGN_EPI) { if (wr == 0) PG8_BAR; }
    PG8_BAR;
    if constexpr (Epi::AFTER_DRAIN) { E.fused(acc, cur, wr, wc, fr, fq, lds, wid, lane); S.done(cur); }
#undef PG8_SA
#undef PG8_SB
#undef PG8_STAGE
#undef PG8_LDA
#undef PG8_LDB
#undef PG8_MMA
#undef PG8_WAIT_V
#undef PG8_WAIT_L
#undef PG8_BAR
#undef PG8_SCHED
}
}

#define XB_TMO      128
#define XB_XCNT(j)  (256  + 64 * (j))
#define XB_XSUB(j)  (1280 + 64 * (j))
#define XB_XGEN(j)  (2304 + 64 * (j))
#define XB_TOP      3328
#define XB_TOPGEN   3392
#define XCD_BAR_WORDS 3456
#define XB_SPIN_CAP (1u << 18)

__device__ __forceinline__ unsigned xb_ld(unsigned* p)              { return __hip_atomic_load(p, __ATOMIC_RELAXED, __HIP_MEMORY_SCOPE_AGENT); }
__device__ __forceinline__ unsigned xb_add(unsigned* p, unsigned v) { return __hip_atomic_fetch_add(p, v, __ATOMIC_RELAXED, __HIP_MEMORY_SCOPE_AGENT); }
__device__ __forceinline__ unsigned xb_xcc_id() { return (unsigned)__builtin_amdgcn_s_getreg((3 << 11) | 20) & 0xFu; }
#define XB_SPIN(cond, bar) do { unsigned _sp = 0; while (cond) { __builtin_amdgcn_s_sleep(1); \
    if ((++_sp & 255u) == 0u) { if (xb_ld(&(bar)[XB_TMO])) break; if (_sp > XB_SPIN_CAP) { atomicAdd(&(bar)[XB_TMO], 1u); break; } } } } while (0)

struct XcdBarrier {
    unsigned* bar; unsigned x;
    volatile LAS unsigned* st;
};

__device__ __forceinline__ XcdBarrier xcd_barrier_post(unsigned* bar, volatile LAS unsigned* st) {
    XcdBarrier b; b.bar = bar; b.x = xb_xcc_id(); b.st = st;
    if (threadIdx.x == 0) (void)xb_add(&bar[XB_XCNT(b.x)], 1u);
    return b;
}
__device__ __forceinline__ void xcd_barrier_complete(unsigned* bar, unsigned x, unsigned& nloc, unsigned& nx) {
    const unsigned G = gridDim.x * gridDim.y * gridDim.z;
    asm volatile("" : "+s"(x));
    unsigned sum, cnt, mine, sp = 0u;
    for (;;) {
        sum = 0u; cnt = 0u; mine = 0u;
#pragma unroll
        for (unsigned j = 0; j < 16; ++j) { const unsigned c = xb_ld(&bar[XB_XCNT(j)]); sum += c; cnt += (c > 0u) ? 1u : 0u; mine = (j == x) ? c : mine; }
        if (sum == G) break;
        __builtin_amdgcn_s_sleep(1);
        if ((++sp & 255u) == 0u) { if (xb_ld(&bar[XB_TMO])) break; if (sp > XB_SPIN_CAP) { atomicAdd(&bar[XB_TMO], 1u); break; } }
    }
    nloc = mine > 0u ? mine : 1u; nx = cnt > 0u ? cnt : 1u;
}

__device__ __forceinline__ void xcd_barrier(const XcdBarrier& b) {
    asm volatile("s_waitcnt vmcnt(0)" ::: "memory");
    __syncthreads();
    if (threadIdx.x == 0) {
        unsigned* bar = b.bar;
        __builtin_amdgcn_s_waitcnt(0);
        unsigned nloc = b.st[0], nx = b.st[1];
        if (nloc == 0u) { xcd_barrier_complete(bar, b.x, nloc, nx); b.st[0] = nloc; b.st[1] = nx; }
        const unsigned old = xb_add(&bar[XB_XSUB(b.x)], 1u);
        const unsigned gen = old / nloc;
        if (old + 1u == (gen + 1u) * nloc) {
            __builtin_amdgcn_fence(__ATOMIC_RELEASE, "agent");
            asm volatile("s_waitcnt vmcnt(0)" ::: "memory");
            const unsigned og = xb_add(&bar[XB_TOP], 1u);
            const unsigned tg = og / nx;
            if (og + 1u == (tg + 1u) * nx) xb_add(&bar[XB_TOPGEN], 1u);
            else XB_SPIN(xb_ld(&bar[XB_TOPGEN]) == tg, bar);
            __builtin_amdgcn_fence(__ATOMIC_ACQUIRE, "agent");
            xb_add(&bar[XB_XGEN(b.x)], 1u);
            asm volatile("s_waitcnt vmcnt(0)" ::: "memory");
        } else {
            XB_SPIN(xb_ld(&bar[XB_XGEN(b.x)]) == gen, bar);
            __builtin_amdgcn_fence(__ATOMIC_ACQUIRE, "agent");
            asm volatile("s_waitcnt vmcnt(0)" ::: "memory");
        }
    }
    __syncthreads();
}

#ifndef REP_PRO_A
#define REP_PRO_A 1
#endif
#ifndef REP_PRO_D
#define REP_PRO_D 1
#endif
#ifndef REP_PRO_C
#define REP_PRO_C 1
#endif
#define REPEAT(n) _Pragma("unroll 1") for (int rep_ = 0; rep_ < (n); ++rep_)
struct Args { const GAS void* in[18]; GAS float* out; GAS unsigned char* ws; int ph_lo, ph_hi; };
typedef const __attribute__((address_space(4))) Args* ArgsP;
struct Ctx {
    LAS unsigned char* lds;
    int tid, lane, wave, G, gw, ngw;
    unsigned char* ws;
};
#define LDS_WAIT() asm volatile("s_waitcnt lgkmcnt(0)" ::: "memory")

__device__ const float INVF[32] = {1.000000000e+00f, 7.498942018e-01f, 5.623413324e-01f, 4.216965139e-01f, 3.162277639e-01f, 2.371373922e-01f, 1.778279394e-01f, 1.333521456e-01f,
    1.000000015e-01f, 7.498941571e-02f, 5.623412877e-02f, 4.216964915e-02f, 3.162277862e-02f, 2.371373586e-02f, 1.778279431e-02f, 1.333521493e-02f,
    9.999999776e-03f, 7.498942316e-03f, 5.623413250e-03f, 4.216964822e-03f, 3.162277862e-03f, 2.371373819e-03f, 1.778279431e-03f, 1.333521446e-03f,
    1.000000047e-03f, 7.498941850e-04f, 5.623413017e-04f, 4.216965463e-04f, 3.162277862e-04f, 2.371373848e-04f, 1.778279402e-04f, 1.333521504e-04f};

__device__ __forceinline__ void sincos_d(double x, double& sn, double& cs) {
    const double k = __builtin_rint(x * 0.63661977236758134308);
    double r = __builtin_fma(-k, 1.57079632679489655800e+00, x); r = __builtin_fma(-k, 6.12323399573676603587e-17, r);
    const double z = r * r;
    double sp = 1.0 / 6227020800.0; sp = sp * z - 1.0 / 39916800.0; sp = sp * z + 1.0 / 362880.0; sp = sp * z - 1.0 / 5040.0; sp = sp * z + 1.0 / 120.0; sp = sp * z - 1.0 / 6.0; sp = sp * z + 1.0;
    const double s0 = sp * r;
    double cp = -1.0 / 87178291200.0; cp = cp * z + 1.0 / 479001600.0; cp = cp * z - 1.0 / 3628800.0; cp = cp * z + 1.0 / 40320.0; cp = cp * z - 1.0 / 720.0; cp = cp * z + 1.0 / 24.0; cp = cp * z - 0.5; cp = cp * z + 1.0;
    const int q = ((int)k) & 3;
    sn = (q == 0) ? s0 : (q == 1) ? cp : (q == 2) ? -s0 : -cp;
    cs = (q == 0) ? cp : (q == 1) ? -s0 : (q == 2) ? -cp : s0;
}

__device__ __forceinline__ int w_rowmap(int mode, int n) {
    if (mode == 0) return n;
    bool rope;
    if (mode == 1) { const int t = n >> 8; rope = (t < 4) || t == 4 || t == 6 || t == 8; }
    else rope = n < 1152;
    if (!rope) return n;
    const int d = n & 63; return (n & ~63) + 2 * (d & 31) + (d >> 5);
}
__device__ __forceinline__ void convert_item(const float* W, int K, int N, half_t* WT, int mode, LAS float* scr, int item, int lane) {
    const int nblk = (N + 31) / 32, kb = item / nblk, nb = item % nblk, k0 = 64 * kb, n0 = 32 * nb;
    const int nn = n0 + (lane & 31);
    float t[32];
#pragma unroll
    for (int i = 0; i < 32; ++i) { const int kk = 2 * i + (lane >> 5); t[i] = (nn < N) ? W[(size_t)(k0 + kk) * N + nn] : 0.f; }
#pragma unroll
    for (int i = 0; i < 32; ++i) { const int kk = 2 * i + (lane >> 5); scr[kk * 33 + (lane & 31)] = t[i]; }
    LDS_WAIT(); asm volatile("" ::: "memory");
    const int c = lane & 7;
#pragma unroll
    for (int j = 0; j < 4; ++j) { const int nl = (lane >> 3) + 8 * j, n = n0 + nl; const LAS float* s = scr + (8 * c) * 33 + nl;
        u32x4 o; o.x = pkh2(s[0 * 33], s[1 * 33]); o.y = pkh2(s[2 * 33], s[3 * 33]); o.z = pkh2(s[4 * 33], s[5 * 33]); o.w = pkh2(s[6 * 33], s[7 * 33]);
        if (n < N) *(u32x4*)(WT + (size_t)w_rowmap(mode, n) * K + k0 + 8 * c) = o; }
    LDS_WAIT(); asm volatile("" ::: "memory");
}
struct WDesc { const float* src; half_t* dst; int K, N, mode; };
__device__ __forceinline__ WDesc wdesc(ArgsP a, int mid) {
    WDesc d; unsigned char* ws = (unsigned char*)a->ws;
    if (mid < 2)       { d.src = (const float*)a->in[6] + (size_t)mid * D * NSA_IN;            d.dst = (half_t*)(ws + WS_WINN) + (size_t)mid * NSA_INP * D;         d.K = D;    d.N = NSA_IN; d.mode = 1; }
    else if (mid < 4)  { d.src = (const float*)a->in[13] + (size_t)(mid - 2) * D * SWA_IN;     d.dst = (half_t*)(ws + WS_WINS) + (size_t)(mid - 2) * SWA_IN * D;    d.K = D;    d.N = SWA_IN; d.mode = 2; }
    else if (mid < 6)  { d.src = (const float*)a->in[7] + (size_t)(mid - 4) * D * D;           d.dst = (half_t*)(ws + WS_WOUT) + (size_t)(2 * (mid - 4)) * D * D;   d.K = D;    d.N = D;      d.mode = 0; }
    else if (mid < 8)  { d.src = (const float*)a->in[14] + (size_t)(mid - 6) * D * D;          d.dst = (half_t*)(ws + WS_WOUT) + (size_t)(2 * (mid - 6) + 1) * D * D; d.K = D;  d.N = D;      d.mode = 0; }
    else if (mid < 12) { d.src = (const float*)a->in[9] + (size_t)(mid - 8) * 2048 * 256;      d.dst = (half_t*)(ws + WS_W1T) + (size_t)(mid - 8) * 256 * 2048;     d.K = 2048; d.N = 256;    d.mode = 0; }
    else if (mid < 16) { d.src = (const float*)a->in[11] + (size_t)(mid - 12) * 256 * 64;      d.dst = (half_t*)(ws + WS_W2T) + (size_t)(mid - 12) * 64 * 256;      d.K = 256;  d.N = 64;     d.mode = 0; }
    else if (mid < 20) { d.src = (const float*)a->in[16] + (size_t)(mid - 16) * D * FF;        d.dst = (half_t*)(ws + WS_WUP) + (size_t)(mid - 16) * FF * D;        d.K = D;    d.N = FF;     d.mode = 0; }
    else               { d.src = (const float*)a->in[17] + (size_t)(mid - 20) * FF * D;        d.dst = (half_t*)(ws + WS_WDN) + (size_t)(mid - 20) * D * FF;        d.K = FF;   d.N = D;      d.mode = 0; }
    return d;
}

__device__ __forceinline__ void phase_prologue(ArgsP a, const Ctx& C) {
    unsigned char* ws = C.ws;
    {
        LAS float* scr = (LAS float*)(C.lds + C.wave * 16384);
        REPEAT(REP_PRO_A) for (int mid = 0; mid < 24; ++mid) { const WDesc d = wdesc(a, mid); const int nit = (d.K / 64) * ((d.N + 31) / 32);
            for (int it = C.gw; it < nit; it += C.ngw) convert_item(d.src, d.K, d.N, d.dst, d.mode, scr, it, C.lane); }
    }
    {
        const int gt = C.gw * 64 + C.lane, ngt = C.ngw * 64;
        for (int i = gt; i < 2 * 208 * 128; i += ngt) { const int mat = i / (208 * 128), r = i % (208 * 128);
            *(u32x4*)((half_t*)(ws + WS_WINN) + (size_t)mat * NSA_INP * D + (size_t)NSA_IN * D + (size_t)r * 8) = (u32x4){0u, 0u, 0u, 0u}; }
        const int* pos = (const int*)a->in[2]; float* rope = (float*)(ws + WS_ROPE);
        REPEAT(REP_PRO_C) for (int i = gt; i < M * 32; i += ngt) { const int tok = i >> 5, fi = i & 31;
            const float ang = (float)pos[tok] * INVF[fi]; double sn, cs; sincos_d((double)ang, sn, cs);
            rope[(size_t)tok * 64 + fi] = (float)cs; rope[(size_t)tok * 64 + 32 + fi] = (float)sn; }
    }
    {
        float* b1p = (float*)(ws + WS_B1P);
        for (int task = C.gw; task < 4 * 4 * 32; task += C.ngw) { const int ks = task & 31, cg = (task >> 5) & 3, lw = task >> 7, j = cg * 64 + C.lane;
            const float* w1 = (const float*)a->in[9] + ((size_t)lw * 2048 + ks * 64) * 256 + j; const float* pe = (const float*)a->in[8] + (size_t)lw * 2048 + ks * 64;
            float s = 0.f;
#pragma unroll 16
            for (int k = 0; k < 64; ++k) s += pe[k] * w1[(size_t)k * 256];
            b1p[ks * 1024 + lw * 256 + j] = s; }
    }
    __syncthreads();
    {
        LAS float* cl = (LAS float*)C.lds; const float* cin = (const float*)a->in[1];
        for (int i = C.tid; i < 16 * 1024; i += 512) { const int b = i >> 10, k = i & 1023; const float v = cin[i]; cl[k * 16 + b] = v / (1.0f + __expf(-v)); }
        __syncthreads();
        const float* aw = (const float*)a->in[3]; float* part = (float*)(ws + WS_PART);
        REPEAT(REP_PRO_D) for (int task = C.gw; task < 4 * 8 * 96; task += C.ngw) {
            const int ng = task % 96, lk = task / 96, ks = lk & 7, L = lk >> 3, col = ng * 64 + C.lane;
            const float* wp = aw + ((size_t)L * 1024 + ks * 128) * 6144 + col;
            float acc[16];
#pragma unroll
            for (int b = 0; b < 16; ++b) acc[b] = 0.f;
#pragma unroll 8
            for (int kk = 0; kk < 128; ++kk) { const float w = wp[(size_t)kk * 6144]; const LAS f32x4* cv = (const LAS f32x4*)(cl + (ks * 128 + kk) * 16);
#pragma unroll
                for (int q = 0; q < 4; ++q) { const f32x4 c4 = cv[q]; acc[4 * q] += c4[0] * w; acc[4 * q + 1] += c4[1] * w; acc[4 * q + 2] += c4[2] * w; acc[4 * q + 3] += c4[3] * w; } }
#pragma unroll
            for (int b = 0; b < 16; ++b) part[((size_t)(ks * 4 + L) * 16 + b) * 6144 + col] = acc[b];
        }
    }
}
__device__ __forceinline__ void phase_modfinal(ArgsP a, const Ctx& C) {
    const float* part = (const float*)(C.ws + WS_PART); const float* ab = (const float*)a->in[4]; float* mod = (float*)(C.ws + WS_MOD);
    for (int i = C.gw * 64 + C.lane; i < 4 * 16 * 6144; i += C.ngw * 64) { const int L = i / 98304, rem = i % 98304, n = rem % 6144;
        float s = ab[L * 6144 + n];
#pragma unroll
        for (int ks = 0; ks < 8; ++ks) s += part[(size_t)(ks * 4 + L) * 98304 + rem];
        mod[i] = s; }
    const float* b1p = (const float*)(C.ws + WS_B1P); const float* b1 = (const float*)a->in[10]; float* b1f = (float*)(C.ws + WS_B1F);
    for (int i = C.gw * 64 + C.lane; i < 1024; i += C.ngw * 64) { float s = b1[i];
#pragma unroll 8
        for (int ks = 0; ks < 32; ++ks) s += b1p[ks * 1024 + i];
        b1f[i] = s; }
}

__device__ __forceinline__ void row_norm_mod(const f32x4 (&v)[4], float rstd, const float* gain, const float* sh, const float* sc, half_t* hrow, int lane) {
#pragma unroll
    for (int j = 0; j < 4; ++j) { const int c = 4 * lane + 256 * j;
        const f32x4 g = *(const f32x4*)(gain + c), s1 = *(const f32x4*)(sc + c), s0 = *(const f32x4*)(sh + c);
        const f32x4 h = (v[j] * rstd * g) * (s1 + 1.0f) + s0;
        *(u32x2*)(hrow + c) = pk4(h); }
}

constexpr int ROW_RB = 4;
__device__ __forceinline__ float sumsq4(const f32x4 (&v)[4]) { float s = 0.f;
#pragma unroll
    for (int j = 0; j < 4; ++j) s += (v[j][0] * v[j][0] + v[j][1] * v[j][1]) + (v[j][2] * v[j][2] + v[j][3] * v[j][3]);
    return s; }
__device__ __forceinline__ f32x4 h4f(const h4 h) { return (f32x4){(float)h[0], (float)h[1], (float)h[2], (float)h[3]}; }
__device__ __forceinline__ void phase_row_first(ArgsP a, const Ctx& C) {
    const float* x = (const float*)a->in[0]; const float* ng = (const float*)a->in[5]; const float* mod = (const float*)(C.ws + WS_MOD); half_t* H = (half_t*)(C.ws + WS_H);
    const int rpw = M / C.ngw, row0 = C.gw * rpw, b = row0 >> 11;
    const float* mb = mod + (size_t)b * 6144;
    f32x4 vg[4], vsh[4], vsc[4];
#pragma unroll
    for (int j = 0; j < 4; ++j) { const int c = 4 * C.lane + 256 * j; vg[j] = *(const f32x4*)(ng + c); vsh[j] = *(const f32x4*)(mb + c); vsc[j] = *(const f32x4*)(mb + 1024 + c) + 1.0f; }
    for (int r0 = 0; r0 < rpw; r0 += ROW_RB) {
        f32x4 v[ROW_RB][4];
#pragma unroll
        for (int q = 0; q < ROW_RB; ++q)
#pragma unroll
            for (int j = 0; j < 4; ++j) v[q][j] = *(const f32x4*)(x + (size_t)(row0 + r0 + q) * D + 4 * C.lane + 256 * j);
#pragma unroll
        for (int q = 0; q < ROW_RB; ++q) {
            const float rstd = 1.0f / sqrtf(wave_sum(sumsq4(v[q]), C.lane) * (1.0f / D) + NORM_EPS);
#pragma unroll
            for (int j = 0; j < 4; ++j) *(u32x2*)(H + (size_t)(row0 + r0 + q) * D + 4 * C.lane + 256 * j) = pk4((v[q][j] * rstd * vg[j]) * vsc[j] + vsh[j]);
        }
    }
}
__device__ __forceinline__ void phase_row_update(ArgsP a, const Ctx& C, int L, int which) {
    const float* ng = (const float*)a->in[5]; const float* mod = (const float*)(C.ws + WS_MOD);
    const half_t* Y = (const half_t*)(C.ws + (which ? WS_Y2 : WS_Y)); half_t* H = (half_t*)(C.ws + WS_H); half_t* X16 = (half_t*)(C.ws + WS_X16);
    const bool first = (L == 0 && which == 0), last = (which == 1 && L == DEPTH - 1);
    const float* xin32 = (const float*)a->in[0]; float* xout32 = (float*)a->out;
    const int Lh = which ? L + 1 : L;
    const int rpw = M / C.ngw, row0 = C.gw * rpw, b = row0 >> 11;
    const float* gy = ng + (size_t)(L * 4 + (which ? 3 : 1)) * D;
    const float* gh = ng + (size_t)((last ? L : Lh) * 4 + (which ? 0 : 2)) * D;
    const float* mg = mod + ((size_t)L * 16 + b) * 6144 + (which ? 5 : 2) * 1024;
    const float* mh = mod + ((size_t)(last ? L : Lh) * 16 + b) * 6144 + (which ? 0 : 3) * 1024;
    f32x4 wy[4], vg[4], vsh[4], vsc[4];
#pragma unroll
    for (int j = 0; j < 4; ++j) { const int c = 4 * C.lane + 256 * j; wy[j] = (*(const f32x4*)(mg + c) + 1.0f) * *(const f32x4*)(gy + c);
        vg[j] = *(const f32x4*)(gh + c); vsh[j] = *(const f32x4*)(mh + c); vsc[j] = *(const f32x4*)(mh + 1024 + c) + 1.0f; }
    for (int r0 = 0; r0 < rpw; r0 += ROW_RB) {
        h4 yh[ROW_RB][4]; f32x4 xv[ROW_RB][4];
#pragma unroll
        for (int q = 0; q < ROW_RB; ++q)
#pragma unroll
            for (int j = 0; j < 4; ++j) { const size_t o = (size_t)(row0 + r0 + q) * D + 4 * C.lane + 256 * j; yh[q][j] = *(const h4*)(Y + o);
                if (first) xv[q][j] = *(const f32x4*)(xin32 + o); else xv[q][j] = h4f(*(const h4*)(X16 + o)); }
#pragma unroll
        for (int q = 0; q < ROW_RB; ++q) {
            f32x4 y[4];
#pragma unroll
            for (int j = 0; j < 4; ++j) y[j] = h4f(yh[q][j]);
            const float r1 = 1.0f / sqrtf(wave_sum(sumsq4(y), C.lane) * (1.0f / D) + NORM_EPS);
#pragma unroll
            for (int j = 0; j < 4; ++j) { const size_t o = (size_t)(row0 + r0 + q) * D + 4 * C.lane + 256 * j;
                xv[q][j] = xv[q][j] + wy[j] * (y[j] * r1);
                if (last) *(f32x4*)(xout32 + o) = xv[q][j]; else *(u32x2*)(X16 + o) = pk4(xv[q][j]); }
            if (!last) { const float r2 = 1.0f / sqrtf(wave_sum(sumsq4(xv[q]), C.lane) * (1.0f / D) + NORM_EPS);
#pragma unroll
                for (int j = 0; j < 4; ++j) *(u32x2*)(H + (size_t)(row0 + r0 + q) * D + 4 * C.lane + 256 * j) = pk4((xv[q][j] * r2 * vg[j]) * vsc[j] + vsh[j]); }
        }
    }
}

__device__ __forceinline__ void phase_cmp2(ArgsP a, const Ctx& C, int la) {
    const half_t* HC = (const half_t*)(C.ws + WS_HIDC); half_t* KCC = (half_t*)(C.ws + WS_KCC);
    const int r32 = C.lane & 31, hi = C.lane >> 5;
    for (int task = C.gw; task < 512; task += C.ngw) {
        const int R0 = task * 32, which = R0 >> 13;
        const half_t* W2 = (const half_t*)(C.ws + WS_W2T) + (size_t)(la * 2 + which) * 64 * 256;
        const float* b2 = (const float*)a->in[12] + (la * 2 + which) * 64;
        f32x16 acc[2]; acc[0] = (f32x16){}; acc[1] = (f32x16){};
        const half_t* ap = HC + (size_t)(R0 + r32) * 256 + hi * 8;
#pragma unroll 4
        for (int ks = 0; ks < 16; ++ks) {
            const h8 af = *(const h8*)(ap + ks * 16);
            const h8 w0 = *(const h8*)(W2 + (size_t)r32 * 256 + ks * 16 + hi * 8), w1 = *(const h8*)(W2 + (size_t)(32 + r32) * 256 + ks * 16 + hi * 8);
            acc[0] = __builtin_amdgcn_mfma_f32_32x32x16_f16(w0, af, acc[0], 0, 0, 0);
            acc[1] = __builtin_amdgcn_mfma_f32_32x32x16_f16(w1, af, acc[1], 0, 0, 0);
        }
        const int row = R0 + r32; const bool dead = (row & 127) == 127;
#pragma unroll
        for (int ct = 0; ct < 2; ++ct)
#pragma unroll
            for (int rg = 0; rg < 4; ++rg) { const int oc = 32 * ct + 8 * rg + 4 * hi; const f32x4 bb = *(const f32x4*)(b2 + oc);
                f32x4 v = {acc[ct][4 * rg] + bb[0], acc[ct][4 * rg + 1] + bb[1], acc[ct][4 * rg + 2] + bb[2], acc[ct][4 * rg + 3] + bb[3]};
                if (dead) v = (f32x4){0.f, 0.f, 0.f, 0.f};
                *(u32x2*)(KCC + (size_t)row * 64 + oc) = pk4(v); }
    }
}

constexpr int AL_K = 0, AL_V = 16384, AL_PSUM = 32768, AL_W = 65536;
__device__ __forceinline__ int crow(int r, int hi) { return (r & 3) + 8 * (r >> 2) + 4 * hi; }
__device__ __forceinline__ void kv_load(const half_t* Kt, const half_t* Vt, int wave, int lane, u32x4& kr, u32x4& vr) {
    kr = *(const u32x4*)(Kt + (size_t)lane * 64 + wave * 8);
    vr = *(const u32x4*)(Vt + (size_t)(16 * (wave & 3) + (lane >> 2)) * 64 + (wave >> 2) * 32 + (lane & 3) * 8);
}
__device__ __forceinline__ void kv_store(LAS unsigned char* Kb, LAS unsigned char* Vb, int wave, int lane, const u32x4 kr, const u32x4 vr) {
    *(LAS u32x4*)(Kb + wave * 1024 + lane * 16) = kr;
    *(LAS u32x4*)(Vb + (wave >> 2) * 4096 + (16 * (wave & 3) + (lane >> 2)) * 64 + (lane & 3) * 16) = vr;
}
__device__ __forceinline__ void qk_tile(f32x16& p0, f32x16& p1, const LAS unsigned char* Kb, const h8 (&qf)[4], int r32, int hi) {
    p0 = (f32x16){}; p1 = (f32x16){};
#pragma unroll
    for (int d0 = 0; d0 < 4; ++d0) {
        const h8 k0 = *(const LAS h8*)(Kb + (2 * d0 + hi) * 1024 + r32 * 16), k1 = *(const LAS h8*)(Kb + (2 * d0 + hi) * 1024 + (32 + r32) * 16);
        p0 = __builtin_amdgcn_mfma_f32_32x32x16_f16(k0, qf[d0], p0, 0, 0, 0);
        p1 = __builtin_amdgcn_mfma_f32_32x32x16_f16(k1, qf[d0], p1, 0, 0, 0);
    }
}
__device__ __forceinline__ s16x4 tr_read(const LAS unsigned char* p) { return __builtin_amdgcn_ds_read_tr16_b64_v4i16((LAS s16x4*)p); }
__device__ __forceinline__ h8 p8(const f32x16& p, int base) {
    return (h8){(half_t)p[base], (half_t)p[base + 1], (half_t)p[base + 2], (half_t)p[base + 3], (half_t)p[base + 4], (half_t)p[base + 5], (half_t)p[base + 6], (half_t)p[base + 7]};
}
__device__ __forceinline__ void pv_tile(f32x16 (&o)[2], const LAS unsigned char* Vb, const f32x16& p0, const f32x16& p1, int lane) {
    const int hi = lane >> 5;
    const LAS unsigned char* va = Vb + ((lane >> 4) & 1) * 32 + (lane & 3) * 8 + (4 * hi + ((lane & 15) >> 2)) * 64;
    h8 pf[4]; pf[0] = p8(p0, 0); pf[1] = p8(p0, 8); pf[2] = p8(p1, 0); pf[3] = p8(p1, 8);
#pragma unroll
    for (int dh = 0; dh < 2; ++dh)
#pragma unroll
        for (int s = 0; s < 4; ++s) {
            const s16x4 lo = tr_read(va + dh * 4096 + s * 1024), hh = tr_read(va + dh * 4096 + s * 1024 + 512);
            typedef short s16x8 __attribute__((ext_vector_type(8)));
            const s16x8 t8 = {lo[0], lo[1], lo[2], lo[3], hh[0], hh[1], hh[2], hh[3]};
            const h8 vf = __builtin_bit_cast(h8, t8);
            o[dh] = __builtin_amdgcn_mfma_f32_32x32x16_f16(vf, pf[s], o[dh], 0, 0, 0);
        }
}
__device__ __forceinline__ float max16(const f32x16& p) {
    float a = fmaxf(fmaxf(p[0], p[1]), fmaxf(p[2], p[3])), b = fmaxf(fmaxf(p[4], p[5]), fmaxf(p[6], p[7]));
    float c = fmaxf(fmaxf(p[8], p[9]), fmaxf(p[10], p[11])), d = fmaxf(fmaxf(p[12], p[13]), fmaxf(p[14], p[15]));
    return fmaxf(fmaxf(a, b), fmaxf(c, d));
}
__device__ __forceinline__ float sum16(const f32x16& p) {
    return (((p[0] + p[1]) + (p[2] + p[3])) + ((p[4] + p[5]) + (p[6] + p[7]))) + (((p[8] + p[9]) + (p[10] + p[11])) + ((p[12] + p[13]) + (p[14] + p[15])));
}

enum { MODE_WIN = 0, MODE_SEL = 1, MODE_SWA = 2 };
template <int MODE>
__device__ __forceinline__ void attn_unit(const Ctx& C, int b, int hkv, int chunk, const half_t* Q, const half_t* Kh, const half_t* Vh,
                                          const unsigned* selm, const float* Gt, float* Oacc, half_t* O, const float* sinks) {
    constexpr int GH = (MODE == MODE_SWA) ? 8 : 4, TPW = 32 / GH, TPB = 8 * TPW, WIN = (MODE == MODE_SWA) ? 128 : 512;
    const int lane = C.lane, wave = C.wave, r32 = lane & 31, hi = lane >> 5;
    const int t0 = chunk * TPB, tw0 = t0 + wave * TPW, tok = tw0 + r32 / GH, head = hkv * GH + (r32 % GH);
    const size_t gtok = (size_t)b * S + tok;
    LAS unsigned char* lds = C.lds;
    h8 qf[4];
#pragma unroll
    for (int d0 = 0; d0 < 4; ++d0) qf[d0] = *(const h8*)(Q + gtok * D + head * 64 + d0 * 16 + hi * 8);
    const int jlast = (t0 + TPB - 1) >> 6;
    unsigned tiles, msk = 0u, wneed = 0u;
    if (MODE == MODE_SEL) {
        msk = selm[tok]; unsigned x = msk;
#pragma unroll
        for (int o = 1; o < 64; o <<= 1) x |= (unsigned)shxi((int)x, o, lane);
        wneed = (unsigned)__builtin_amdgcn_readfirstlane((int)x);
        LAS unsigned* bw = (LAS unsigned*)(lds + AL_W);
        if (C.tid == 0) bw[0] = 0u;
        __syncthreads();
        if (lane == 0) __hip_atomic_fetch_or(bw, wneed, __ATOMIC_RELAXED, __HIP_MEMORY_SCOPE_WORKGROUP);
        __syncthreads();
        tiles = bw[0];
        tiles = (unsigned)__builtin_amdgcn_readfirstlane((int)tiles);
    } else {
        const int kfirst = t0 - WIN + 1, jlo = (kfirst > 0 ? kfirst : 0) >> 6;
        tiles = (jlast >= 31 ? 0xffffffffu : ((1u << (jlast + 1)) - 1u)) & ~((1u << jlo) - 1u);
    }
    float m = NEG_BIG, l = 0.f; f32x16 o[2]; o[0] = (f32x16){}; o[1] = (f32x16){};
    u32x4 kr, vr; int buf = 0;
    unsigned tm = tiles;
    { const int j = __builtin_ctz(tm); kv_load(Kh + (size_t)j * 4096, Vh + (size_t)j * 4096, wave, lane, kr, vr); kv_store(lds + AL_K, lds + AL_V, wave, lane, kr, vr); }
    __syncthreads();
    while (tm) {
        const int j = __builtin_ctz(tm); tm &= tm - 1u;
        const bool more = tm != 0u;
        if (more) { const int jn = __builtin_ctz(tm); kv_load(Kh + (size_t)jn * 4096, Vh + (size_t)jn * 4096, wave, lane, kr, vr); }
        bool need;
        if (MODE == MODE_SEL) need = (wneed >> j) & 1u;
        else need = (64 * j <= tw0 + TPW - 1) && (64 * j + 63 >= tw0 - WIN + 1);
        if (need) {
            f32x16 p0, p1; qk_tile(p0, p1, lds + AL_K + buf * 8192, qf, r32, hi);
            const bool rowok = (MODE == MODE_SEL) ? (((msk >> j) & 1u) != 0u) : true;
            float tmax = NEG_BIG;
#pragma unroll
            for (int r = 0; r < 16; ++r) { const int k0 = 64 * j + crow(r, hi), k1 = k0 + 32;
                const bool v0 = rowok && (k0 <= tok) && (MODE == MODE_SEL || k0 > tok - WIN), v1 = rowok && (k1 <= tok) && (MODE == MODE_SEL || k1 > tok - WIN);
                p0[r] = v0 ? p0[r] : NEG_BIG; p1[r] = v1 ? p1[r] : NEG_BIG; tmax = fmaxf(tmax, fmaxf(p0[r], p1[r])); }
            tmax = fmaxf(tmax, shx(tmax, 32, lane));
            const float mn = fmaxf(m, tmax), alpha = fast_exp2(m - mn);
            m = mn;
#pragma unroll
            for (int r = 0; r < 16; ++r) { p0[r] = (p0[r] > -1.0e29f) ? fast_exp2(p0[r] - mn) : 0.f; p1[r] = (p1[r] > -1.0e29f) ? fast_exp2(p1[r] - mn) : 0.f; }
            l = l * alpha + (sum16(p0) + sum16(p1));
#pragma unroll
            for (int r = 0; r < 16; ++r) { o[0][r] *= alpha; o[1][r] *= alpha; }
            pv_tile(o, lds + AL_V + buf * 8192, p0, p1, lane);
        }
        if (more) kv_store(lds + AL_K + (buf ^ 1) * 8192, lds + AL_V + (buf ^ 1) * 8192, wave, lane, kr, vr);
        __syncthreads();
        buf ^= 1;
    }
    float lt = l + shx(l, 32, lane);
    if (MODE == MODE_SWA) lt += fast_exp2(sinks[head] * LOG2E - m);
    float sc = 1.0f / lt;
    if (MODE != MODE_SWA) sc *= Gt[gtok * 48 + head * 3 + (MODE == MODE_SEL ? 1 : 2)];
#pragma unroll
    for (int dh = 0; dh < 2; ++dh)
#pragma unroll
        for (int rg = 0; rg < 4; ++rg) { const size_t off = gtok * D + head * 64 + 32 * dh + 8 * rg + 4 * hi;
            f32x4 v = {o[dh][4 * rg] * sc, o[dh][4 * rg + 1] * sc, o[dh][4 * rg + 2] * sc, o[dh][4 * rg + 3] * sc};
            if (MODE == MODE_SEL) { *(f32x4*)(Oacc + off) = *(const f32x4*)(Oacc + off) + v; }
            else { if (MODE == MODE_WIN) v = v + *(const f32x4*)(Oacc + off); *(u32x2*)(O + off) = pk4(v); } }
}

__device__ __forceinline__ void cmp_unit(const Ctx& C, int b, int hkv, int c, const half_t* Q, const half_t* Kc, const half_t* Vc, const float* Gt, float* Oacc, unsigned* selm) {
    const int lane = C.lane, wave = C.wave, r32 = lane & 31, hi = lane >> 5;
    const int t0 = c * 64, tl = wave * 8 + (r32 >> 2), tok = t0 + tl, head = hkv * 4 + (r32 & 3);
    const size_t gtok = (size_t)b * S + tok;
    LAS unsigned char* lds = C.lds;
    h8 qf[4];
#pragma unroll
    for (int d0 = 0; d0 < 4; ++d0) qf[d0] = *(const h8*)(Q + gtok * D + head * 64 + d0 * 16 + hi * 8);
    { u32x4 kr, vr;
      kv_load(Kc, Vc, wave, lane, kr, vr); kv_store(lds + AL_K, lds + AL_V, wave, lane, kr, vr);
      kv_load(Kc + 4096, Vc + 4096, wave, lane, kr, vr); kv_store(lds + AL_K + 8192, lds + AL_V + 8192, wave, lane, kr, vr); }
    __syncthreads();
    f32x16 p[4];
    qk_tile(p[0], p[1], lds + AL_K, qf, r32, hi); qk_tile(p[2], p[3], lds + AL_K + 8192, qf, r32, hi);
    const int nvis = (tok >= 31) ? ((tok - 31) >> 4) + 1 : 0;
    float mx = NEG_BIG;
#pragma unroll
    for (int q = 0; q < 4; ++q)
#pragma unroll
        for (int r = 0; r < 16; ++r) { const int n = 32 * q + crow(r, hi); p[q][r] = (n < nvis) ? p[q][r] : NEG_BIG; mx = fmaxf(mx, p[q][r]); }
    mx = fmaxf(mx, shx(mx, 32, lane));
    float l = 0.f;
#pragma unroll
    for (int q = 0; q < 4; ++q) {
#pragma unroll
        for (int r = 0; r < 16; ++r) p[q][r] = (p[q][r] > -1.0e29f) ? fast_exp2(p[q][r] - mx) : 0.f;
        l += sum16(p[q]); }
    l += shx(l, 32, lane);
    const float inv = (l > 0.f) ? 1.0f / l : 0.f;
#pragma unroll
    for (int q = 0; q < 4; ++q)
#pragma unroll
        for (int r = 0; r < 16; ++r) p[q][r] *= inv;
    f32x16 o[2]; o[0] = (f32x16){}; o[1] = (f32x16){};
    pv_tile(o, lds + AL_V, p[0], p[1], lane); pv_tile(o, lds + AL_V + 8192, p[2], p[3], lane);
    const float g0 = Gt[gtok * 48 + head * 3 + 0];
#pragma unroll
    for (int dh = 0; dh < 2; ++dh)
#pragma unroll
        for (int rg = 0; rg < 4; ++rg) { const size_t off = gtok * D + head * 64 + 32 * dh + 8 * rg + 4 * hi;
            *(f32x4*)(Oacc + off) = (f32x4){o[dh][4 * rg] * g0, o[dh][4 * rg + 1] * g0, o[dh][4 * rg + 2] * g0, o[dh][4 * rg + 3] * g0}; }
    LAS float* ps = (LAS float*)(lds + AL_PSUM);
#pragma unroll
    for (int q = 0; q < 4; ++q)
#pragma unroll
        for (int rg = 0; rg < 4; ++rg) { f32x4 v = {p[q][4 * rg], p[q][4 * rg + 1], p[q][4 * rg + 2], p[q][4 * rg + 3]};
#pragma unroll
            for (int e = 0; e < 4; ++e) { v[e] += shx(v[e], 1, lane); v[e] += shx(v[e], 2, lane); }
            if ((r32 & 3) == 0) *(LAS f32x4*)(ps + tl * 128 + 32 * q + 8 * rg + 4 * hi) = v; }
    __syncthreads();
#pragma unroll 1
    for (int it = 0; it < 4; ++it) {
        const int tl2 = wave * 8 + 2 * it + hi, j = r32; const LAS float* pr = ps + tl2 * 128 + 4 * j;
        const f32x4 q4 = *(const LAS f32x4*)pr; const float pm1 = (j > 0) ? pr[-1] : 0.f;
        const float imp = pm1 + 2.0f * q4[0] + 2.0f * q4[1] + 2.0f * q4[2] + q4[3];
        const bool forced = (j == 0) || (j == c) || (j == c - 1);
        const float val = forced ? __builtin_inff() : ((j <= c) ? imp : -__builtin_inff());
        int rank = 0;
#pragma unroll 8
        for (int jj = 0; jj < 32; ++jj) { const float vv = shidx(val, (lane & 32) + jj); rank += (vv > val || (vv == val && jj < j)) ? 1 : 0; }
        const bool sel = (rank < 8) && (j <= c);
        const unsigned long long bal = __ballot(sel);
        if (r32 == 0) selm[t0 + tl2] = hi ? (unsigned)(bal >> 32) : (unsigned)bal;
    }
    __syncthreads();
}

#ifndef REP_CMPSTAGE
#define REP_CMPSTAGE 1
#endif
constexpr int RG_SLOT = 16384;
constexpr int FL_CMPK = 49152, FL_CMPV = 65536, FL_PSUM = 81920, FL_MASK = 114688, FL_WORD = 114944;
constexpr float ATT_THR = 8.0f, M_INIT = -64.0f;
__device__ __forceinline__ void glds16(const void* gsrc, unsigned lds_dst) { unsigned keep;
    asm volatile("s_mov_b32 %0, m0\n\ts_mov_b32 m0, %2\n\ts_nop 0\n\tglobal_load_lds_dwordx4 %1, off\n\ts_mov_b32 m0, %0" : "=&s"(keep) : "v"(gsrc), "s"(lds_dst) : "memory"); }
#define ATT_WAIT_BAR(N) asm volatile("s_waitcnt vmcnt(" #N ") lgkmcnt(0)\n\ts_barrier" ::: "memory")
__device__ __forceinline__ void dma_tile(const half_t* Kt, const half_t* Vt, unsigned slot, int wave, int lane) {
    glds16(Kt + (size_t)lane * 64 + wave * 8, (unsigned)__builtin_amdgcn_readfirstlane((int)(slot + wave * 1024)));
    glds16(Vt + (size_t)(16 * (wave & 3) + (lane >> 2)) * 64 + (wave >> 2) * 32 + (lane & 3) * 8, (unsigned)__builtin_amdgcn_readfirstlane((int)(slot + 8192 + wave * 1024)));
}
__device__ __forceinline__ float swapmax(float v) { auto rr = __builtin_amdgcn_permlane32_swap(__float_as_uint(v), __float_as_uint(v), false, false); return fmaxf(__uint_as_float(rr[0]), __uint_as_float(rr[1])); }
__device__ __forceinline__ float swapsum(float v) { auto rr = __builtin_amdgcn_permlane32_swap(__float_as_uint(v), __float_as_uint(v), false, false); return __uint_as_float(rr[0]) + __uint_as_float(rr[1]); }

__device__ __forceinline__ float max3f(float a, float b, float c) { return __builtin_fmaxf(__builtin_fmaxf(a, b), c); }
__device__ __forceinline__ void tile_x(const bool BOUNDARY, float& m, float& l, f32x16 (&o)[2], f32x16& p0, f32x16& p1, const h8 (&qf)[4], const LAS unsigned char* Kb,
                                       float rowbias, int kbase, int tok, int win, int lane) {
    const int r32 = lane & 31, hi = lane >> 5;
    const float ci = rowbias - m;
#pragma unroll
    for (int r = 0; r < 16; ++r) { p0[r] = ci; p1[r] = ci; }
    h8 kf[8];
#pragma unroll
    for (int d0 = 0; d0 < 4; ++d0) { kf[2 * d0] = *(const LAS h8*)(Kb + (2 * d0 + hi) * 1024 + r32 * 16); kf[2 * d0 + 1] = *(const LAS h8*)(Kb + (2 * d0 + hi) * 1024 + (32 + r32) * 16); }
    asm volatile("s_waitcnt lgkmcnt(0)" : "+v"(kf[0]), "+v"(kf[1]), "+v"(kf[2]), "+v"(kf[3]), "+v"(kf[4]), "+v"(kf[5]), "+v"(kf[6]), "+v"(kf[7]) :: "memory");
#pragma unroll
    for (int d0 = 0; d0 < 4; ++d0) {
        p0 = __builtin_amdgcn_mfma_f32_32x32x16_f16(kf[2 * d0], qf[d0], p0, 0, 0, 0);
        p1 = __builtin_amdgcn_mfma_f32_32x32x16_f16(kf[2 * d0 + 1], qf[d0], p1, 0, 0, 0);
    }
    if (BOUNDARY) {
        const int ub = tok - kbase - 4 * hi, lb = ub - win;
#pragma unroll
        for (int r = 0; r < 16; ++r) { const int cr = (r & 3) + 8 * (r >> 2);
            p0[r] = (cr <= ub && cr > lb) ? p0[r] : NEG_BIG; p1[r] = (cr + 32 <= ub && cr + 32 > lb) ? p1[r] : NEG_BIG; }
    }
    float ta = max3f(p0[0], p0[1], p0[2]), tb = max3f(p1[0], p1[1], p1[2]);
    ta = max3f(ta, p0[3], p0[4]); tb = max3f(tb, p1[3], p1[4]); ta = max3f(ta, p0[5], p0[6]); tb = max3f(tb, p1[5], p1[6]);
    ta = max3f(ta, p0[7], p0[8]); tb = max3f(tb, p1[7], p1[8]); ta = max3f(ta, p0[9], p0[10]); tb = max3f(tb, p1[9], p1[10]);
    ta = max3f(ta, p0[11], p0[12]); tb = max3f(tb, p1[11], p1[12]); ta = max3f(ta, p0[13], p0[14]); tb = max3f(tb, p1[13], p1[14]);
    const float tmax = swapmax(max3f(ta, tb, fmaxf(p0[15], p1[15])));
    if (__any(tmax > ATT_THR)) {
        const float dl = fmaxf(tmax, 0.f), f = fast_exp2(-dl);
        m += dl; l *= f;
#pragma unroll
        for (int r = 0; r < 16; ++r) { o[0][r] *= f; o[1][r] *= f; p0[r] -= dl; p1[r] -= dl; }
    }
#pragma unroll
    for (int r = 0; r < 16; ++r) p0[r] = fast_exp2(p0[r]);
}
__device__ __forceinline__ void tile_y(float& l, f32x16 (&o)[2], f32x16& p0, f32x16& p1, const LAS unsigned char* Vb, int lane) {
    typedef short s16x8 __attribute__((ext_vector_type(8)));
    const int hi = lane >> 5;
    const LAS unsigned char* va = Vb + ((lane >> 4) & 1) * 32 + (lane & 3) * 8 + (4 * hi + ((lane & 15) >> 2)) * 64;
    s16x4 vlo[8], vhi[8];
#pragma unroll
    for (int i = 0; i < 8; ++i) { vlo[i] = tr_read(va + (i >> 2) * 4096 + (i & 3) * 1024); vhi[i] = tr_read(va + (i >> 2) * 4096 + (i & 3) * 1024 + 512); }
#pragma unroll
    for (int r = 0; r < 16; ++r) p1[r] = fast_exp2(p1[r]);
    f32x2 s2 = {0.f, 0.f};
#pragma unroll
    for (int r = 0; r < 16; r += 2) { s2 += (f32x2){p0[r], p0[r + 1]}; s2 += (f32x2){p1[r], p1[r + 1]}; }
    l += s2[0] + s2[1];
    h8 pf[4]; pf[0] = p8(p0, 0); pf[1] = p8(p0, 8); pf[2] = p8(p1, 0); pf[3] = p8(p1, 8);
    asm volatile("s_waitcnt lgkmcnt(0)" : "+v"(vlo[0]), "+v"(vlo[1]), "+v"(vlo[2]), "+v"(vlo[3]), "+v"(vlo[4]), "+v"(vlo[5]), "+v"(vlo[6]), "+v"(vlo[7]),
                 "+v"(vhi[0]), "+v"(vhi[1]), "+v"(vhi[2]), "+v"(vhi[3]), "+v"(vhi[4]), "+v"(vhi[5]), "+v"(vhi[6]), "+v"(vhi[7]) :: "memory");
#pragma unroll
    for (int s = 0; s < 4; ++s)
#pragma unroll
        for (int dh = 0; dh < 2; ++dh) { const int i = dh * 4 + s;
            const s16x8 t8 = {vlo[i][0], vlo[i][1], vlo[i][2], vlo[i][3], vhi[i][0], vhi[i][1], vhi[i][2], vhi[i][3]};
            o[dh] = __builtin_amdgcn_mfma_f32_32x32x16_f16(__builtin_bit_cast(h8, t8), pf[s], o[dh], 0, 0, 0); }
}
#define ATT_BAR_L() asm volatile("s_waitcnt lgkmcnt(0)\n\ts_barrier" ::: "memory")
#define ATT_BAR_V(two_more) do { if (two_more) ATT_WAIT_BAR(2); else ATT_WAIT_BAR(0); } while (0)

__device__ __forceinline__ void nsa_unit(const Ctx& C, int b, int hkv, int c, const half_t* Q, const half_t* KV, const half_t* KCC, const float* Gt, half_t* O) {
    const int lane = C.lane, wave = C.wave, r32 = lane & 31, hi = lane >> 5;
    const int bh = b * 4 + hkv, t0 = c * 64, tw0 = t0 + wave * 8, tl = wave * 8 + (r32 >> 2), tok = t0 + tl, head = hkv * 4 + (r32 & 3);
    const size_t gtok = (size_t)b * S + tok;
    LAS unsigned char* lds = C.lds;
    const unsigned ring = (unsigned)(size_t)lds;
    const half_t* Ks = KV + 2 * KVT + (size_t)bh * S * 64; const half_t* Vs = KV + 3 * KVT + (size_t)bh * S * 64;
    const half_t* Kw = KV + 4 * KVT + (size_t)bh * S * 64; const half_t* Vw = KV + 5 * KVT + (size_t)bh * S * 64;
    const int jlo = (c > 8) ? c - 8 : 0, n_win = c - jlo + 1;
    asm volatile("s_waitcnt vmcnt(0)" ::: "memory");
    dma_tile(Kw + (size_t)jlo * 4096, Vw + (size_t)jlo * 4096, ring, wave, lane);
    if (n_win >= 2) dma_tile(Kw + (size_t)(jlo + 1) * 4096, Vw + (size_t)(jlo + 1) * 4096, ring + RG_SLOT, wave, lane);
    h8 qf[4];
#pragma unroll
    for (int d0 = 0; d0 < 4; ++d0) qf[d0] = *(const h8*)(Q + gtok * D + head * 64 + d0 * 16 + hi * 8);
    const float g_cmp = Gt[gtok * 48 + head * 3 + 0], g_sel = Gt[gtok * 48 + head * 3 + 1], g_win = Gt[gtok * 48 + head * 3 + 2];
    f32x16 oc[2];
    REPEAT(REP_CMPSTAGE) {
        const half_t* Kc = KCC + (size_t)bh * 128 * 64; const half_t* Vc = Kc + (size_t)64 * 128 * 64;
        { u32x4 kr, vr;
          kv_load(Kc, Vc, wave, lane, kr, vr); kv_store(lds + FL_CMPK, lds + FL_CMPV, wave, lane, kr, vr);
          kv_load(Kc + 4096, Vc + 4096, wave, lane, kr, vr); kv_store(lds + FL_CMPK + 8192, lds + FL_CMPV + 8192, wave, lane, kr, vr); }
        if (C.tid == 0) ((LAS unsigned*)(lds + FL_WORD))[0] = 0u;
        __syncthreads();
        f32x16 p[4];
        qk_tile(p[0], p[1], lds + FL_CMPK, qf, r32, hi); qk_tile(p[2], p[3], lds + FL_CMPK + 8192, qf, r32, hi);
        const int nvis = ((tok >= 31) ? ((tok - 31) >> 4) + 1 : 0) - 4 * hi;
        float mx = NEG_BIG;
#pragma unroll
        for (int q = 0; q < 4; ++q)
#pragma unroll
            for (int r = 0; r < 16; ++r) { const int cn = 32 * q + (r & 3) + 8 * (r >> 2); p[q][r] = (cn < nvis) ? p[q][r] : NEG_BIG; mx = fmaxf(mx, p[q][r]); }
        mx = swapmax(mx);
        float l = 0.f;
#pragma unroll
        for (int q = 0; q < 4; ++q) {
#pragma unroll
            for (int r = 0; r < 16; ++r) p[q][r] = (p[q][r] > -1.0e29f) ? fast_exp2(p[q][r] - mx) : 0.f;
            l += sum16(p[q]); }
        l = swapsum(l);
        const float inv = (l > 0.f) ? 1.0f / l : 0.f;
#pragma unroll
        for (int q = 0; q < 4; ++q)
#pragma unroll
            for (int r = 0; r < 16; ++r) p[q][r] *= inv;
        oc[0] = (f32x16){}; oc[1] = (f32x16){};
        pv_tile(oc, lds + FL_CMPV, p[0], p[1], lane); pv_tile(oc, lds + FL_CMPV + 8192, p[2], p[3], lane);
#pragma unroll
        for (int r = 0; r < 16; ++r) { oc[0][r] *= g_cmp; oc[1][r] *= g_cmp; }
        LAS float* ps = (LAS float*)(lds + FL_PSUM);
#pragma unroll
        for (int q = 0; q < 4; ++q)
#pragma unroll
            for (int rg = 0; rg < 4; ++rg) { f32x4 v = {p[q][4 * rg], p[q][4 * rg + 1], p[q][4 * rg + 2], p[q][4 * rg + 3]};
#pragma unroll
                for (int e = 0; e < 4; ++e) { v[e] += shx(v[e], 1, lane); v[e] += shx(v[e], 2, lane); }
                if ((r32 & 3) == 0) *(LAS f32x4*)(ps + tl * 128 + 32 * q + 8 * rg + 4 * hi) = v; }
        __syncthreads();
        LAS unsigned* mk = (LAS unsigned*)(lds + FL_MASK); unsigned wor = 0u;
#pragma unroll 1
        for (int it = 0; it < 4; ++it) {
            const int tl2 = wave * 8 + 2 * it + hi, j = r32; const LAS float* pr = ps + tl2 * 128 + 4 * j;
            const f32x4 q4 = *(const LAS f32x4*)pr; const float pm1 = (j > 0) ? pr[-1] : 0.f;
            const float imp = pm1 + 2.0f * q4[0] + 2.0f * q4[1] + 2.0f * q4[2] + q4[3];
            const bool forced = (j == 0) || (j == c) || (j == c - 1);
            const float val = forced ? __builtin_inff() : ((j <= c) ? imp : -__builtin_inff());
            int rank = 0;
#pragma unroll 8
            for (int jj = 0; jj < 32; ++jj) { const float vv = shidx(val, (lane & 32) + jj); rank += (vv > val || (vv == val && jj < j)) ? 1 : 0; }
            const bool sel = (rank < 8) && (j <= c);
            const unsigned long long bal = __ballot(sel);
            const unsigned mine = hi ? (unsigned)(bal >> 32) : (unsigned)bal;
            if (r32 == 0) mk[tl2] = mine;
            wor |= (unsigned)bal | (unsigned)(bal >> 32);
        }
        if (lane == 0) __hip_atomic_fetch_or((LAS unsigned*)(lds + FL_WORD), wor, __ATOMIC_RELAXED, __HIP_MEMORY_SCOPE_WORKGROUP);
        __syncthreads();
    }
    const unsigned msk = ((const LAS unsigned*)(lds + FL_MASK))[tl];
    unsigned wneed = msk;
#pragma unroll
    for (int o_ = 1; o_ < 64; o_ <<= 1) wneed |= (unsigned)shxi((int)wneed, o_, lane);
    wneed = (unsigned)__builtin_amdgcn_readfirstlane((int)wneed);
    const unsigned bneed = (unsigned)__builtin_amdgcn_readfirstlane((int)((const LAS unsigned*)(lds + FL_WORD))[0]);
    const int n_tot = n_win + __builtin_popcount(bneed);
    unsigned dbits = bneed, cbits = bneed;
    if (n_win < 2 && n_tot >= 2) { const int j = __builtin_ctz(dbits); dbits &= dbits - 1u; dma_tile(Ks + (size_t)j * 4096, Vs + (size_t)j * 4096, ring + RG_SLOT, wave, lane); }
    float m = M_INIT, l = 0.f; f32x16 o[2]; o[0] = (f32x16){}; o[1] = (f32x16){};
    f32x16 p0, p1;
    int slot_c = 0, slot_d = 2;
#pragma unroll 1
    for (int e = 0; e < n_tot; ++e) {
        if (e + 1 < n_tot) ATT_WAIT_BAR(2); else ATT_WAIT_BAR(0);
        const LAS unsigned char* Kb = lds + slot_c * RG_SLOT; const LAS unsigned char* Vb = Kb + 8192;
        const bool is_win = e < n_win;
        int j; bool need, bnd; float rb = 0.f; int win = 512;
        if (is_win) { j = jlo + e; need = (64 * j <= tw0 + 7) && (64 * j + 63 >= tw0 - 511); bnd = (64 * j + 63 > tw0) || (64 * j <= tw0 + 7 - 512); }
        else { j = __builtin_ctz(cbits); cbits &= cbits - 1u; need = (wneed >> j) & 1u; bnd = (j == c); rb = ((msk >> j) & 1u) ? 0.f : NEG_BIG; win = 1 << 20; }
        if (e + 2 < n_tot) {
            if (e + 2 < n_win) { const int jn = jlo + e + 2; dma_tile(Kw + (size_t)jn * 4096, Vw + (size_t)jn * 4096, ring + slot_d * RG_SLOT, wave, lane); }
            else { const int jn = __builtin_ctz(dbits); dbits &= dbits - 1u; dma_tile(Ks + (size_t)jn * 4096, Vs + (size_t)jn * 4096, ring + slot_d * RG_SLOT, wave, lane); }
        }
        if (need) { tile_x(bnd, m, l, o, p0, p1, qf, Kb, rb, 64 * j, tok, win, lane); tile_y(l, o, p0, p1, Vb, lane); }
        if (e == n_win - 1) {
            const float sc = g_win / swapsum(l);
#pragma unroll
            for (int r = 0; r < 16; ++r) { oc[0][r] += o[0][r] * sc; oc[1][r] += o[1][r] * sc; o[0][r] = 0.f; o[1][r] = 0.f; }
            m = M_INIT; l = 0.f;
        }
        slot_c = (slot_c == 2) ? 0 : slot_c + 1; slot_d = (slot_d == 2) ? 0 : slot_d + 1;
    }
    {
        const float sc = g_sel / swapsum(l);
#pragma unroll
        for (int dh = 0; dh < 2; ++dh)
#pragma unroll
            for (int rg = 0; rg < 4; ++rg) { const size_t off = gtok * D + head * 64 + 32 * dh + 8 * rg + 4 * hi;
                const f32x4 v = {oc[dh][4 * rg] + o[dh][4 * rg] * sc, oc[dh][4 * rg + 1] + o[dh][4 * rg + 1] * sc, oc[dh][4 * rg + 2] + o[dh][4 * rg + 2] * sc, oc[dh][4 * rg + 3] + o[dh][4 * rg + 3] * sc};
                *(u32x2*)(O + off) = pk4(v); }
    }
    asm volatile("s_waitcnt lgkmcnt(0)\n\ts_barrier" ::: "memory");
}

__device__ __forceinline__ void swa_unit(const Ctx& C, int b, int hkv, int cc, const half_t* Q, const half_t* Kh, const half_t* Vh, const float* sinks, half_t* O) {
    const int lane = C.lane, wave = C.wave, r32 = lane & 31, hi = lane >> 5;
    const int t0 = cc * 32, tw0 = t0 + 4 * wave, tok = tw0 + (r32 >> 3), head = hkv * 8 + (r32 & 7);
    const size_t gtok = (size_t)b * S + tok;
    LAS unsigned char* lds = C.lds; const unsigned ring = (unsigned)(size_t)lds;
    const int jhi = (t0 + 31) >> 6, jlo = ((t0 > 127) ? (t0 - 127) : 0) >> 6, n_tot = jhi - jlo + 1;
    asm volatile("s_waitcnt vmcnt(0)" ::: "memory");
    dma_tile(Kh + (size_t)jlo * 4096, Vh + (size_t)jlo * 4096, ring, wave, lane);
    if (n_tot >= 2) dma_tile(Kh + (size_t)(jlo + 1) * 4096, Vh + (size_t)(jlo + 1) * 4096, ring + RG_SLOT, wave, lane);
    h8 qf[4];
#pragma unroll
    for (int d0 = 0; d0 < 4; ++d0) qf[d0] = *(const h8*)(Q + gtok * D + head * 64 + d0 * 16 + hi * 8);
    float m = M_INIT, l = 0.f; f32x16 o[2]; o[0] = (f32x16){}; o[1] = (f32x16){};
    const float sk = sinks[head] * LOG2E;
    f32x16 p0, p1;
#pragma unroll 1
    for (int e = 0; e < n_tot; ++e) {
        if (e + 1 < n_tot) ATT_WAIT_BAR(2); else ATT_WAIT_BAR(0);
        if (e + 2 < n_tot) dma_tile(Kh + (size_t)(jlo + 2) * 4096, Vh + (size_t)(jlo + 2) * 4096, ring + 2 * RG_SLOT, wave, lane);
        const int jt = jlo + e;
        const LAS unsigned char* Kb = lds + e * RG_SLOT; const LAS unsigned char* Vb = Kb + 8192;
        const bool need = (64 * jt <= tw0 + 3) && (64 * jt + 63 >= tw0 - 127), bnd = (64 * jt + 63 > tw0) || (64 * jt <= tw0 + 3 - 128);
        if (need) { tile_x(bnd, m, l, o, p0, p1, qf, Kb, 0.f, 64 * jt, tok, 128, lane); tile_y(l, o, p0, p1, Vb, lane); }
    }
    const float sc = 1.0f / (swapsum(l) + fast_exp2(sk - m));
#pragma unroll
    for (int dh = 0; dh < 2; ++dh)
#pragma unroll
        for (int rg = 0; rg < 4; ++rg) { const size_t off = gtok * D + head * 64 + 32 * dh + 8 * rg + 4 * hi;
            const f32x4 v = {o[dh][4 * rg] * sc, o[dh][4 * rg + 1] * sc, o[dh][4 * rg + 2] * sc, o[dh][4 * rg + 3] * sc};
            *(u32x2*)(O + off) = pk4(v); }
    asm volatile("s_waitcnt lgkmcnt(0)\n\ts_barrier" ::: "memory");
}

#ifndef EN_PRO
#define EN_PRO 1
#endif
#ifndef EN_ROW
#define EN_ROW 1
#endif
#ifndef EN_INPROJ
#define EN_INPROJ 1
#endif
#ifndef EN_CMP1
#define EN_CMP1 1
#endif
#ifndef EN_CMP2
#define EN_CMP2 1
#endif
#ifndef EN_CMPATT
#define EN_CMPATT 1
#endif
#ifndef EN_SEL
#define EN_SEL 1
#endif
#ifndef EN_WIN
#define EN_WIN 1
#endif
#ifndef EN_SWA
#define EN_SWA 1
#endif
#ifndef EN_OUT
#define EN_OUT 1
#endif
#ifndef EN_UP
#define EN_UP 1
#endif
#ifndef EN_DOWN
#define EN_DOWN 1
#endif
#ifndef REP_PRO
#define REP_PRO 1
#endif
#ifndef REP_ROWF
#define REP_ROWF 1
#endif
#ifndef REP_INPROJ
#define REP_INPROJ 1
#endif
#ifndef REP_CMP1
#define REP_CMP1 1
#endif
#ifndef REP_CMP2
#define REP_CMP2 1
#endif
#ifndef REP_NSA
#define REP_NSA 1
#endif
#ifndef REP_SWA
#define REP_SWA 1
#endif
#ifndef REP_OUT
#define REP_OUT 1
#endif
#ifndef REP_UP
#define REP_UP 1
#endif
#ifndef REP_DOWN
#define REP_DOWN 1
#endif
constexpr int NPHASE = 3 + 11 * DEPTH;
__host__ __device__ constexpr bool phase_exists(int p) { return p < 3 ? true : (((p - 3) / 11) % 2 == 0 ? !(((p - 3) % 11) == 4 || ((p - 3) % 11) == 5) : !(((p - 3) % 11) >= 1 && ((p - 3) % 11) <= 4)); }

__global__ void __launch_bounds__(512, 2) mk_fwd(Args a) {
    extern __shared__ __attribute__((aligned(16))) unsigned char lds_raw[];
    Ctx C;
    C.lds = (LAS unsigned char*)lds_raw;
    const int wave0 = __builtin_amdgcn_readfirstlane((int)(threadIdx.x >> 6));
    C.lane = (int)__builtin_amdgcn_mbcnt_hi(~0u, __builtin_amdgcn_mbcnt_lo(~0u, 0u)); C.wave = wave0; C.tid = wave0 * 64 + C.lane;
    C.G = gridDim.x; C.gw = blockIdx.x * 8 + C.wave; C.ngw = C.G * 8; C.ws = (unsigned char*)a.ws;
    GAS unsigned char* ws = a.ws;
    for (int u = C.tid; u < (LDS_BYTES - LDSCTL_OFF) / 4; u += 512) ((LAS unsigned*)(C.lds + LDSCTL_OFF))[u] = 0u;
    __syncthreads();
#if MK_ONE_LAUNCH
    XcdBarrier bar = xcd_barrier_post((unsigned*)(ws + WS_CTL) + CW_BAR, (volatile LAS unsigned*)(C.lds + MISC_OFF) + 8);
#define SEAM() xcd_barrier(bar)
#else
#define SEAM() do { } while (0)
#endif
    const int lo = a.ph_lo, hi = a.ph_hi;
#define RUN(p) (lo <= (p) && (p) < hi)
#define FRESH() Ctx Cp = C; ArgsP ap = (ArgsP)__builtin_amdgcn_kernarg_segment_ptr(); { int w_ = wave0; asm volatile("" : "+s"(w_), "+s"(ap)); int l_; asm volatile("v_mbcnt_lo_u32_b32 %0, -1, 0\n\tv_mbcnt_hi_u32_b32 %0, -1, %0" : "=v"(l_)); Cp.tid = w_ * 64 + l_; Cp.lane = l_; Cp.wave = w_; Cp.gw = blockIdx.x * 8 + w_; } GAS unsigned char* const wsx = ap->ws; Cp.ws = (unsigned char*)wsx; (void)wsx;
#define Hb ((half_t*)(wsx + WS_H))
#define Yb ((half_t*)(wsx + WS_Y))
#define Qb ((half_t*)(wsx + WS_Q))
#define KVb ((half_t*)(wsx + WS_KV))
#define Ob ((half_t*)(wsx + WS_O))
#define Gb ((float*)(wsx + WS_G))
#define HIDb ((half_t*)(wsx + WS_BIG))
#define ropeb ((const float*)(wsx + WS_ROPE))

    if (EN_PRO && RUN(0)) { FRESH(); REPEAT(REP_PRO) { phase_prologue(ap, Cp); __syncthreads(); } SEAM(); }
    if (EN_PRO && RUN(1)) { FRESH(); phase_modfinal(ap, Cp); SEAM(); }
    if (EN_ROW && RUN(2)) { FRESH(); REPEAT(REP_ROWF) phase_row_first(ap, Cp); SEAM(); }

#pragma unroll 1
    for (int L = 0; L < DEPTH; ++L) {
        const int pb = 3 + 11 * L, la = L >> 1; const bool nsa = (L & 1) == 0;
        if (EN_INPROJ && RUN(pb + 0)) { FRESH();
            if (nsa) { pg8::Gemm g{Hb, (const half_t*)(wsx + WS_WINN) + (size_t)la * NSA_INP * D, M, NSA_INP, D, D}; pg8::StaticOrder So; So.init(M, NSA_INP, C.G, (int)blockIdx.x);
                pg8::EpiNsaIn E{Qb, KVb, Gb, ropeb};
                REPEAT(REP_INPROJ) pg8::gemm_phase<pg8::EpiNsaIn, pg8::StaticOrder, true, true>(C.lds, g, So, E, Cp.tid);
            } else { pg8::Gemm g{Hb, (const half_t*)(wsx + WS_WINS) + (size_t)la * SWA_IN * D, M, SWA_IN, D, D}; pg8::StaticOrder So; So.init(M, SWA_IN, C.G, (int)blockIdx.x);
                pg8::EpiSwaIn E{Qb, KVb, ropeb};
                REPEAT(REP_INPROJ) pg8::gemm_phase<pg8::EpiSwaIn, pg8::StaticOrder, true, true>(C.lds, g, So, E, Cp.tid);
            }
            SEAM();
        }
        if (nsa) {
            if (EN_CMP1 && RUN(pb + 1)) { FRESH();
                pg8::Gemm g{KVb, (const half_t*)(wsx + WS_W1T) + (size_t)la * 512 * 2048, 16384, 512, 2048, 1024}; pg8::CmpOrder So{C.G, (int)blockIdx.x};
                pg8::EpiF16<2> E{(half_t*)(wsx + WS_HIDC), 256, (const float*)(wsx + WS_B1F) + la * 512};
                REPEAT(REP_CMP1) pg8::gemm_phase<pg8::EpiF16<2>, pg8::CmpOrder, true, true>(C.lds, g, So, E, Cp.tid);
                SEAM();
            }
            if (EN_CMP2 && RUN(pb + 2)) { FRESH(); REPEAT(REP_CMP2) phase_cmp2(ap, Cp, la); SEAM(); }
            if (EN_CMPATT && RUN(pb + 3)) { FRESH();
                REPEAT(REP_NSA) for (int u = blockIdx.x; u < NB * 4 * 32; u += C.G) { const int k = u & 255, i = u >> 8, bh = k >> 2, s_ = k & 3, a_ = 3 - (i >> 1), c = (i & 1) ? (8 * a_ + s_) : (8 * a_ + 7 - s_);
                    nsa_unit(Cp, bh >> 2, bh & 3, c, Qb, KVb, (const half_t*)(wsx + WS_KCC), Gb, Ob); }
                SEAM();
            }
        } else {
            if (EN_SWA && RUN(pb + 5)) { FRESH();
                const float* sinks = (const float*)ap->in[15] + la * 16;
                REPEAT(REP_SWA) for (int u = blockIdx.x; u < NB * 2 * 64; u += C.G) { const int j = 63 - (u & 63), bh = u >> 6;
                    swa_unit(Cp, bh >> 1, bh & 1, j, Qb, KVb + (size_t)bh * S * 64, KVb + (size_t)M * 128 + (size_t)bh * S * 64, sinks, Ob); }
                SEAM();
            }
        }
        if (EN_OUT && RUN(pb + 6)) { FRESH();
            pg8::Gemm g{Ob, (const half_t*)(wsx + WS_WOUT) + (size_t)L * D * D, M, D, D, D}; pg8::StaticOrder So; So.init(M, D, C.G, (int)blockIdx.x);
            pg8::EpiF16<0> E{Yb, D, nullptr};
            REPEAT(REP_OUT) pg8::gemm_phase<pg8::EpiF16<0>, pg8::StaticOrder, true, true>(C.lds, g, So, E, Cp.tid);
            SEAM();
        }
        if (EN_ROW && RUN(pb + 7)) { FRESH(); phase_row_update(ap, Cp, L, 0); SEAM(); }
        if (EN_UP && RUN(pb + 8)) { FRESH();
            pg8::Gemm g{Hb, (const half_t*)(wsx + WS_WUP) + (size_t)L * FF * D, M, FF, D, D}; pg8::StaticOrder So; So.init(M, FF, C.G, (int)blockIdx.x);
            pg8::EpiF16<1> E{HIDb, FF, nullptr};
            REPEAT(REP_UP) pg8::gemm_phase<pg8::EpiF16<1>, pg8::StaticOrder, true, true>(C.lds, g, So, E, Cp.tid);
            SEAM();
        }
        if (EN_DOWN && RUN(pb + 9)) { FRESH();
            pg8::Gemm g{HIDb, (const half_t*)(wsx + WS_WDN) + (size_t)L * D * FF, M, D, FF, FF}; pg8::StaticOrder So; So.init(M, D, C.G, (int)blockIdx.x);
            pg8::EpiF16<0> E{(half_t*)(wsx + WS_Y2), D, nullptr};
            REPEAT(REP_DOWN) pg8::gemm_phase<pg8::EpiF16<0>, pg8::StaticOrder, true, true>(C.lds, g, So, E, Cp.tid);
            SEAM();
        }
        if (EN_ROW && RUN(pb + 10)) { FRESH(); phase_row_update(ap, Cp, L, 1); if (L + 1 < DEPTH) SEAM(); }
    }
#undef RUN
#undef Hb
#undef Yb
#undef Qb
#undef KVb
#undef Ob
#undef Gb
#undef HIDb
#undef ropeb
#undef SEAM
}

extern "C" void kernel_launch(void* const* d_in, const int* in_sizes, int n_in, void* d_out, int out_size, void* d_ws, size_t ws_size, hipStream_t stream) {
    static int grid = 0;
    if (grid == 0) {
        if (n_in != 18 || in_sizes[0] != M * D || out_size != M * D || ws_size < WS_END) {
            fprintf(stderr, "kernel_launch: built for 18 inputs, x/out of %d floats, >= %zu bytes of workspace; got n_in %d, in0 %d, out %d, ws %zu; nothing launched\n", M * D, (size_t)WS_END, n_in, n_in > 0 ? in_sizes[0] : -1, out_size, ws_size);
            grid = -1; return; }
        int dev = 0, cus = 0, per_cu = 0;
        if (hipGetDevice(&dev) != hipSuccess || hipDeviceGetAttribute(&cus, hipDeviceAttributeMultiprocessorCount, dev) != hipSuccess) { fprintf(stderr, "kernel_launch: device query failed\n"); grid = -1; return; }
        if (hipFuncSetAttribute((const void*)mk_fwd, hipFuncAttributeMaxDynamicSharedMemorySize, LDS_BYTES) != hipSuccess) { fprintf(stderr, "kernel_launch: hipFuncSetAttribute failed\n"); grid = -1; return; }
        if (hipOccupancyMaxActiveBlocksPerMultiprocessor(&per_cu, (const void*)mk_fwd, 512, LDS_BYTES) != hipSuccess || per_cu < 1)
            fprintf(stderr, "kernel_launch: note: occupancy query reports %d workgroups per CU\n", per_cu);
        (void)hipGetLastError();
        if (cus < 256) { fprintf(stderr, "kernel_launch: built for a 256-CU device, found %d CUs; nothing launched\n", cus); grid = -1; return; }
        grid = 256;
    }
    if (grid < 0) return;
    if (hipMemsetAsync((char*)d_ws + WS_CTL, 0, CTL_ZERO_BYTES, stream) != hipSuccess) { fprintf(stderr, "kernel_launch: memset failed\n"); return; }
    Args a{};
    for (int i = 0; i < 18; ++i) a.in[i] = (const GAS void*)d_in[i];
    a.out = (GAS float*)d_out; a.ws = (GAS unsigned char*)d_ws;
#if MK_ONE_LAUNCH
    a.ph_lo = 0; a.ph_hi = NPHASE;
    hipLaunchKernelGGL(mk_fwd, dim3(grid), dim3(512), LDS_BYTES, stream, a);
#else
    for (int p = 0; p < NPHASE; ++p) { if (!phase_exists(p)) continue;
        a.ph_lo = p; a.ph_hi = p + 1;
        hipLaunchKernelGGL(mk_fwd, dim3(grid), dim3(512), LDS_BYTES, stream, a); }
#endif
    const hipError_t le = hipPeekAtLastError();
    if (le != hipSuccess) fprintf(stderr, "kernel_launch: launch failed: %s\n", hipGetErrorName(le));
}
```

```cpp
#include <hip/hip_runtime.h>
#include <cstdio>
#include <cstdint>

#ifndef MK_ONE_LAUNCH
#define MK_ONE_LAUNCH 1
#endif

#define LAS __attribute__((address_space(3)))
#define GAS __attribute__((address_space(1)))
typedef _Float16 half_t;
typedef _Float16 h8 __attribute__((ext_vector_type(8)));
typedef _Float16 h4 __attribute__((ext_vector_type(4)));
typedef _Float16 h2 __attribute__((ext_vector_type(2)));
typedef float f32x2 __attribute__((ext_vector_type(2)));
typedef float f32x4 __attribute__((ext_vector_type(4)));
typedef float f32x16 __attribute__((ext_vector_type(16)));
typedef unsigned u32x2 __attribute__((ext_vector_type(2)));
typedef unsigned u32x4 __attribute__((ext_vector_type(4)));
typedef short s16x4 __attribute__((ext_vector_type(4)));

constexpr int D = 1024, NB = 16, S = 2048, M = NB * S, DEPTH = 4, HD = 64, FF = 4096;
constexpr int NSA_IN = 2608, NSA_INP = 2816, SWA_IN = 1280;
constexpr int NCMP = 127;
constexpr float NORM_EPS = 1e-6f;
constexpr float LOG2E = 1.4426950408889634f;
constexpr float C2 = 0.125f * LOG2E;
constexpr float NEG_BIG = -1.0e30f;

constexpr size_t MiB = 1u << 20;
constexpr size_t WS_CTL = 0, CTL_ZERO_BYTES = 1 * MiB;
constexpr size_t WS_MOD  = 1 * MiB;
constexpr size_t WS_B1F  = 3 * MiB;
constexpr size_t WS_W2T  = 3 * MiB + 65536;
constexpr size_t WS_B1P  = 3 * MiB + 262144;
constexpr size_t WS_ROPE = 4 * MiB;
constexpr size_t WS_PART = 12 * MiB;
constexpr size_t WS_WINN = 24 * MiB;
constexpr size_t WS_WINS = 36 * MiB;
constexpr size_t WS_WOUT = 41 * MiB;
constexpr size_t WS_W1T  = 49 * MiB;
constexpr size_t WS_WUP  = 53 * MiB;
constexpr size_t WS_WDN  = 85 * MiB;
constexpr size_t WS_X16  = 117 * MiB;
constexpr size_t WS_Y    = 245 * MiB;
constexpr size_t WS_Y2   = 181 * MiB;
constexpr size_t WS_H    = 181 * MiB;
constexpr size_t WS_BIG  = 245 * MiB;
constexpr size_t WS_Q    = 245 * MiB;
constexpr size_t WS_KV   = 309 * MiB;
constexpr size_t WS_O    = 405 * MiB;
constexpr size_t WS_G    = 469 * MiB;
constexpr size_t WS_HIDC = 475 * MiB;
constexpr size_t WS_KCC  = 483 * MiB;
constexpr size_t WS_SELM = 485 * MiB;
constexpr size_t WS_END  = 501 * MiB;
constexpr size_t KVT = (size_t)M * 256;

constexpr int CW_BAR = 4096;

constexpr int RING_BYTES = 131072;
constexpr int LDSCTL_OFF = RING_BYTES, MISC_OFF = LDSCTL_OFF + 320;
constexpr int LDS_BYTES = 147456;

__device__ __forceinline__ unsigned pkh2(float lo, float hi) { h2 p = {(half_t)lo, (half_t)hi}; return __builtin_bit_cast(unsigned, p); }
__device__ __forceinline__ u32x2 pk4(const f32x4 v) { u32x2 w; w.x = pkh2(v[0], v[1]); w.y = pkh2(v[2], v[3]); return w; }
__device__ __forceinline__ float fast_exp2(float x) { return __builtin_amdgcn_exp2f(x); }
__device__ __forceinline__ float fast_rcp(float x) { return __builtin_amdgcn_rcpf(x); }
__device__ __forceinline__ float shx(float v, int o, int lane) { return __builtin_bit_cast(float, __builtin_amdgcn_ds_bpermute((lane ^ o) << 2, __builtin_bit_cast(int, v))); }
__device__ __forceinline__ int shxi(int v, int o, int lane) { return __builtin_amdgcn_ds_bpermute((lane ^ o) << 2, v); }
__device__ __forceinline__ float shidx(float v, int src) { return __builtin_bit_cast(float, __builtin_amdgcn_ds_bpermute(src << 2, __builtin_bit_cast(int, v))); }
__device__ __forceinline__ float wave_sum(float v, int lane) {
#pragma unroll
    for (int o = 1; o < 64; o <<= 1) v += shx(v, o, lane);
    return v;
}

namespace pg8 {
#define PG8_LAS __attribute__((address_space(3)))
typedef _Float16 bf16_t;
typedef _Float16 bf16x8 __attribute__((ext_vector_type(8)));
typedef float f32x4 __attribute__((ext_vector_type(4)));
typedef unsigned u32x4 __attribute__((ext_vector_type(4)));
constexpr int BM = 256, BK = 64, HALF = 128, HTB = HALF * BK * 2  , STAGE_BYTES = 8 * HTB, NXCD = 8, WGM = 8;

__host__ __device__ __forceinline__ int lds_byte(int r, int c) { const int st = (r >> 4) * 2 + (c >> 5), rr = r & 15, cc = c & 31, ob = rr * 64 + cc * 2; return st * 1024 + (ob ^ (((ob >> 9) & 1) << 5)); }
__host__ __device__ __forceinline__ void stage_rc(int b, int& R, int& C) { const int st = b / 1024, sb = b % 1024, swz = sb ^ (((sb >> 9) & 1) << 5); R = (st >> 1) * 16 + swz / 64; C = (st & 1) * 32 + (swz % 64) / 2; }
__host__ __device__ __forceinline__ int perm32(int rho) { const int n = rho >> 4, i = rho & 15; return 8 * (i >> 2) + 4 * n + (i & 3); }

struct Unit { int pm, pn; };
struct Gemm { const bf16_t* A; const bf16_t* Bt; int M, N, K, lda; };

struct StaticOrder {
    int nM, nN, nwg, G, c;
    __host__ __device__ void init(int M, int N, int G_, int c_) { nM = M / BM; nN = N / BM; nwg = nM * nN; G = G_; c = c_; }
    __host__ __device__ bool next(int i, Unit& u) const {
        const long L = (long)i * G + c; if (L >= nwg) return false;
        int wgid = (int)L; { const int q = nwg / NXCD, r = nwg % NXCD, xcd = wgid % NXCD, off = wgid / NXCD; wgid = (xcd < r ? xcd * (q + 1) : r * (q + 1) + (xcd - r) * q) + off; }
        const int nig = WGM * nN, gid = wgid / nig, fm = gid * WGM, gsz = (nM - fm) < WGM ? (nM - fm) : WGM;
        u.pm = fm + ((wgid % nig) % gsz); u.pn = (wgid % nig) / gsz; return true;
    }
    __device__ __forceinline__ void a_ready(const Unit&) const {}
    __device__ __forceinline__ void done(const Unit&) const {}
};


struct CmpOrder {
    int G, c;
    __device__ bool next(int i, Unit& u) const { const int L = i * G + c; if (L >= 64) return false; u.pm = L; u.pn = L >> 5; return true; }
    __device__ __forceinline__ void a_ready(const Unit&) const {}
    __device__ __forceinline__ void done(const Unit&) const {}
};

__device__ __forceinline__ u32x4 pack8h(const f32x4 v0, const f32x4 v1) { u32x4 w; w.x = pkh2(v0[0], v0[1]); w.y = pkh2(v0[2], v0[3]); w.z = pkh2(v1[0], v1[1]); w.w = pkh2(v1[2], v1[3]); return w; }
__device__ __forceinline__ float gelu_tanh(float v) {
    const float u2 = 1.5957691216057308f * (v + 0.044715f * v * v * v);
    return v * fast_rcp(1.0f + fast_exp2(-u2 * LOG2E));
}
template <int ACT> struct EpiF16 {
    static constexpr bool PERM = true, AFTER_DRAIN = false;
    half_t* O; int ldc; const float* bias;
    __device__ __forceinline__ void operator()(const f32x4 (&acc)[2][2][4][2], const Unit& u, int wr, int wc, int fr, int fq) const {
        asm volatile("" : "+v"(fr), "+v"(fq));
        const int row0 = u.pm * BM + wr * 64 + fr;
        const int col0 = (ACT == 2 ? 0 : u.pn * BM) + wc * 32 + 8 * fq, bcol0 = u.pn * BM + wc * 32 + 8 * fq;
        f32x4 bv[2][2];
#pragma unroll
        for (int bj = 0; bj < 2; ++bj)
#pragma unroll
            for (int n = 0; n < 2; ++n) bv[bj][n] = (ACT == 2) ? *(const f32x4*)(bias + bcol0 + bj * HALF + 4 * n) : (f32x4){0.f, 0.f, 0.f, 0.f};
#pragma unroll
        for (int ai = 0; ai < 2; ++ai)
#pragma unroll
            for (int m = 0; m < 4; ++m) { half_t* rowp = O + (size_t)(row0 + ai * HALF + m * 16) * ldc + col0;
#pragma unroll
                for (int bj = 0; bj < 2; ++bj) { f32x4 v0 = acc[ai][bj][m][0], v1 = acc[ai][bj][m][1];
                    if (ACT == 1) {
#pragma unroll
                        for (int e = 0; e < 4; ++e) { const float a = fmaxf(v0[e], 0.f), b = fmaxf(v1[e], 0.f); v0[e] = a * a; v1[e] = b * b; } }
                    if (ACT == 2) { v0 = v0 + bv[bj][0]; v1 = v1 + bv[bj][1];
#pragma unroll
                        for (int e = 0; e < 4; ++e) { v0[e] = gelu_tanh(v0[e]); v1[e] = gelu_tanh(v1[e]); } }
                    *(u32x4*)(rowp + bj * HALF) = pack8h(v0, v1); } }
    }
};

__device__ __forceinline__ void rope8(const f32x4 v0, const f32x4 v1, const float* ropetok, int i0, float sc, f32x4& o1, f32x4& o2) {
    const f32x4 c = *(const f32x4*)(ropetok + i0), s = *(const f32x4*)(ropetok + 32 + i0);
    const f32x4 x1 = {v0[0], v0[2], v1[0], v1[2]}, x2 = {v0[1], v0[3], v1[1], v1[3]};
    o1 = (x1 * c - x2 * s) * sc; o2 = (x2 * c + x1 * s) * sc;
}
__device__ __forceinline__ u32x2 pack4h(const f32x4 v) { u32x2 w; w.x = pkh2(v[0], v[1]); w.y = pkh2(v[2], v[3]); return w; }

struct EpiNsaIn {
    static constexpr bool PERM = true, AFTER_DRAIN = false;
    half_t* Q; half_t* KV; float* G; const float* rope;
    __device__ __forceinline__ void operator()(const f32x4 (&acc)[2][2][4][2], const Unit& u, int wr, int wc, int fr, int fq) const {
        asm volatile("" : "+v"(fr), "+v"(fq));
        const int pn = u.pn;
#pragma unroll
        for (int ai = 0; ai < 2; ++ai)
#pragma unroll
            for (int m = 0; m < 4; ++m) {
                const int tok = u.pm * BM + ai * HALF + wr * 64 + m * 16 + fr, b = tok >> 11, s = tok & 2047;
                const float* rt = rope + (size_t)tok * 64;
#pragma unroll
                for (int bj = 0; bj < 2; ++bj) {
                    const int cit = bj * HALF + wc * 32 + 8 * fq, hh = cit >> 6, jj0 = cit & 63;
                    const f32x4 v0 = acc[ai][bj][m][0], v1 = acc[ai][bj][m][1];
                    if (pn < 4) { f32x4 o1, o2; rope8(v0, v1, rt, jj0 >> 1, C2, o1, o2);
                        half_t* p = Q + (size_t)tok * D + pn * 256 + hh * 64 + (jj0 >> 1);
                        *(u32x2*)p = pack4h(o1); *(u32x2*)(p + 32) = pack4h(o2);
                    } else if (pn == 10) {
                        if (cit < 48) { f32x4 g0, g1;
#pragma unroll
                            for (int e = 0; e < 4; ++e) { g0[e] = fast_rcp(1.0f + fast_exp2(-v0[e] * LOG2E)); g1[e] = fast_rcp(1.0f + fast_exp2(-v1[e] * LOG2E)); }
                            float* p = G + (size_t)tok * 48 + cit; *(f32x4*)p = g0; *(f32x4*)(p + 4) = g1; }
                    } else {
                        const int t = pn - 4;
                        half_t* base = KV + (size_t)t * KVT + ((size_t)(b * 4 + hh) * S + s) * 64;
                        if ((t & 1) == 0) { f32x4 o1, o2; rope8(v0, v1, rt, jj0 >> 1, 1.0f, o1, o2);
                            *(u32x2*)(base + (jj0 >> 1)) = pack4h(o1); *(u32x2*)(base + 32 + (jj0 >> 1)) = pack4h(o2);
                        } else *(u32x4*)(base + jj0) = pack8h(v0, v1);
                    }
                }
                asm volatile("" ::: "memory");
            }
    }
};
struct EpiSwaIn {
    static constexpr bool PERM = true, AFTER_DRAIN = false;
    half_t* Q; half_t* KV; const float* rope;
    __device__ __forceinline__ void operator()(const f32x4 (&acc)[2][2][4][2], const Unit& u, int wr, int wc, int fr, int fq) const {
        asm volatile("" : "+v"(fr), "+v"(fq));
        const int pn = u.pn;
#pragma unroll
        for (int ai = 0; ai < 2; ++ai)
#pragma unroll
            for (int m = 0; m < 4; ++m) {
                const int tok = u.pm * BM + ai * HALF + wr * 64 + m * 16 + fr, b = tok >> 11, s = tok & 2047;
                const float* rt = rope + (size_t)tok * 64;
#pragma unroll
                for (int bj = 0; bj < 2; ++bj) {
                    const int cit = bj * HALF + wc * 32 + 8 * fq, hh = cit >> 6, jj0 = cit & 63;
                    const f32x4 v0 = acc[ai][bj][m][0], v1 = acc[ai][bj][m][1];
                    if (pn < 4) { f32x4 o1, o2; rope8(v0, v1, rt, jj0 >> 1, C2, o1, o2);
                        half_t* p = Q + (size_t)tok * D + pn * 256 + hh * 64 + (jj0 >> 1);
                        *(u32x2*)p = pack4h(o1); *(u32x2*)(p + 32) = pack4h(o2);
                    } else if (bj == 0) {
                        half_t* base = KV + ((size_t)(b * 2 + hh) * S + s) * 64;
                        f32x4 o1, o2; rope8(v0, v1, rt, jj0 >> 1, 1.0f, o1, o2);
                        *(u32x2*)(base + (jj0 >> 1)) = pack4h(o1); *(u32x2*)(base + 32 + (jj0 >> 1)) = pack4h(o2);
                    } else {
                        half_t* base = KV + (size_t)M * 128 + ((size_t)(b * 2 + (hh - 2)) * S + s) * 64;
                        *(u32x4*)(base + jj0) = pack8h(v0, v1);
                    }
                }
                asm volatile("" ::: "memory");
            }
    }
};
template <class Epi, class Sched, bool ALIGN_EPI = false, bool SP2 = false>
__device__ __forceinline__ void gemm_phase(PG8_LAS unsigned char* lds, const Gemm g, const Sched& S, const Epi& E, int tid_in) {
    int tid_ = tid_in; asm volatile("" : "+v"(tid_));
    const int tid = tid_, wid = __builtin_amdgcn_readfirstlane(tid >> 6), lane = tid & 63, wr = wid >> 2, wc = wid & 3, fr = lane & 15, fq = lane >> 4;
    const int K = g.K, nt = K / BK;
    unsigned voffA[2], voffB[2];
#pragma unroll
    for (int i = 0; i < 2; ++i) { int R, C; stage_rc(tid * 16 + i * 8192, R, C); const int Rb = Epi::PERM ? ((R & ~31) + perm32(R & 31)) : R;
        voffA[i] = (unsigned)(R * g.lda + C) * 2u; voffB[i] = (unsigned)(Rb * K + C) * 2u; }
    const size_t kstep = (size_t)(BK * 2);
    const size_t hstep = (size_t)HALF * K * 2;
    const size_t tstep = 2 * hstep;
    const size_t hstepA = (size_t)HALF * g.lda * 2, tstepA = 2 * hstepA;
    const unsigned ldsw = (unsigned)wid * 1024u;
    const int aoff = lds_byte(wr * 64 + fr, fq * 8), boff = lds_byte(wc * 32 + fr, fq * 8);
#define PG8_SA(b, h) (((b) * 2 + (h)) * HTB)
#define PG8_SB(b, h) ((4 + (b) * 2 + (h)) * HTB)
#define PG8_STAGE(bufoff, gbase, voff) do { _Pragma("unroll") for (int _i = 0; _i < 2; ++_i) \
        __builtin_amdgcn_global_load_lds((const unsigned*)((const char*)(gbase) + (voff)[_i]), (PG8_LAS unsigned*)(lds + (bufoff) + ldsw + _i * 8192), 16, 0, 0); } while (0)
#define PG8_LDA(dst, b, h) do { _Pragma("unroll") for (int m = 0; m < 4; ++m) _Pragma("unroll") for (int k = 0; k < 2; ++k) dst[m][k] = *(const PG8_LAS bf16x8*)(lds + PG8_SA(b, h) + aoff + m * 2048 + k * 1024); } while (0)
#define PG8_LDB(dst, b, h) do { _Pragma("unroll") for (int n = 0; n < 2; ++n) _Pragma("unroll") for (int k = 0; k < 2; ++k) dst[n][k] = *(const PG8_LAS bf16x8*)(lds + PG8_SB(b, h) + boff + n * 2048 + k * 1024); } while (0)
#define PG8_MMA(ai, bj, At, Bt) do { __builtin_amdgcn_s_setprio(1); _Pragma("unroll") for (int m = 0; m < 4; ++m) _Pragma("unroll") for (int n = 0; n < 2; ++n) _Pragma("unroll") for (int k = 0; k < 2; ++k) \
        acc[ai][bj][m][n] = __builtin_amdgcn_mfma_f32_16x16x32_f16(Bt[n][k], At[m][k], acc[ai][bj][m][n], 0, 0, 0); __builtin_amdgcn_s_setprio(0); } while (0)
#define PG8_WAIT_V(n) asm volatile("s_waitcnt vmcnt(" #n ")" ::: "memory")
#define PG8_WAIT_L(n) asm volatile("s_waitcnt lgkmcnt(" #n ")" ::: "memory")
#define PG8_BAR __builtin_amdgcn_s_barrier()
#define PG8_SCHED __builtin_amdgcn_sched_barrier(0)
    Unit cur, nxt; int ui = 0;
    if (!S.next(0, cur)) return;
    f32x4 acc[2][2][4][2];
#pragma unroll
    for (int a = 0; a < 2; ++a)
#pragma unroll
        for (int b = 0; b < 2; ++b)
#pragma unroll
            for (int m = 0; m < 4; ++m)
#pragma unroll
                for (int n = 0; n < 2; ++n) acc[a][b][m][n] = (f32x4){0.f, 0.f, 0.f, 0.f};
    bf16x8 At[4][2], B0[2][2], B1[2][2];
    const char* cA = (const char*)g.A + (size_t)cur.pm * tstepA; const char* cB = (const char*)g.Bt + (size_t)cur.pn * tstep;
    S.a_ready(cur);
    static_assert(SP2, "only the SP2 loop is kept in this file");
    {
        PG8_STAGE(PG8_SB(0, 0), cB, voffB); PG8_STAGE(PG8_SB(0, 1), cB + hstep, voffB); PG8_STAGE(PG8_SA(0, 0), cA, voffA); PG8_STAGE(PG8_SA(0, 1), cA + hstepA, voffA);
        if (wr == 1) PG8_BAR;
        PG8_WAIT_V(2); PG8_BAR;
        PG8_STAGE(PG8_SB(1, 0), cB + kstep, voffB); PG8_STAGE(PG8_SA(1, 0), cA + kstep, voffA); PG8_STAGE(PG8_SB(1, 1), cB + hstep + kstep, voffB);
        PG8_WAIT_V(6); PG8_BAR;
    }
    for (;;) {
        const bool has_next = S.next(ui + 1, nxt);
        const char* nA = has_next ? (const char*)g.A + (size_t)nxt.pm * tstepA : cA; const char* nB = has_next ? (const char*)g.Bt + (size_t)nxt.pn * tstep : cB;
        for (int t = 0; t < nt; t += 2) {
            const bool last = (t == nt - 2);
            const char* a1 = cA + (size_t)(t + 1) * kstep;
            const char* a2 = last ? nA : cA + (size_t)(t + 2) * kstep; const char* b2 = last ? nB : cB + (size_t)(t + 2) * kstep;
            const char* a3 = a2 + kstep; const char* b3 = b2 + kstep;
            if (last && has_next) S.a_ready(nxt);
            {
            PG8_LDB(B0, 0, 0); PG8_LDB(B1, 0, 1); PG8_SCHED; PG8_LDA(At, 0, 0); PG8_STAGE(PG8_SA(1, 1), a1 + hstepA, voffA);
            PG8_WAIT_V(8); PG8_WAIT_L(0); PG8_BAR; PG8_MMA(0, 0, At, B0); PG8_MMA(0, 1, At, B1); PG8_BAR; PG8_SCHED;
            PG8_LDA(At, 0, 1); PG8_STAGE(PG8_SB(0, 0), b2, voffB); PG8_STAGE(PG8_SB(0, 1), b2 + hstep, voffB); PG8_STAGE(PG8_SA(0, 0), a2, voffA);
            PG8_WAIT_V(8); PG8_WAIT_L(0); PG8_BAR; PG8_MMA(1, 0, At, B0); PG8_MMA(1, 1, At, B1); PG8_BAR; PG8_SCHED;
            PG8_LDB(B0, 1, 0); PG8_LDB(B1, 1, 1); PG8_SCHED; PG8_LDA(At, 1, 0); PG8_STAGE(PG8_SA(0, 1), a2 + hstepA, voffA);
            PG8_WAIT_V(8); PG8_WAIT_L(0); PG8_BAR; PG8_MMA(0, 0, At, B0); PG8_MMA(0, 1, At, B1); PG8_BAR; PG8_SCHED;
            PG8_LDA(At, 1, 1); PG8_STAGE(PG8_SB(1, 0), b3, voffB); PG8_STAGE(PG8_SB(1, 1), b3 + hstep, voffB); PG8_STAGE(PG8_SA(1, 0), a3, voffA);
            PG8_WAIT_V(8); PG8_WAIT_L(0); PG8_BAR; PG8_MMA(1, 0, At, B0); PG8_MMA(1, 1, At, B1); PG8_BAR; PG8_SCHED;
            }
        }
        if constexpr (ALIGN_EPI) { if (wr == 0) PG8_BAR; }
        if constexpr (!Epi::AFTER_DRAIN) { E(acc, cur, wr, wc, fr, fq); S.done(cur); }
        if (!has_next) break;
#pragma unroll
        for (int a = 0; a < 2; ++a)
#pragma unroll
            for (int b = 0; b < 2; ++b)
#pragma unroll
                for (int m = 0; m < 4; ++m)
#pragma unroll
                    for (int n = 0; n < 2; ++n) acc[a][b][m][n] = (f32x4){0.f, 0.f, 0.f, 0.f};
        cur = nxt; cA = nA; cB = nB; ++ui;
        if constexpr (ALIGN_EPI) { if (wr == 1) PG8_BAR; }
    }
    PG8_WAIT_V(0);
    if constexpr (!ALIGN_EPI) { if (wr == 0) PG8_BAR; }
    PG8_BAR;
    if constexpr (Epi::AFTER_DRAIN) { E.fused(acc, cur, wr, wc, fr, fq, lds, wid, lane); S.done(cur); }
#undef PG8_SA
#undef PG8_SB
#undef PG8_STAGE
#undef PG8_LDA
#undef PG8_LDB
#undef PG8_MMA
#undef PG8_WAIT_V
#undef PG8_WAIT_L
#undef PG8_BAR
#undef PG8_SCHED
}
}

#define XB_TMO      128
#define XB_XCNT(j)  (256  + 64 * (j))
#define XB_XSUB(j)  (1280 + 64 * (j))
#define XB_XGEN(j)  (2304 + 64 * (j))
#define XB_TOP      3328
#define XB_TOPGEN   3392
#define XCD_BAR_WORDS 3456
#define XB_SPIN_CAP (1u << 18)

__device__ __forceinline__ unsigned xb_ld(unsigned* p)              { return __hip_atomic_load(p, __ATOMIC_RELAXED, __HIP_MEMORY_SCOPE_AGENT); }
__device__ __forceinline__ unsigned xb_add(unsigned* p, unsigned v) { return __hip_atomic_fetch_add(p, v, __ATOMIC_RELAXED, __HIP_MEMORY_SCOPE_AGENT); }
__device__ __forceinline__ unsigned xb_xcc_id() { return (unsigned)__builtin_amdgcn_s_getreg((3 << 11) | 20) & 0xFu; }
#define XB_SPIN(cond, bar) do { unsigned _sp = 0; while (cond) { __builtin_amdgcn_s_sleep(1); \
    if ((++_sp & 255u) == 0u) { if (xb_ld(&(bar)[XB_TMO])) break; if (_sp > XB_SPIN_CAP) { atomicAdd(&(bar)[XB_TMO], 1u); break; } } } } while (0)

struct XcdBarrier {
    unsigned* bar; unsigned x;
    volatile LAS unsigned* st;
};

__device__ __forceinline__ XcdBarrier xcd_barrier_post(unsigned* bar, volatile LAS unsigned* st) {
    XcdBarrier b; b.bar = bar; b.x = xb_xcc_id(); b.st = st;
    if (threadIdx.x == 0) (void)xb_add(&bar[XB_XCNT(b.x)], 1u);
    return b;
}
__device__ __forceinline__ void xcd_barrier_complete(unsigned* bar, unsigned x, unsigned& nloc, unsigned& nx) {
    const unsigned G = gridDim.x * gridDim.y * gridDim.z;
    asm volatile("" : "+s"(x));
    unsigned sum, cnt, mine, sp = 0u;
    for (;;) {
        sum = 0u; cnt = 0u; mine = 0u;
#pragma unroll
        for (unsigned j = 0; j < 16; ++j) { const unsigned c = xb_ld(&bar[XB_XCNT(j)]); sum += c; cnt += (c > 0u) ? 1u : 0u; mine = (j == x) ? c : mine; }
        if (sum == G) break;
        __builtin_amdgcn_s_sleep(1);
        if ((++sp & 255u) == 0u) { if (xb_ld(&bar[XB_TMO])) break; if (sp > XB_SPIN_CAP) { atomicAdd(&bar[XB_TMO], 1u); break; } }
    }
    nloc = mine > 0u ? mine : 1u; nx = cnt > 0u ? cnt : 1u;
}

__device__ __forceinline__ void xcd_barrier(const XcdBarrier& b) {
    asm volatile("s_waitcnt vmcnt(0)" ::: "memory");
    __syncthreads();
    if (threadIdx.x == 0) {
        unsigned* bar = b.bar;
        __builtin_amdgcn_s_waitcnt(0);
        unsigned nloc = b.st[0], nx = b.st[1];
        if (nloc == 0u) { xcd_barrier_complete(bar, b.x, nloc, nx); b.st[0] = nloc; b.st[1] = nx; }
        const unsigned old = xb_add(&bar[XB_XSUB(b.x)], 1u);
        const unsigned gen = old / nloc;
        if (old + 1u == (gen + 1u) * nloc) {
            __builtin_amdgcn_fence(__ATOMIC_RELEASE, "agent");
            asm volatile("s_waitcnt vmcnt(0)" ::: "memory");
            const unsigned og = xb_add(&bar[XB_TOP], 1u);
            const unsigned tg = og / nx;
            if (og + 1u == (tg + 1u) * nx) xb_add(&bar[XB_TOPGEN], 1u);
            else XB_SPIN(xb_ld(&bar[XB_TOPGEN]) == tg, bar);
            __builtin_amdgcn_fence(__ATOMIC_ACQUIRE, "agent");
            xb_add(&bar[XB_XGEN(b.x)], 1u);
            asm volatile("s_waitcnt vmcnt(0)" ::: "memory");
        } else {
            XB_SPIN(xb_ld(&bar[XB_XGEN(b.x)]) == gen, bar);
            __builtin_amdgcn_fence(__ATOMIC_ACQUIRE, "agent");
            asm volatile("s_waitcnt vmcnt(0)" ::: "memory");
        }
    }
    __syncthreads();
}

#ifndef REP_PRO_A
#define REP_PRO_A 1
#endif
#ifndef REP_PRO_D
#define REP_PRO_D 1
#endif
#ifndef REP_PRO_C
#define REP_PRO_C 1
#endif
#define REPEAT(n) _Pragma("unroll 1") for (int rep_ = 0; rep_ < (n); ++rep_)
struct Args { const GAS void* in[18]; GAS float* out; GAS unsigned char* ws; int ph_lo, ph_hi; };
typedef const __attribute__((address_space(4))) Args* ArgsP;
struct Ctx {
    LAS unsigned char* lds;
    int tid, lane, wave, G, gw, ngw;
    unsigned char* ws;
};
#define LDS_WAIT() asm volatile("s_waitcnt lgkmcnt(0)" ::: "memory")

__device__ const float INVF[32] = {1.000000000e+00f, 7.498942018e-01f, 5.623413324e-01f, 4.216965139e-01f, 3.162277639e-01f, 2.371373922e-01f, 1.778279394e-01f, 1.333521456e-01f,
    1.000000015e-01f, 7.498941571e-02f, 5.623412877e-02f, 4.216964915e-02f, 3.162277862e-02f, 2.371373586e-02f, 1.778279431e-02f, 1.333521493e-02f,
    9.999999776e-03f, 7.498942316e-03f, 5.623413250e-03f, 4.216964822e-03f, 3.162277862e-03f, 2.371373819e-03f, 1.778279431e-03f, 1.333521446e-03f,
    1.000000047e-03f, 7.498941850e-04f, 5.623413017e-04f, 4.216965463e-04f, 3.162277862e-04f, 2.371373848e-04f, 1.778279402e-04f, 1.333521504e-04f};

__device__ __forceinline__ void sincos_d(double x, double& sn, double& cs) {
    const double k = __builtin_rint(x * 0.63661977236758134308);
    double r = __builtin_fma(-k, 1.57079632679489655800e+00, x); r = __builtin_fma(-k, 6.12323399573676603587e-17, r);
    const double z = r * r;
    double sp = 1.0 / 6227020800.0; sp = sp * z - 1.0 / 39916800.0; sp = sp * z + 1.0 / 362880.0; sp = sp * z - 1.0 / 5040.0; sp = sp * z + 1.0 / 120.0; sp = sp * z - 1.0 / 6.0; sp = sp * z + 1.0;
    const double s0 = sp * r;
    double cp = -1.0 / 87178291200.0; cp = cp * z + 1.0 / 479001600.0; cp = cp * z - 1.0 / 3628800.0; cp = cp * z + 1.0 / 40320.0; cp = cp * z - 1.0 / 720.0; cp = cp * z + 1.0 / 24.0; cp = cp * z - 0.5; cp = cp * z + 1.0;
    const int q = ((int)k) & 3;
    sn = (q == 0) ? s0 : (q == 1) ? cp : (q == 2) ? -s0 : -cp;
    cs = (q == 0) ? cp : (q == 1) ? -s0 : (q == 2) ? -cp : s0;
}

__device__ __forceinline__ int w_rowmap(int mode, int n) {
    if (mode == 0) return n;
    bool rope;
    if (mode == 1) { const int t = n >> 8; rope = (t < 4) || t == 4 || t == 6 || t == 8; }
    else rope = n < 1152;
    if (!rope) return n;
    const int d = n & 63; return (n & ~63) + 2 * (d & 31) + (d >> 5);
}
__device__ __forceinline__ void convert_item(const float* W, int K, int N, half_t* WT, int mode, LAS float* scr, int item, int lane) {
    const int nblk = (N + 31) / 32, kb = item / nblk, nb = item % nblk, k0 = 64 * kb, n0 = 32 * nb;
    const int nn = n0 + (lane & 31);
    float t[32];
#pragma unroll
    for (int i = 0; i < 32; ++i) { const int kk = 2 * i + (lane >> 5); t[i] = (nn < N) ? W[(size_t)(k0 + kk) * N + nn] : 0.f; }
#pragma unroll
    for (int i = 0; i < 32; ++i) { const int kk = 2 * i + (lane >> 5); scr[kk * 33 + (lane & 31)] = t[i]; }
    LDS_WAIT(); asm volatile("" ::: "memory");
    const int c = lane & 7;
#pragma unroll
    for (int j = 0; j < 4; ++j) { const int nl = (lane >> 3) + 8 * j, n = n0 + nl; const LAS float* s = scr + (8 * c) * 33 + nl;
        u32x4 o; o.x = pkh2(s[0 * 33], s[1 * 33]); o.y = pkh2(s[2 * 33], s[3 * 33]); o.z = pkh2(s[4 * 33], s[5 * 33]); o.w = pkh2(s[6 * 33], s[7 * 33]);
        if (n < N) *(u32x4*)(WT + (size_t)w_rowmap(mode, n) * K + k0 + 8 * c) = o; }
    LDS_WAIT(); asm volatile("" ::: "memory");
}
struct WDesc { const float* src; half_t* dst; int K, N, mode; };
__device__ __forceinline__ WDesc wdesc(ArgsP a, int mid) {
    WDesc d; unsigned char* ws = (unsigned char*)a->ws;
    if (mid < 2)       { d.src = (const float*)a->in[6] + (size_t)mid * D * NSA_IN;            d.dst = (half_t*)(ws + WS_WINN) + (size_t)mid * NSA_INP * D;         d.K = D;    d.N = NSA_IN; d.mode = 1; }
    else if (mid < 4)  { d.src = (const float*)a->in[13] + (size_t)(mid - 2) * D * SWA_IN;     d.dst = (half_t*)(ws + WS_WINS) + (size_t)(mid - 2) * SWA_IN * D;    d.K = D;    d.N = SWA_IN; d.mode = 2; }
    else if (mid < 6)  { d.src = (const float*)a->in[7] + (size_t)(mid - 4) * D * D;           d.dst = (half_t*)(ws + WS_WOUT) + (size_t)(2 * (mid - 4)) * D * D;   d.K = D;    d.N = D;      d.mode = 0; }
    else if (mid < 8)  { d.src = (const float*)a->in[14] + (size_t)(mid - 6) * D * D;          d.dst = (half_t*)(ws + WS_WOUT) + (size_t)(2 * (mid - 6) + 1) * D * D; d.K = D;  d.N = D;      d.mode = 0; }
    else if (mid < 12) { d.src = (const float*)a->in[9] + (size_t)(mid - 8) * 2048 * 256;      d.dst = (half_t*)(ws + WS_W1T) + (size_t)(mid - 8) * 256 * 2048;     d.K = 2048; d.N = 256;    d.mode = 0; }
    else if (mid < 16) { d.src = (const float*)a->in[11] + (size_t)(mid - 12) * 256 * 64;      d.dst = (half_t*)(ws + WS_W2T) + (size_t)(mid - 12) * 64 * 256;      d.K = 256;  d.N = 64;     d.mode = 0; }
    else if (mid < 20) { d.src = (const float*)a->in[16] + (size_t)(mid - 16) * D * FF;        d.dst = (half_t*)(ws + WS_WUP) + (size_t)(mid - 16) * FF * D;        d.K = D;    d.N = FF;     d.mode = 0; }
    else               { d.src = (const float*)a->in[17] + (size_t)(mid - 20) * FF * D;        d.dst = (half_t*)(ws + WS_WDN) + (size_t)(mid - 20) * D * FF;        d.K = FF;   d.N = D;      d.mode = 0; }
    return d;
}

__device__ __forceinline__ void phase_prologue(ArgsP a, const Ctx& C) {
    unsigned char* ws = C.ws;
    {
        LAS float* scr = (LAS float*)(C.lds + C.wave * 16384);
        REPEAT(REP_PRO_A) for (int mid = 0; mid < 24; ++mid) { const WDesc d = wdesc(a, mid); const int nit = (d.K / 64) * ((d.N + 31) / 32);
            for (int it = C.gw; it < nit; it += C.ngw) convert_item(d.src, d.K, d.N, d.dst, d.mode, scr, it, C.lane); }
    }
    {
        const int gt = C.gw * 64 + C.lane, ngt = C.ngw * 64;
        for (int i = gt; i < 2 * 208 * 128; i += ngt) { const int mat = i / (208 * 128), r = i % (208 * 128);
            *(u32x4*)((half_t*)(ws + WS_WINN) + (size_t)mat * NSA_INP * D + (size_t)NSA_IN * D + (size_t)r * 8) = (u32x4){0u, 0u, 0u, 0u}; }
        const int* pos = (const int*)a->in[2]; float* rope = (float*)(ws + WS_ROPE);
        REPEAT(REP_PRO_C) for (int i = gt; i < M * 32; i += ngt) { const int tok = i >> 5, fi = i & 31;
            const float ang = (float)pos[tok] * INVF[fi]; double sn, cs; sincos_d((double)ang, sn, cs);
            rope[(size_t)tok * 64 + fi] = (float)cs; rope[(size_t)tok * 64 + 32 + fi] = (float)sn; }
    }
    {
        float* b1p = (float*)(ws + WS_B1P);
        for (int task = C.gw; task < 4 * 4 * 32; task += C.ngw) { const int ks = task & 31, cg = (task >> 5) & 3, lw = task >> 7, j = cg * 64 + C.lane;
            const float* w1 = (const float*)a->in[9] + ((size_t)lw * 2048 + ks * 64) * 256 + j; const float* pe = (const float*)a->in[8] + (size_t)lw * 2048 + ks * 64;
            float s = 0.f;
#pragma unroll 16
            for (int k = 0; k < 64; ++k) s += pe[k] * w1[(size_t)k * 256];
            b1p[ks * 1024 + lw * 256 + j] = s; }
    }
    __syncthreads();
    {
        LAS float* cl = (LAS float*)C.lds; const float* cin = (const float*)a->in[1];
        for (int i = C.tid; i < 16 * 1024; i += 512) { const int b = i >> 10, k = i & 1023; const float v = cin[i]; cl[k * 16 + b] = v / (1.0f + __expf(-v)); }
        __syncthreads();
        const float* aw = (const float*)a->in[3]; float* part = (float*)(ws + WS_PART);
        REPEAT(REP_PRO_D) for (int task = C.gw; task < 4 * 8 * 96; task += C.ngw) {
            const int ng = task % 96, lk = task / 96, ks = lk & 7, L = lk >> 3, col = ng * 64 + C.lane;
            const float* wp = aw + ((size_t)L * 1024 + ks * 128) * 6144 + col;
            float acc[16];
#pragma unroll
            for (int b = 0; b < 16; ++b) acc[b] = 0.f;
#pragma unroll 8
            for (int kk = 0; kk < 128; ++kk) { const float w = wp[(size_t)kk * 6144]; const LAS f32x4* cv = (const LAS f32x4*)(cl + (ks * 128 + kk) * 16);
#pragma unroll
                for (int q = 0; q < 4; ++q) { const f32x4 c4 = cv[q]; acc[4 * q] += c4[0] * w; acc[4 * q + 1] += c4[1] * w; acc[4 * q + 2] += c4[2] * w; acc[4 * q + 3] += c4[3] * w; } }
#pragma unroll
            for (int b = 0; b < 16; ++b) part[((size_t)(ks * 4 + L) * 16 + b) * 6144 + col] = acc[b];
        }
    }
}
__device__ __forceinline__ void phase_modfinal(ArgsP a, const Ctx& C) {
    const float* part = (const float*)(C.ws + WS_PART); const float* ab = (const float*)a->in[4]; float* mod = (float*)(C.ws + WS_MOD);
    for (int i = C.gw * 64 + C.lane; i < 4 * 16 * 6144; i += C.ngw * 64) { const int L = i / 98304, rem = i % 98304, n = rem % 6144;
        float s = ab[L * 6144 + n];
#pragma unroll
        for (int ks = 0; ks < 8; ++ks) s += part[(size_t)(ks * 4 + L) * 98304 + rem];
        mod[i] = s; }
    const float* b1p = (const float*)(C.ws + WS_B1P); const float* b1 = (const float*)a->in[10]; float* b1f = (float*)(C.ws + WS_B1F);
    for (int i = C.gw * 64 + C.lane; i < 1024; i += C.ngw * 64) { float s = b1[i];
#pragma unroll 8
        for (int ks = 0; ks < 32; ++ks) s += b1p[ks * 1024 + i];
        b1f[i] = s; }
}

__device__ __forceinline__ void row_norm_mod(const f32x4 (&v)[4], float rstd, const float* gain, const float* sh, const float* sc, half_t* hrow, int lane) {
#pragma unroll
    for (int j = 0; j < 4; ++j) { const int c = 4 * lane + 256 * j;
        const f32x4 g = *(const f32x4*)(gain + c), s1 = *(const f32x4*)(sc + c), s0 = *(const f32x4*)(sh + c);
        const f32x4 h = (v[j] * rstd * g) * (s1 + 1.0f) + s0;
        *(u32x2*)(hrow + c) = pk4(h); }
}

constexpr int ROW_RB = 4;
__device__ __forceinline__ float sumsq4(const f32x4 (&v)[4]) { float s = 0.f;
#pragma unroll
    for (int j = 0; j < 4; ++j) s += (v[j][0] * v[j][0] + v[j][1] * v[j][1]) + (v[j][2] * v[j][2] + v[j][3] * v[j][3]);
    return s; }
__device__ __forceinline__ f32x4 h4f(const h4 h) { return (f32x4){(float)h[0], (float)h[1], (float)h[2], (float)h[3]}; }
__device__ __forceinline__ void phase_row_first(ArgsP a, const Ctx& C) {
    const float* x = (const float*)a->in[0]; const float* ng = (const float*)a->in[5]; const float* mod = (const float*)(C.ws + WS_MOD); half_t* H = (half_t*)(C.ws + WS_H);
    const int rpw = M / C.ngw, row0 = C.gw * rpw, b = row0 >> 11;
    const float* mb = mod + (size_t)b * 6144;
    f32x4 vg[4], vsh[4], vsc[4];
#pragma unroll
    for (int j = 0; j < 4; ++j) { const int c = 4 * C.lane + 256 * j; vg[j] = *(const f32x4*)(ng + c); vsh[j] = *(const f32x4*)(mb + c); vsc[j] = *(const f32x4*)(mb + 1024 + c) + 1.0f; }
    for (int r0 = 0; r0 < rpw; r0 += ROW_RB) {
        f32x4 v[ROW_RB][4];
#pragma unroll
        for (int q = 0; q < ROW_RB; ++q)
#pragma unroll
            for (int j = 0; j < 4; ++j) v[q][j] = *(const f32x4*)(x + (size_t)(row0 + r0 + q) * D + 4 * C.lane + 256 * j);
#pragma unroll
        for (int q = 0; q < ROW_RB; ++q) {
            const float rstd = 1.0f / sqrtf(wave_sum(sumsq4(v[q]), C.lane) * (1.0f / D) + NORM_EPS);
#pragma unroll
            for (int j = 0; j < 4; ++j) *(u32x2*)(H + (size_t)(row0 + r0 + q) * D + 4 * C.lane + 256 * j) = pk4((v[q][j] * rstd * vg[j]) * vsc[j] + vsh[j]);
        }
    }
}
__device__ __forceinline__ void phase_row_update(ArgsP a, const Ctx& C, int L, int which) {
    const float* ng = (const float*)a->in[5]; const float* mod = (const float*)(C.ws + WS_MOD);
    const half_t* Y = (const half_t*)(C.ws + (which ? WS_Y2 : WS_Y)); half_t* H = (half_t*)(C.ws + WS_H); half_t* X16 = (half_t*)(C.ws + WS_X16);
    const bool first = (L == 0 && which == 0), last = (which == 1 && L == DEPTH - 1);
    const float* xin32 = (const float*)a->in[0]; float* xout32 = (float*)a->out;
    const int Lh = which ? L + 1 : L;
    const int rpw = M / C.ngw, row0 = C.gw * rpw, b = row0 >> 11;
    const float* gy = ng + (size_t)(L * 4 + (which ? 3 : 1)) * D;
    const float* gh = ng + (size_t)((last ? L : Lh) * 4 + (which ? 0 : 2)) * D;
    const float* mg = mod + ((size_t)L * 16 + b) * 6144 + (which ? 5 : 2) * 1024;
    const float* mh = mod + ((size_t)(last ? L : Lh) * 16 + b) * 6144 + (which ? 0 : 3) * 1024;
    f32x4 wy[4], vg[4], vsh[4], vsc[4];
#pragma unroll
    for (int j = 0; j < 4; ++j) { const int c = 4 * C.lane + 256 * j; wy[j] = (*(const f32x4*)(mg + c) + 1.0f) * *(const f32x4*)(gy + c);
        vg[j] = *(const f32x4*)(gh + c); vsh[j] = *(const f32x4*)(mh + c); vsc[j] = *(const f32x4*)(mh + 1024 + c) + 1.0f; }
    for (int r0 = 0; r0 < rpw; r0 += ROW_RB) {
        h4 yh[ROW_RB][4]; f32x4 xv[ROW_RB][4];
#pragma unroll
        for (int q = 0; q < ROW_RB; ++q)
#pragma unroll
            for (int j = 0; j < 4; ++j) { const size_t o = (size_t)(row0 + r0 + q) * D + 4 * C.lane + 256 * j; yh[q][j] = *(const h4*)(Y + o);
                if (first) xv[q][j] = *(const f32x4*)(xin32 + o); else xv[q][j] = h4f(*(const h4*)(X16 + o)); }
#pragma unroll
        for (int q = 0; q < ROW_RB; ++q) {
            f32x4 y[4];
#pragma unroll
            for (int j = 0; j < 4; ++j) y[j] = h4f(yh[q][j]);
            const float r1 = 1.0f / sqrtf(wave_sum(sumsq4(y), C.lane) * (1.0f / D) + NORM_EPS);
#pragma unroll
            for (int j = 0; j < 4; ++j) { const size_t o = (size_t)(row0 + r0 + q) * D + 4 * C.lane + 256 * j;
                xv[q][j] = xv[q][j] + wy[j] * (y[j] * r1);
                if (last) *(f32x4*)(xout32 + o) = xv[q][j]; else *(u32x2*)(X16 + o) = pk4(xv[q][j]); }
            if (!last) { const float r2 = 1.0f / sqrtf(wave_sum(sumsq4(xv[q]), C.lane) * (1.0f / D) + NORM_EPS);
#pragma unroll
                for (int j = 0; j < 4; ++j) *(u32x2*)(H + (size_t)(row0 + r0 + q) * D + 4 * C.lane + 256 * j) = pk4((xv[q][j] * r2 * vg[j]) * vsc[j] + vsh[j]); }
        }
    }
}

__device__ __forceinline__ void phase_cmp2(ArgsP a, const Ctx& C, int la) {
    const half_t* HC = (const half_t*)(C.ws + WS_HIDC); half_t* KCC = (half_t*)(C.ws + WS_KCC);
    const int r32 = C.lane & 31, hi = C.lane >> 5;
    for (int task = C.gw; task < 512; task += C.ngw) {
        const int R0 = task * 32, which = R0 >> 13;
        const half_t* W2 = (const half_t*)(C.ws + WS_W2T) + (size_t)(la * 2 + which) * 64 * 256;
        const float* b2 = (const float*)a->in[12] + (la * 2 + which) * 64;
        f32x16 acc[2]; acc[0] = (f32x16){}; acc[1] = (f32x16){};
        const half_t* ap = HC + (size_t)(R0 + r32) * 256 + hi * 8;
#pragma unroll 4
        for (int ks = 0; ks < 16; ++ks) {
            const h8 af = *(const h8*)(ap + ks * 16);
            const h8 w0 = *(const h8*)(W2 + (size_t)r32 * 256 + ks * 16 + hi * 8), w1 = *(const h8*)(W2 + (size_t)(32 + r32) * 256 + ks * 16 + hi * 8);
            acc[0] = __builtin_amdgcn_mfma_f32_32x32x16_f16(w0, af, acc[0], 0, 0, 0);
            acc[1] = __builtin_amdgcn_mfma_f32_32x32x16_f16(w1, af, acc[1], 0, 0, 0);
        }
        const int row = R0 + r32; const bool dead = (row & 127) == 127;
#pragma unroll
        for (int ct = 0; ct < 2; ++ct)
#pragma unroll
            for (int rg = 0; rg < 4; ++rg) { const int oc = 32 * ct + 8 * rg + 4 * hi; const f32x4 bb = *(const f32x4*)(b2 + oc);
                f32x4 v = {acc[ct][4 * rg] + bb[0], acc[ct][4 * rg + 1] + bb[1], acc[ct][4 * rg + 2] + bb[2], acc[ct][4 * rg + 3] + bb[3]};
                if (dead) v = (f32x4){0.f, 0.f, 0.f, 0.f};
                *(u32x2*)(KCC + (size_t)row * 64 + oc) = pk4(v); }
    }
}

constexpr int AL_K = 0, AL_V = 16384, AL_PSUM = 32768, AL_W = 65536;
__device__ __forceinline__ int crow(int r, int hi) { return (r & 3) + 8 * (r >> 2) + 4 * hi; }
__device__ __forceinline__ void kv_load(const half_t* Kt, const half_t* Vt, int wave, int lane, u32x4& kr, u32x4& vr) {
    kr = *(const u32x4*)(Kt + (size_t)lane * 64 + wave * 8);
    vr = *(const u32x4*)(Vt + (size_t)(16 * (wave & 3) + (lane >> 2)) * 64 + (wave >> 2) * 32 + (lane & 3) * 8);
}
__device__ __forceinline__ void kv_store(LAS unsigned char* Kb, LAS unsigned char* Vb, int wave, int lane, const u32x4 kr, const u32x4 vr) {
    *(LAS u32x4*)(Kb + wave * 1024 + lane * 16) = kr;
    *(LAS u32x4*)(Vb + (wave >> 2) * 4096 + (16 * (wave & 3) + (lane >> 2)) * 64 + (lane & 3) * 16) = vr;
}
__device__ __forceinline__ void qk_tile(f32x16& p0, f32x16& p1, const LAS unsigned char* Kb, const h8 (&qf)[4], int r32, int hi) {
    p0 = (f32x16){}; p1 = (f32x16){};
#pragma unroll
    for (int d0 = 0; d0 < 4; ++d0) {
        const h8 k0 = *(const LAS h8*)(Kb + (2 * d0 + hi) * 1024 + r32 * 16), k1 = *(const LAS h8*)(Kb + (2 * d0 + hi) * 1024 + (32 + r32) * 16);
        p0 = __builtin_amdgcn_mfma_f32_32x32x16_f16(k0, qf[d0], p0, 0, 0, 0);
        p1 = __builtin_amdgcn_mfma_f32_32x32x16_f16(k1, qf[d0], p1, 0, 0, 0);
    }
}
__device__ __forceinline__ s16x4 tr_read(const LAS unsigned char* p) { return __builtin_amdgcn_ds_read_tr16_b64_v4i16((LAS s16x4*)p); }
__device__ __forceinline__ h8 p8(const f32x16& p, int base) {
    return (h8){(half_t)p[base], (half_t)p[base + 1], (half_t)p[base + 2], (half_t)p[base + 3], (half_t)p[base + 4], (half_t)p[base + 5], (half_t)p[base + 6], (half_t)p[base + 7]};
}
__device__ __forceinline__ void pv_tile(f32x16 (&o)[2], const LAS unsigned char* Vb, const f32x16& p0, const f32x16& p1, int lane) {
    const int hi = lane >> 5;
    const LAS unsigned char* va = Vb + ((lane >> 4) & 1) * 32 + (lane & 3) * 8 + (4 * hi + ((lane & 15) >> 2)) * 64;
    h8 pf[4]; pf[0] = p8(p0, 0); pf[1] = p8(p0, 8); pf[2] = p8(p1, 0); pf[3] = p8(p1, 8);
#pragma unroll
    for (int dh = 0; dh < 2; ++dh)
#pragma unroll
        for (int s = 0; s < 4; ++s) {
            const s16x4 lo = tr_read(va + dh * 4096 + s * 1024), hh = tr_read(va + dh * 4096 + s * 1024 + 512);
            typedef short s16x8 __attribute__((ext_vector_type(8)));
            const s16x8 t8 = {lo[0], lo[1], lo[2], lo[3], hh[0], hh[1], hh[2], hh[3]};
            const h8 vf = __builtin_bit_cast(h8, t8);
            o[dh] = __builtin_amdgcn_mfma_f32_32x32x16_f16(vf, pf[s], o[dh], 0, 0, 0);
        }
}
__device__ __forceinline__ float max16(const f32x16& p) {
    float a = fmaxf(fmaxf(p[0], p[1]), fmaxf(p[2], p[3])), b = fmaxf(fmaxf(p[4], p[5]), fmaxf(p[6], p[7]));
    float c = fmaxf(fmaxf(p[8], p[9]), fmaxf(p[10], p[11])), d = fmaxf(fmaxf(p[12], p[13]), fmaxf(p[14], p[15]));
    return fmaxf(fmaxf(a, b), fmaxf(c, d));
}
__device__ __forceinline__ float sum16(const f32x16& p) {
    return (((p[0] + p[1]) + (p[2] + p[3])) + ((p[4] + p[5]) + (p[6] + p[7]))) + (((p[8] + p[9]) + (p[10] + p[11])) + ((p[12] + p[13]) + (p[14] + p[15])));
}

enum { MODE_WIN = 0, MODE_SEL = 1, MODE_SWA = 2 };
template <int MODE>
__device__ __forceinline__ void attn_unit(const Ctx& C, int b, int hkv, int chunk, const half_t* Q, const half_t* Kh, const half_t* Vh,
                                          const unsigned* selm, const float* Gt, float* Oacc, half_t* O, const float* sinks) {
    constexpr int GH = (MODE == MODE_SWA) ? 8 : 4, TPW = 32 / GH, TPB = 8 * TPW, WIN = (MODE == MODE_SWA) ? 128 : 512;
    const int lane = C.lane, wave = C.wave, r32 = lane & 31, hi = lane >> 5;
    const int t0 = chunk * TPB, tw0 = t0 + wave * TPW, tok = tw0 + r32 / GH, head = hkv * GH + (r32 % GH);
    const size_t gtok = (size_t)b * S + tok;
    LAS unsigned char* lds = C.lds;
    h8 qf[4];
#pragma unroll
    for (int d0 = 0; d0 < 4; ++d0) qf[d0] = *(const h8*)(Q + gtok * D + head * 64 + d0 * 16 + hi * 8);
    const int jlast = (t0 + TPB - 1) >> 6;
    unsigned tiles, msk = 0u, wneed = 0u;
    if (MODE == MODE_SEL) {
        msk = selm[tok]; unsigned x = msk;
#pragma unroll
        for (int o = 1; o < 64; o <<= 1) x |= (unsigned)shxi((int)x, o, lane);
        wneed = (unsigned)__builtin_amdgcn_readfirstlane((int)x);
        LAS unsigned* bw = (LAS unsigned*)(lds + AL_W);
        if (C.tid == 0) bw[0] = 0u;
        __syncthreads();
        if (lane == 0) __hip_atomic_fetch_or(bw, wneed, __ATOMIC_RELAXED, __HIP_MEMORY_SCOPE_WORKGROUP);
        __syncthreads();
        tiles = bw[0];
        tiles = (unsigned)__builtin_amdgcn_readfirstlane((int)tiles);
    } else {
        const int kfirst = t0 - WIN + 1, jlo = (kfirst > 0 ? kfirst : 0) >> 6;
        tiles = (jlast >= 31 ? 0xffffffffu : ((1u << (jlast + 1)) - 1u)) & ~((1u << jlo) - 1u);
    }
    float m = NEG_BIG, l = 0.f; f32x16 o[2]; o[0] = (f32x16){}; o[1] = (f32x16){};
    u32x4 kr, vr; int buf = 0;
    unsigned tm = tiles;
    { const int j = __builtin_ctz(tm); kv_load(Kh + (size_t)j * 4096, Vh + (size_t)j * 4096, wave, lane, kr, vr); kv_store(lds + AL_K, lds + AL_V, wave, lane, kr, vr); }
    __syncthreads();
    while (tm) {
        const int j = __builtin_ctz(tm); tm &= tm - 1u;
        const bool more = tm != 0u;
        if (more) { const int jn = __builtin_ctz(tm); kv_load(Kh + (size_t)jn * 4096, Vh + (size_t)jn * 4096, wave, lane, kr, vr); }
        bool need;
        if (MODE == MODE_SEL) need = (wneed >> j) & 1u;
        else need = (64 * j <= tw0 + TPW - 1) && (64 * j + 63 >= tw0 - WIN + 1);
        if (need) {
            f32x16 p0, p1; qk_tile(p0, p1, lds + AL_K + buf * 8192, qf, r32, hi);
            const bool rowok = (MODE == MODE_SEL) ? (((msk >> j) & 1u) != 0u) : true;
            float tmax = NEG_BIG;
#pragma unroll
            for (int r = 0; r < 16; ++r) { const int k0 = 64 * j + crow(r, hi), k1 = k0 + 32;
                const bool v0 = rowok && (k0 <= tok) && (MODE == MODE_SEL || k0 > tok - WIN), v1 = rowok && (k1 <= tok) && (MODE == MODE_SEL || k1 > tok - WIN);
                p0[r] = v0 ? p0[r] : NEG_BIG; p1[r] = v1 ? p1[r] : NEG_BIG; tmax = fmaxf(tmax, fmaxf(p0[r], p1[r])); }
            tmax = fmaxf(tmax, shx(tmax, 32, lane));
            const float mn = fmaxf(m, tmax), alpha = fast_exp2(m - mn);
            m = mn;
#pragma unroll
            for (int r = 0; r < 16; ++r) { p0[r] = (p0[r] > -1.0e29f) ? fast_exp2(p0[r] - mn) : 0.f; p1[r] = (p1[r] > -1.0e29f) ? fast_exp2(p1[r] - mn) : 0.f; }
            l = l * alpha + (sum16(p0) + sum16(p1));
#pragma unroll
            for (int r = 0; r < 16; ++r) { o[0][r] *= alpha; o[1][r] *= alpha; }
            pv_tile(o, lds + AL_V + buf * 8192, p0, p1, lane);
        }
        if (more) kv_store(lds + AL_K + (buf ^ 1) * 8192, lds + AL_V + (buf ^ 1) * 8192, wave, lane, kr, vr);
        __syncthreads();
        buf ^= 1;
    }
    float lt = l + shx(l, 32, lane);
    if (MODE == MODE_SWA) lt += fast_exp2(sinks[head] * LOG2E - m);
    float sc = 1.0f / lt;
    if (MODE != MODE_SWA) sc *= Gt[gtok * 48 + head * 3 + (MODE == MODE_SEL ? 1 : 2)];
#pragma unroll
    for (int dh = 0; dh < 2; ++dh)
#pragma unroll
        for (int rg = 0; rg < 4; ++rg) { const size_t off = gtok * D + head * 64 + 32 * dh + 8 * rg + 4 * hi;
            f32x4 v = {o[dh][4 * rg] * sc, o[dh][4 * rg + 1] * sc, o[dh][4 * rg + 2] * sc, o[dh][4 * rg + 3] * sc};
            if (MODE == MODE_SEL) { *(f32x4*)(Oacc + off) = *(const f32x4*)(Oacc + off) + v; }
            else { if (MODE == MODE_WIN) v = v + *(const f32x4*)(Oacc + off); *(u32x2*)(O + off) = pk4(v); } }
}

__device__ __forceinline__ void cmp_unit(const Ctx& C, int b, int hkv, int c, const half_t* Q, const half_t* Kc, const half_t* Vc, const float* Gt, float* Oacc, unsigned* selm) {
    const int lane = C.lane, wave = C.wave, r32 = lane & 31, hi = lane >> 5;
    const int t0 = c * 64, tl = wave * 8 + (r32 >> 2), tok = t0 + tl, head = hkv * 4 + (r32 & 3);
    const size_t gtok = (size_t)b * S + tok;
    LAS unsigned char* lds = C.lds;
    h8 qf[4];
#pragma unroll
    for (int d0 = 0; d0 < 4; ++d0) qf[d0] = *(const h8*)(Q + gtok * D + head * 64 + d0 * 16 + hi * 8);
    { u32x4 kr, vr;
      kv_load(Kc, Vc, wave, lane, kr, vr); kv_store(lds + AL_K, lds + AL_V, wave, lane, kr, vr);
      kv_load(Kc + 4096, Vc + 4096, wave, lane, kr, vr); kv_store(lds + AL_K + 8192, lds + AL_V + 8192, wave, lane, kr, vr); }
    __syncthreads();
    f32x16 p[4];
    qk_tile(p[0], p[1], lds + AL_K, qf, r32, hi); qk_tile(p[2], p[3], lds + AL_K + 8192, qf, r32, hi);
    const int nvis = (tok >= 31) ? ((tok - 31) >> 4) + 1 : 0;
    float mx = NEG_BIG;
#pragma unroll
    for (int q = 0; q < 4; ++q)
#pragma unroll
        for (int r = 0; r < 16; ++r) { const int n = 32 * q + crow(r, hi); p[q][r] = (n < nvis) ? p[q][r] : NEG_BIG; mx = fmaxf(mx, p[q][r]); }
    mx = fmaxf(mx, shx(mx, 32, lane));
    float l = 0.f;
#pragma unroll
    for (int q = 0; q < 4; ++q) {
#pragma unroll
        for (int r = 0; r < 16; ++r) p[q][r] = (p[q][r] > -1.0e29f) ? fast_exp2(p[q][r] - mx) : 0.f;
        l += sum16(p[q]); }
    l += shx(l, 32, lane);
    const float inv = (l > 0.f) ? 1.0f / l : 0.f;
#pragma unroll
    for (int q = 0; q < 4; ++q)
#pragma unroll
        for (int r = 0; r < 16; ++r) p[q][r] *= inv;
    f32x16 o[2]; o[0] = (f32x16){}; o[1] = (f32x16){};
    pv_tile(o, lds + AL_V, p[0], p[1], lane); pv_tile(o, lds + AL_V + 8192, p[2], p[3], lane);
    const float g0 = Gt[gtok * 48 + head * 3 + 0];
#pragma unroll
    for (int dh = 0; dh < 2; ++dh)
#pragma unroll
        for (int rg = 0; rg < 4; ++rg) { const size_t off = gtok * D + head * 64 + 32 * dh + 8 * rg + 4 * hi;
            *(f32x4*)(Oacc + off) = (f32x4){o[dh][4 * rg] * g0, o[dh][4 * rg + 1] * g0, o[dh][4 * rg + 2] * g0, o[dh][4 * rg + 3] * g0}; }
    LAS float* ps = (LAS float*)(lds + AL_PSUM);
#pragma unroll
    for (int q = 0; q < 4; ++q)
#pragma unroll
        for (int rg = 0; rg < 4; ++rg) { f32x4 v = {p[q][4 * rg], p[q][4 * rg + 1], p[q][4 * rg + 2], p[q][4 * rg + 3]};
#pragma unroll
            for (int e = 0; e < 4; ++e) { v[e] += shx(v[e], 1, lane); v[e] += shx(v[e], 2, lane); }
            if ((r32 & 3) == 0) *(LAS f32x4*)(ps + tl * 128 + 32 * q + 8 * rg + 4 * hi) = v; }
    __syncthreads();
#pragma unroll 1
    for (int it = 0; it < 4; ++it) {
        const int tl2 = wave * 8 + 2 * it + hi, j = r32; const LAS float* pr = ps + tl2 * 128 + 4 * j;
        const f32x4 q4 = *(const LAS f32x4*)pr; const float pm1 = (j > 0) ? pr[-1] : 0.f;
        const float imp = pm1 + 2.0f * q4[0] + 2.0f * q4[1] + 2.0f * q4[2] + q4[3];
        const bool forced = (j == 0) || (j == c) || (j == c - 1);
        const float val = forced ? __builtin_inff() : ((j <= c) ? imp : -__builtin_inff());
        int rank = 0;
#pragma unroll 8
        for (int jj = 0; jj < 32; ++jj) { const float vv = shidx(val, (lane & 32) + jj); rank += (vv > val || (vv == val && jj < j)) ? 1 : 0; }
        const bool sel = (rank < 8) && (j <= c);
        const unsigned long long bal = __ballot(sel);
        if (r32 == 0) selm[t0 + tl2] = hi ? (unsigned)(bal >> 32) : (unsigned)bal;
    }
    __syncthreads();
}

#ifndef REP_CMPSTAGE
#define REP_CMPSTAGE 1
#endif
#ifndef PROBE_MFMA2
#define PROBE_MFMA2 0
#endif
#ifndef PROBE_EXP2
#define PROBE_EXP2 0
#endif
#ifndef PROBE_LDS2
#define PROBE_LDS2 0
#endif
#ifndef PROBE_BAR2
#define PROBE_BAR2 0
#endif
constexpr int RG_SLOT = 16384;
constexpr int RG_NSLOT = 4;
constexpr int FL_CMPK = 65536, FL_CMPV = 81920, FL_PSUM = 98304, FL_MASK = LDSCTL_OFF + 1024, FL_WORD = LDSCTL_OFF + 1280;
constexpr float ATT_THR = 8.0f, M_INIT = -64.0f;
__device__ __forceinline__ void glds16(const void* gsrc, unsigned lds_dst) { unsigned keep;
    asm volatile("s_mov_b32 %0, m0\n\ts_mov_b32 m0, %2\n\ts_nop 0\n\tglobal_load_lds_dwordx4 %1, off\n\ts_mov_b32 m0, %0" : "=&s"(keep) : "v"(gsrc), "s"(lds_dst) : "memory"); }
#define ATT_WAIT_BAR(N) asm volatile("s_waitcnt vmcnt(" #N ") lgkmcnt(0)\n\ts_barrier" ::: "memory")
__device__ __forceinline__ void dma_tile(const half_t* Kt, const half_t* Vt, unsigned slot, int wave, int lane) {
    glds16(Kt + (size_t)lane * 64 + wave * 8, (unsigned)__builtin_amdgcn_readfirstlane((int)(slot + wave * 1024)));
    glds16(Vt + (size_t)(16 * (wave & 3) + (lane >> 2)) * 64 + (wave >> 2) * 32 + (lane & 3) * 8, (unsigned)__builtin_amdgcn_readfirstlane((int)(slot + 8192 + wave * 1024)));
}
template <int CTRL> __device__ __forceinline__ float dpp_f(float v) { return __builtin_bit_cast(float, __builtin_amdgcn_update_dpp(0, __builtin_bit_cast(int, v), CTRL, 0xF, 0xF, true)); }
__device__ __forceinline__ float swapmax(float v) { auto rr = __builtin_amdgcn_permlane32_swap(__float_as_uint(v), __float_as_uint(v), false, false); return fmaxf(__uint_as_float(rr[0]), __uint_as_float(rr[1])); }
__device__ __forceinline__ float swapsum(float v) { auto rr = __builtin_amdgcn_permlane32_swap(__float_as_uint(v), __float_as_uint(v), false, false); return __uint_as_float(rr[0]) + __uint_as_float(rr[1]); }

__device__ __forceinline__ float max3f(float a, float b, float c) { return __builtin_fmaxf(__builtin_fmaxf(a, b), c); }
__device__ __forceinline__ void k_frags(h8 (&kf)[8], const LAS unsigned char* Kb, int r32, int hi) {
#pragma unroll
    for (int d0 = 0; d0 < 4; ++d0) { kf[2 * d0] = *(const LAS h8*)(Kb + (2 * d0 + hi) * 1024 + r32 * 16); kf[2 * d0 + 1] = *(const LAS h8*)(Kb + (2 * d0 + hi) * 1024 + (32 + r32) * 16); }
}
template <bool PREF>
__device__ __forceinline__ void tile_step(const bool BOUNDARY, float& m, float& l, f32x16 (&o)[2], const h8 (&qf)[4], const h8 (&kf)[8], h8 (&kfn)[8],
                                          const LAS unsigned char* Vb, const LAS unsigned char* Kn, float rowbias, int kbase, int tok, int win, int lane) {
    typedef short s16x8 __attribute__((ext_vector_type(8)));
    const int r32 = lane & 31, hi = lane >> 5;
    const float ci = rowbias - m;
    f32x16 p0, p1;
#pragma unroll
    for (int r = 0; r < 16; ++r) { p0[r] = ci; p1[r] = ci; }
#pragma unroll
    for (int d0 = 0; d0 < 4; ++d0) {
        p0 = __builtin_amdgcn_mfma_f32_32x32x16_f16(kf[2 * d0], qf[d0], p0, 0, 0, 0);
        p1 = __builtin_amdgcn_mfma_f32_32x32x16_f16(kf[2 * d0 + 1], qf[d0], p1, 0, 0, 0);
    }
    if (PROBE_MFMA2) { f32x16 d0_ = p0, d1_ = p1;
#pragma unroll
        for (int d0 = 0; d0 < 4; ++d0) { d0_ = __builtin_amdgcn_mfma_f32_32x32x16_f16(kf[2 * d0], qf[d0], d0_, 0, 0, 0); d1_ = __builtin_amdgcn_mfma_f32_32x32x16_f16(kf[2 * d0 + 1], qf[d0], d1_, 0, 0, 0); }
        asm volatile("" :: "v"(d0_), "v"(d1_)); }
    const LAS unsigned char* va = Vb + ((lane >> 4) & 1) * 32 + (lane & 3) * 8 + (4 * hi + ((lane & 15) >> 2)) * 64;
    s16x4 vlo[8], vhi[8];
#pragma unroll
    for (int i = 0; i < 8; ++i) { vlo[i] = tr_read(va + (i >> 2) * 4096 + (i & 3) * 1024); vhi[i] = tr_read(va + (i >> 2) * 4096 + (i & 3) * 1024 + 512); }
    asm volatile("" ::: "memory");
    if (PREF) k_frags(kfn, Kn, r32, hi);
    asm volatile("" ::: "memory");
    if (BOUNDARY) {
        asm volatile("; boundary tile" ::: "memory");
        const int ub = tok - kbase - 4 * hi, lb = ub - win;
#pragma unroll
        for (int r = 0; r < 16; ++r) { const int cr = (r & 3) + 8 * (r >> 2);
            p0[r] = (cr <= ub && cr > lb) ? p0[r] : NEG_BIG; p1[r] = (cr + 32 <= ub && cr + 32 > lb) ? p1[r] : NEG_BIG; }
    }
    float ta = max3f(p0[0], p0[1], p0[2]), tb = max3f(p1[0], p1[1], p1[2]);
    ta = max3f(ta, p0[3], p0[4]); tb = max3f(tb, p1[3], p1[4]); ta = max3f(ta, p0[5], p0[6]); tb = max3f(tb, p1[5], p1[6]);
    ta = max3f(ta, p0[7], p0[8]); tb = max3f(tb, p1[7], p1[8]); ta = max3f(ta, p0[9], p0[10]); tb = max3f(tb, p1[9], p1[10]);
    ta = max3f(ta, p0[11], p0[12]); tb = max3f(tb, p1[11], p1[12]); ta = max3f(ta, p0[13], p0[14]); tb = max3f(tb, p1[13], p1[14]);
    const float tmax = swapmax(max3f(ta, tb, fmaxf(p0[15], p1[15])));
    if (__any(tmax > ATT_THR)) {
        asm volatile("; rescale" ::: "memory");
        const float dl = fmaxf(tmax, 0.f), f = fast_exp2(-dl);
        m += dl; l *= f;
#pragma unroll
        for (int r = 0; r < 16; ++r) { o[0][r] *= f; o[1][r] *= f; p0[r] -= dl; p1[r] -= dl; }
    }
    if (PROBE_EXP2) { f32x16 e_;
#pragma unroll
        for (int r = 0; r < 16; ++r) e_[r] = fast_exp2(p0[r] + 1.0f);
        asm volatile("" :: "v"(e_));
#pragma unroll
        for (int r = 0; r < 16; ++r) e_[r] = fast_exp2(p1[r] + 1.0f);
        asm volatile("" :: "v"(e_)); }
#pragma unroll
    for (int r = 0; r < 16; ++r) { p0[r] = fast_exp2(p0[r]); p1[r] = fast_exp2(p1[r]); }
    f32x2 s2 = {0.f, 0.f};
#pragma unroll
    for (int r = 0; r < 16; r += 2) { s2 += (f32x2){p0[r], p0[r + 1]}; s2 += (f32x2){p1[r], p1[r + 1]}; }
    l += s2[0] + s2[1];
    h8 pf[4]; pf[0] = p8(p0, 0); pf[1] = p8(p0, 8); pf[2] = p8(p1, 0); pf[3] = p8(p1, 8);
    asm volatile("s_waitcnt lgkmcnt(0)" : "+v"(vlo[0]), "+v"(vlo[1]), "+v"(vlo[2]), "+v"(vlo[3]), "+v"(vlo[4]), "+v"(vlo[5]), "+v"(vlo[6]), "+v"(vlo[7]),
                 "+v"(vhi[0]), "+v"(vhi[1]), "+v"(vhi[2]), "+v"(vhi[3]), "+v"(vhi[4]), "+v"(vhi[5]), "+v"(vhi[6]), "+v"(vhi[7]) :: "memory");
#pragma unroll
    for (int s = 0; s < 4; ++s)
#pragma unroll
        for (int dh = 0; dh < 2; ++dh) { const int i = dh * 4 + s;
            const s16x8 t8 = {vlo[i][0], vlo[i][1], vlo[i][2], vlo[i][3], vhi[i][0], vhi[i][1], vhi[i][2], vhi[i][3]};
            o[dh] = __builtin_amdgcn_mfma_f32_32x32x16_f16(__builtin_bit_cast(h8, t8), pf[s], o[dh], 0, 0, 0); }
}

__device__ __forceinline__ void nsa_unit(const Ctx& C, int b, int hkv, int c, const half_t* Q, const half_t* KV, const half_t* KCC, const float* Gt, half_t* O, const bool dry = false) {
    int lane_ = C.lane; asm volatile("" : "+v"(lane_));
    const int lane = lane_, wave = C.wave, r32 = lane & 31, hi = lane >> 5;
    const int bh = b * 4 + hkv, t0 = c * 64, tw0 = t0 + wave * 8, tl = wave * 8 + (r32 >> 2), tok = t0 + tl, head = hkv * 4 + (r32 & 3);
    const size_t gtok = (size_t)b * S + tok;
    LAS unsigned char* lds = C.lds;
    const unsigned ring = (unsigned)(size_t)lds;
    const half_t* Ks = KV + 2 * KVT + (size_t)bh * S * 64; const half_t* Vs = KV + 3 * KVT + (size_t)bh * S * 64;
    const half_t* Kw = KV + 4 * KVT + (size_t)bh * S * 64; const half_t* Vw = KV + 5 * KVT + (size_t)bh * S * 64;
    const int jlo = (c > 8) ? c - 8 : 0, n_win = dry ? 1 : c - jlo + 1;
    asm volatile("s_waitcnt vmcnt(0)" ::: "memory");
    dma_tile(Kw + (size_t)jlo * 4096, Vw + (size_t)jlo * 4096, ring, wave, lane);
    if (n_win >= 2) dma_tile(Kw + (size_t)(jlo + 1) * 4096, Vw + (size_t)(jlo + 1) * 4096, ring + RG_SLOT, wave, lane);
    if (n_win >= 3) dma_tile(Kw + (size_t)(jlo + 2) * 4096, Vw + (size_t)(jlo + 2) * 4096, ring + 2 * RG_SLOT, wave, lane);
    h8 qf[4];
#pragma unroll
    for (int d0 = 0; d0 < 4; ++d0) qf[d0] = *(const h8*)(Q + gtok * D + head * 64 + d0 * 16 + hi * 8);
    const float g_cmp = Gt[gtok * 48 + head * 3 + 0], g_sel = Gt[gtok * 48 + head * 3 + 1], g_win = Gt[gtok * 48 + head * 3 + 2];
    f32x16 oc[2];
    REPEAT(REP_CMPSTAGE) {
        const half_t* Kc = KCC + (size_t)bh * 128 * 64; const half_t* Vc = Kc + (size_t)64 * 128 * 64;
        { u32x4 kr, vr;
          kv_load(Kc, Vc, wave, lane, kr, vr); kv_store(lds + FL_CMPK, lds + FL_CMPV, wave, lane, kr, vr);
          kv_load(Kc + 4096, Vc + 4096, wave, lane, kr, vr); kv_store(lds + FL_CMPK + 8192, lds + FL_CMPV + 8192, wave, lane, kr, vr); }
        if (C.tid == 0) ((LAS unsigned*)(lds + FL_WORD))[0] = 0u;
        __syncthreads();
        const bool two = c > 15;
        f32x16 p[4];
        { h8 ka[8], kb[8]; k_frags(ka, lds + FL_CMPK, r32, hi); if (two) k_frags(kb, lds + FL_CMPK + 8192, r32, hi);
          asm volatile("s_waitcnt lgkmcnt(0)" : "+v"(ka[0]), "+v"(ka[1]), "+v"(ka[2]), "+v"(ka[3]), "+v"(ka[4]), "+v"(ka[5]), "+v"(ka[6]), "+v"(ka[7]) :: "memory");
          p[0] = (f32x16){}; p[1] = (f32x16){};
#pragma unroll
          for (int d0 = 0; d0 < 4; ++d0) { p[0] = __builtin_amdgcn_mfma_f32_32x32x16_f16(ka[2 * d0], qf[d0], p[0], 0, 0, 0); p[1] = __builtin_amdgcn_mfma_f32_32x32x16_f16(ka[2 * d0 + 1], qf[d0], p[1], 0, 0, 0); }
          if (two) { p[2] = (f32x16){}; p[3] = (f32x16){};
#pragma unroll
              for (int d0 = 0; d0 < 4; ++d0) { p[2] = __builtin_amdgcn_mfma_f32_32x32x16_f16(kb[2 * d0], qf[d0], p[2], 0, 0, 0); p[3] = __builtin_amdgcn_mfma_f32_32x32x16_f16(kb[2 * d0 + 1], qf[d0], p[3], 0, 0, 0); } }
          else {
#pragma unroll
              for (int r = 0; r < 16; ++r) { p[2][r] = NEG_BIG; p[3][r] = NEG_BIG; } } }
        const int nvis = ((tok >= 31) ? ((tok - 31) >> 4) + 1 : 0) - 4 * hi;
        float mx = NEG_BIG;
#pragma unroll
        for (int q = 0; q < 4; ++q)
#pragma unroll
            for (int r = 0; r < 16; ++r) { const int cn = 32 * q + (r & 3) + 8 * (r >> 2); p[q][r] = (cn < nvis) ? p[q][r] : NEG_BIG; mx = fmaxf(mx, p[q][r]); }
        mx = swapmax(mx);
        float l = 0.f;
#pragma unroll
        for (int q = 0; q < 4; ++q) {
#pragma unroll
            for (int r = 0; r < 16; ++r) p[q][r] = (p[q][r] > -1.0e29f) ? fast_exp2(p[q][r] - mx) : 0.f;
            l += sum16(p[q]); }
        l = swapsum(l);
        const float inv = (l > 0.f) ? 1.0f / l : 0.f;
#pragma unroll
        for (int q = 0; q < 4; ++q)
#pragma unroll
            for (int r = 0; r < 16; ++r) p[q][r] *= inv;
        oc[0] = (f32x16){}; oc[1] = (f32x16){};
        pv_tile(oc, lds + FL_CMPV, p[0], p[1], lane); if (two) pv_tile(oc, lds + FL_CMPV + 8192, p[2], p[3], lane);
#pragma unroll
        for (int r = 0; r < 16; ++r) { oc[0][r] *= g_cmp; oc[1][r] *= g_cmp; }
        LAS float* ps = (LAS float*)(lds + FL_PSUM);
#pragma unroll
        for (int q = 0; q < 4; ++q)
#pragma unroll
            for (int rg = 0; rg < 4; ++rg) { f32x4 v = {p[q][4 * rg], p[q][4 * rg + 1], p[q][4 * rg + 2], p[q][4 * rg + 3]};
#pragma unroll
                for (int e = 0; e < 4; ++e) { v[e] += dpp_f<0xB1>(v[e]); v[e] += dpp_f<0x4E>(v[e]); }
                if ((r32 & 3) == 0) *(LAS f32x4*)(ps + tl * 128 + 32 * q + 8 * rg + 4 * hi) = v; }
        asm volatile("s_waitcnt lgkmcnt(0)" ::: "memory");
        LAS unsigned* mk = (LAS unsigned*)(lds + FL_MASK); unsigned wor = 0u;
        if (c < 8) {
            const unsigned all = (2u << c) - 1u;
            if (lane < 8) mk[wave * 8 + lane] = all;
            wor = all;
        } else {
            LAS float* vl = (LAS float*)(lds + 3 * RG_SLOT) + wave * 256;
            float val[4];
#pragma unroll
            for (int it = 0; it < 4; ++it) {
                const int tl2 = wave * 8 + 2 * it + hi, j = r32; const LAS float* pr = ps + tl2 * 128 + 4 * j;
                const f32x4 q4 = *(const LAS f32x4*)pr; const float pm1 = (j > 0) ? pr[-1] : 0.f;
                const float imp = pm1 + 2.0f * q4[0] + 2.0f * q4[1] + 2.0f * q4[2] + q4[3];
                const bool forced = (j == 0) || (j == c) || (j == c - 1);
                val[it] = forced ? __builtin_inff() : ((j <= c) ? imp : -__builtin_inff());
            }
#pragma unroll
            for (int it = 0; it < 4; ++it) vl[(2 * it + hi) * 32 + r32] = val[it];
            asm volatile("s_waitcnt lgkmcnt(0)" ::: "memory");
#pragma unroll 1
            for (int it = 0; it < 4; ++it) {
                const LAS f32x4* vr = (const LAS f32x4*)(vl + (2 * it + hi) * 32); const int j = r32; const float v0 = val[it];
                f32x4 w[8];
#pragma unroll
                for (int q = 0; q < 8; ++q) w[q] = vr[q];
                int rank = 0;
#pragma unroll
                for (int q = 0; q < 8; ++q)
#pragma unroll
                    for (int e = 0; e < 4; ++e) { const float vv = w[q][e]; const int jj = 4 * q + e; rank += (vv > v0 || (vv == v0 && jj < j)) ? 1 : 0; }
                const bool sel = (rank < 8) && (j <= c);
                const unsigned long long bal = __ballot(sel);
                const unsigned mine = hi ? (unsigned)(bal >> 32) : (unsigned)bal;
                if (r32 == 0) mk[wave * 8 + 2 * it + hi] = mine;
                wor |= (unsigned)bal | (unsigned)(bal >> 32);
            }
        }
        if (lane == 0) __hip_atomic_fetch_or((LAS unsigned*)(lds + FL_WORD), wor, __ATOMIC_RELAXED, __HIP_MEMORY_SCOPE_WORKGROUP);
        __syncthreads();
    }
    LAS f32x4* ocl = (LAS f32x4*)(lds + FL_CMPK + wave * 8192) + lane;
#pragma unroll
    for (int q = 0; q < 8; ++q) ocl[q * 64] = (f32x4){oc[q >> 2][4 * (q & 3)], oc[q >> 2][4 * (q & 3) + 1], oc[q >> 2][4 * (q & 3) + 2], oc[q >> 2][4 * (q & 3) + 3]};
    const unsigned msk = ((const LAS unsigned*)(lds + FL_MASK))[tl];
    unsigned wneed = msk;
#pragma unroll
    for (int o_ = 1; o_ < 64; o_ <<= 1) wneed |= (unsigned)shxi((int)wneed, o_, lane);
    wneed = (unsigned)__builtin_amdgcn_readfirstlane((int)wneed);
    const unsigned bneed = dry ? 0u : (unsigned)__builtin_amdgcn_readfirstlane((int)((const LAS unsigned*)(lds + FL_WORD))[0]);
    const int n_tot = n_win + __builtin_popcount(bneed);
    unsigned dbits = bneed, cbits = bneed;
    if (n_win < 2 && n_tot >= 2) { const int j = __builtin_ctz(dbits); dbits &= dbits - 1u; dma_tile(Ks + (size_t)j * 4096, Vs + (size_t)j * 4096, ring + RG_SLOT, wave, lane); }
    if (n_win < 3 && n_tot >= 3) { const int j = __builtin_ctz(dbits); dbits &= dbits - 1u; dma_tile(Ks + (size_t)j * 4096, Vs + (size_t)j * 4096, ring + 2 * RG_SLOT, wave, lane); }
    float m = M_INIT, l = 0.f; f32x16 o[2]; o[0] = (f32x16){}; o[1] = (f32x16){};
    h8 kf[8];
    int j_c, win_c, j_n = 0, win_n = 512; bool need_c, bnd_c, need_n = false, bnd_n = false; float rb_c, rb_n = 0.f;
#define NSA_DECODE(E, J, NEED, BND, RB, WIN) do { if ((E) < n_win) { J = jlo + (E); NEED = (64 * J <= tw0 + 7) && (64 * J + 63 >= tw0 - 511); BND = (64 * J + 63 > tw0) || (64 * J <= tw0 + 7 - 512); RB = 0.f; WIN = 512; } \
        else { J = __builtin_ctz(cbits); cbits &= cbits - 1u; NEED = (wneed >> J) & 1u; BND = (J == c); RB = ((msk >> J) & 1u) ? 0.f : NEG_BIG; WIN = 1 << 20; } } while (0)
    NSA_DECODE(0, j_c, need_c, bnd_c, rb_c, win_c);
    if (n_tot >= 3) ATT_WAIT_BAR(2); else ATT_WAIT_BAR(0);
    h8 kfB[8];
    if (need_c) k_frags(kf, lds, r32, hi);
    int slot_c = 0, slot_d = 3;
#define NSA_STEP(E, KU, KP) do { \
        if ((E) > 0) { if ((E) + 2 < n_tot) ATT_WAIT_BAR(2); else ATT_WAIT_BAR(0); }     \
        if (PROBE_BAR2) asm volatile("s_barrier" ::: "memory"); \
        if ((E) + 3 < n_tot) { \
            if ((E) + 3 < n_win) { const int jn = jlo + (E) + 3; dma_tile(Kw + (size_t)jn * 4096, Vw + (size_t)jn * 4096, ring + slot_d * RG_SLOT, wave, lane); } \
            else { const int jn = __builtin_ctz(dbits); dbits &= dbits - 1u; dma_tile(Ks + (size_t)jn * 4096, Vs + (size_t)jn * 4096, ring + slot_d * RG_SLOT, wave, lane); } \
        } \
        const bool has_n = (E) + 1 < n_tot; \
        if (has_n) NSA_DECODE((E) + 1, j_n, need_n, bnd_n, rb_n, win_n); \
        const int slot_n = (slot_c == RG_NSLOT - 1) ? 0 : slot_c + 1; \
        const LAS unsigned char* Vb = lds + slot_c * RG_SLOT + 8192; const LAS unsigned char* Kn = lds + slot_n * RG_SLOT; \
        if (need_c) tile_step<true>(bnd_c, m, l, o, qf, KU, KP, Vb, Kn, rb_c, 64 * j_c, tok, win_c, lane);     \
        else k_frags(KP, Kn, r32, hi); \
        if ((E) == n_win - 1) {                                          \
            const float sc = g_win / swapsum(l); \
            _Pragma("unroll") for (int q = 0; q < 8; ++q) { f32x4 t = ocl[q * 64]; t[0] += o[q >> 2][4 * (q & 3)] * sc; t[1] += o[q >> 2][4 * (q & 3) + 1] * sc; t[2] += o[q >> 2][4 * (q & 3) + 2] * sc; t[3] += o[q >> 2][4 * (q & 3) + 3] * sc; ocl[q * 64] = t; } \
            o[0] = (f32x16){}; o[1] = (f32x16){}; \
            m = M_INIT; l = 0.f; \
        } \
        j_c = j_n; need_c = need_n; bnd_c = bnd_n; rb_c = rb_n; win_c = win_n; \
        slot_c = slot_n; slot_d = (slot_d == RG_NSLOT - 1) ? 0 : slot_d + 1; \
    } while (0)
#pragma unroll 1
    for (int e = 0; e < n_tot; e += 2) {
        NSA_STEP(e, kf, kfB);
        if (e + 1 < n_tot) NSA_STEP(e + 1, kfB, kf);
    }
#undef NSA_STEP
#undef NSA_DECODE
    {
        const float sc = g_sel / swapsum(l);
#pragma unroll
        for (int dh = 0; dh < 2; ++dh)
#pragma unroll
            for (int rg = 0; rg < 4; ++rg) { const size_t off = gtok * D + head * 64 + 32 * dh + 8 * rg + 4 * hi;
                const f32x4 t = ocl[(dh * 4 + rg) * 64];
                const f32x4 v = {t[0] + o[dh][4 * rg] * sc, t[1] + o[dh][4 * rg + 1] * sc, t[2] + o[dh][4 * rg + 2] * sc, t[3] + o[dh][4 * rg + 3] * sc};
                if (!dry) *(u32x2*)(O + off) = pk4(v); }
    }
    asm volatile("s_waitcnt lgkmcnt(0)\n\ts_barrier" ::: "memory");
}

__device__ __forceinline__ void swa_unit(const Ctx& C, int b, int hkv, int cc, const half_t* Q, const half_t* Kh, const half_t* Vh, const float* sinks, half_t* O) {
    int lane_ = C.lane; asm volatile("" : "+v"(lane_));
    const int lane = lane_, wave = C.wave, r32 = lane & 31, hi = lane >> 5;
    const int t0 = cc * 32, tw0 = t0 + 4 * wave, tok = tw0 + (r32 >> 3), head = hkv * 8 + (r32 & 7);
    const size_t gtok = (size_t)b * S + tok;
    LAS unsigned char* lds = C.lds; const unsigned ring = (unsigned)(size_t)lds;
    const int jhi = (t0 + 31) >> 6, jlo = ((t0 > 127) ? (t0 - 127) : 0) >> 6, n_tot = jhi - jlo + 1;
    asm volatile("s_waitcnt vmcnt(0)" ::: "memory");
    dma_tile(Kh + (size_t)jlo * 4096, Vh + (size_t)jlo * 4096, ring, wave, lane);
    if (n_tot >= 2) dma_tile(Kh + (size_t)(jlo + 1) * 4096, Vh + (size_t)(jlo + 1) * 4096, ring + RG_SLOT, wave, lane);
    if (n_tot >= 3) dma_tile(Kh + (size_t)(jlo + 2) * 4096, Vh + (size_t)(jlo + 2) * 4096, ring + 2 * RG_SLOT, wave, lane);
    h8 qf[4];
#pragma unroll
    for (int d0 = 0; d0 < 4; ++d0) qf[d0] = *(const h8*)(Q + gtok * D + head * 64 + d0 * 16 + hi * 8);
    float m = M_INIT, l = 0.f; f32x16 o[2]; o[0] = (f32x16){}; o[1] = (f32x16){};
    const float sk = sinks[head] * LOG2E;
#define SWA_NEED(JT) ((64 * (JT) <= tw0 + 3) && (64 * (JT) + 63 >= tw0 - 127))
#define SWA_BND(JT) ((64 * (JT) + 63 > tw0) || (64 * (JT) <= tw0 + 3 - 128))
    if (n_tot >= 3) ATT_WAIT_BAR(2); else ATT_WAIT_BAR(0);
#pragma unroll 1
    for (int e = 0; e < n_tot; ++e) {
        if (e > 0) ATT_WAIT_BAR(0);
        if (PROBE_BAR2) asm volatile("s_barrier" ::: "memory");
        const int jt = jlo + e;
        const LAS unsigned char* Kb = lds + e * RG_SLOT;
        if (SWA_NEED(jt)) { h8 kf[8], kfd[8]; k_frags(kf, Kb, r32, hi); tile_step<false>(SWA_BND(jt), m, l, o, qf, kf, kfd, Kb + 8192, Kb, 0.f, 64 * jt, tok, 128, lane); }
    }
#undef SWA_NEED
#undef SWA_BND
    const float sc = 1.0f / (swapsum(l) + fast_exp2(sk - m));
#pragma unroll
    for (int dh = 0; dh < 2; ++dh)
#pragma unroll
        for (int rg = 0; rg < 4; ++rg) { const size_t off = gtok * D + head * 64 + 32 * dh + 8 * rg + 4 * hi;
            const f32x4 v = {o[dh][4 * rg] * sc, o[dh][4 * rg + 1] * sc, o[dh][4 * rg + 2] * sc, o[dh][4 * rg + 3] * sc};
            *(u32x2*)(O + off) = pk4(v); }
    asm volatile("s_waitcnt lgkmcnt(0)\n\ts_barrier" ::: "memory");
}

#ifndef EN_PRO
#define EN_PRO 1
#endif
#ifndef EN_ROW
#define EN_ROW 1
#endif
#ifndef EN_INPROJ
#define EN_INPROJ 1
#endif
#ifndef EN_CMP1
#define EN_CMP1 1
#endif
#ifndef EN_CMP2
#define EN_CMP2 1
#endif
#ifndef EN_CMPATT
#define EN_CMPATT 1
#endif
#ifndef EN_SEL
#define EN_SEL 1
#endif
#ifndef EN_WIN
#define EN_WIN 1
#endif
#ifndef EN_SWA
#define EN_SWA 1
#endif
#ifndef EN_OUT
#define EN_OUT 1
#endif
#ifndef EN_UP
#define EN_UP 1
#endif
#ifndef EN_DOWN
#define EN_DOWN 1
#endif
#ifndef REP_PRO
#define REP_PRO 1
#endif
#ifndef REP_ROWF
#define REP_ROWF 1
#endif
#ifndef REP_INPROJ
#define REP_INPROJ 1
#endif
#ifndef REP_CMP1
#define REP_CMP1 1
#endif
#ifndef REP_CMP2
#define REP_CMP2 1
#endif
#ifndef REP_NSA
#define REP_NSA 1
#endif
#ifndef REP_SWA
#define REP_SWA 1
#endif
#ifndef REP_OUT
#define REP_OUT 1
#endif
#ifndef REP_UP
#define REP_UP 1
#endif
#ifndef REP_DOWN
#define REP_DOWN 1
#endif
#ifndef PROBE_DRY
#define PROBE_DRY 0
#endif
constexpr int NPHASE = 3 + 11 * DEPTH;
__host__ __device__ constexpr bool phase_exists(int p) { return p < 3 ? true : (((p - 3) / 11) % 2 == 0 ? !(((p - 3) % 11) == 4 || ((p - 3) % 11) == 5) : !(((p - 3) % 11) >= 1 && ((p - 3) % 11) <= 4)); }

__global__ void __launch_bounds__(512, 2) mk_fwd(Args a) {
    extern __shared__ __attribute__((aligned(16))) unsigned char lds_raw[];
    Ctx C;
    C.lds = (LAS unsigned char*)lds_raw;
    const int wave0 = __builtin_amdgcn_readfirstlane((int)(threadIdx.x >> 6));
    C.lane = (int)__builtin_amdgcn_mbcnt_hi(~0u, __builtin_amdgcn_mbcnt_lo(~0u, 0u)); C.wave = wave0; C.tid = wave0 * 64 + C.lane;
    C.G = gridDim.x; C.gw = blockIdx.x * 8 + C.wave; C.ngw = C.G * 8; C.ws = (unsigned char*)a.ws;
    GAS unsigned char* ws = a.ws;
    for (int u = C.tid; u < (LDS_BYTES - LDSCTL_OFF) / 4; u += 512) ((LAS unsigned*)(C.lds + LDSCTL_OFF))[u] = 0u;
    __syncthreads();
#if MK_ONE_LAUNCH
    XcdBarrier bar = xcd_barrier_post((unsigned*)(ws + WS_CTL) + CW_BAR, (volatile LAS unsigned*)(C.lds + MISC_OFF) + 8);
#define SEAM() xcd_barrier(bar)
#else
#define SEAM() do { } while (0)
#endif
    const int lo = a.ph_lo, hi = a.ph_hi;
#define RUN(p) (lo <= (p) && (p) < hi)
#define FRESH() Ctx Cp = C; ArgsP ap = (ArgsP)__builtin_amdgcn_kernarg_segment_ptr(); { int w_ = wave0; asm volatile("" : "+s"(w_), "+s"(ap)); int l_; asm volatile("v_mbcnt_lo_u32_b32 %0, -1, 0\n\tv_mbcnt_hi_u32_b32 %0, -1, %0" : "=v"(l_)); Cp.tid = w_ * 64 + l_; Cp.lane = l_; Cp.wave = w_; Cp.gw = blockIdx.x * 8 + w_; } GAS unsigned char* const wsx = ap->ws; Cp.ws = (unsigned char*)wsx; (void)wsx;
#define Hb ((half_t*)(wsx + WS_H))
#define Yb ((half_t*)(wsx + WS_Y))
#define Qb ((half_t*)(wsx + WS_Q))
#define KVb ((half_t*)(wsx + WS_KV))
#define Ob ((half_t*)(wsx + WS_O))
#define Gb ((float*)(wsx + WS_G))
#define HIDb ((half_t*)(wsx + WS_BIG))
#define ropeb ((const float*)(wsx + WS_ROPE))

    if (EN_PRO && RUN(0)) { FRESH(); REPEAT(REP_PRO) { phase_prologue(ap, Cp); __syncthreads(); } SEAM(); }
    if (EN_PRO && RUN(1)) { FRESH(); phase_modfinal(ap, Cp); SEAM(); }
    if (EN_ROW && RUN(2)) { FRESH(); REPEAT(REP_ROWF) phase_row_first(ap, Cp); SEAM(); }

#pragma unroll 1
    for (int L = 0; L < DEPTH; ++L) {
        const int pb = 3 + 11 * L, la = L >> 1; const bool nsa = (L & 1) == 0;
        if (EN_INPROJ && RUN(pb + 0)) { FRESH();
            if (nsa) { pg8::Gemm g{Hb, (const half_t*)(wsx + WS_WINN) + (size_t)la * NSA_INP * D, M, NSA_INP, D, D}; pg8::StaticOrder So; So.init(M, NSA_INP, C.G, (int)blockIdx.x);
                pg8::EpiNsaIn E{Qb, KVb, Gb, ropeb};
                REPEAT(REP_INPROJ) pg8::gemm_phase<pg8::EpiNsaIn, pg8::StaticOrder, true, true>(C.lds, g, So, E, Cp.tid);
            } else { pg8::Gemm g{Hb, (const half_t*)(wsx + WS_WINS) + (size_t)la * SWA_IN * D, M, SWA_IN, D, D}; pg8::StaticOrder So; So.init(M, SWA_IN, C.G, (int)blockIdx.x);
                pg8::EpiSwaIn E{Qb, KVb, ropeb};
                REPEAT(REP_INPROJ) pg8::gemm_phase<pg8::EpiSwaIn, pg8::StaticOrder, true, true>(C.lds, g, So, E, Cp.tid);
            }
            SEAM();
        }
        if (nsa) {
            if (EN_CMP1 && RUN(pb + 1)) { FRESH();
                pg8::Gemm g{KVb, (const half_t*)(wsx + WS_W1T) + (size_t)la * 512 * 2048, 16384, 512, 2048, 1024}; pg8::CmpOrder So{C.G, (int)blockIdx.x};
                pg8::EpiF16<2> E{(half_t*)(wsx + WS_HIDC), 256, (const float*)(wsx + WS_B1F) + la * 512};
                REPEAT(REP_CMP1) pg8::gemm_phase<pg8::EpiF16<2>, pg8::CmpOrder, true, true>(C.lds, g, So, E, Cp.tid);
                SEAM();
            }
            if (EN_CMP2 && RUN(pb + 2)) { FRESH(); REPEAT(REP_CMP2) phase_cmp2(ap, Cp, la); SEAM(); }
            if (EN_CMPATT && RUN(pb + 3)) { FRESH();
                REPEAT(REP_NSA) for (int u = blockIdx.x; u < NB * 4 * 32; u += C.G) { const int k = u & 255, i = u >> 8, bh = k >> 2, s_ = k & 3, a_ = 3 - (i >> 1), c = (i & 1) ? (8 * a_ + s_) : (8 * a_ + 7 - s_);
                    nsa_unit(Cp, bh >> 2, bh & 3, c, Qb, KVb, (const half_t*)(wsx + WS_KCC), Gb, Ob);
                    if (PROBE_DRY) nsa_unit(Cp, bh >> 2, bh & 3, c, Qb, KVb, (const half_t*)(wsx + WS_KCC), Gb, Ob, true); }
                SEAM();
            }
        } else {
            if (EN_SWA && RUN(pb + 5)) { FRESH();
                const float* sinks = (const float*)ap->in[15] + la * 16;
                REPEAT(REP_SWA) for (int u = blockIdx.x; u < NB * 2 * 64; u += C.G) { const int j = 63 - (u & 63), bh = u >> 6;
                    swa_unit(Cp, bh >> 1, bh & 1, j, Qb, KVb + (size_t)bh * S * 64, KVb + (size_t)M * 128 + (size_t)bh * S * 64, sinks, Ob); }
                SEAM();
            }
        }
        if (EN_OUT && RUN(pb + 6)) { FRESH();
            pg8::Gemm g{Ob, (const half_t*)(wsx + WS_WOUT) + (size_t)L * D * D, M, D, D, D}; pg8::StaticOrder So; So.init(M, D, C.G, (int)blockIdx.x);
            pg8::EpiF16<0> E{Yb, D, nullptr};
            REPEAT(REP_OUT) pg8::gemm_phase<pg8::EpiF16<0>, pg8::StaticOrder, true, true>(C.lds, g, So, E, Cp.tid);
            SEAM();
        }
        if (EN_ROW && RUN(pb + 7)) { FRESH(); phase_row_update(ap, Cp, L, 0); SEAM(); }
        if (EN_UP && RUN(pb + 8)) { FRESH();
            pg8::Gemm g{Hb, (const half_t*)(wsx + WS_WUP) + (size_t)L * FF * D, M, FF, D, D}; pg8::StaticOrder So; So.init(M, FF, C.G, (int)blockIdx.x);
            pg8::EpiF16<1> E{HIDb, FF, nullptr};
            REPEAT(REP_UP) pg8::gemm_phase<pg8::EpiF16<1>, pg8::StaticOrder, true, true>(C.lds, g, So, E, Cp.tid);
            SEAM();
        }
        if (EN_DOWN && RUN(pb + 9)) { FRESH();
            pg8::Gemm g{HIDb, (const half_t*)(wsx + WS_WDN) + (size_t)L * D * FF, M, D, FF, FF}; pg8::StaticOrder So; So.init(M, D, C.G, (int)blockIdx.x);
            pg8::EpiF16<0> E{(half_t*)(wsx + WS_Y2), D, nullptr};
            REPEAT(REP_DOWN) pg8::gemm_phase<pg8::EpiF16<0>, pg8::StaticOrder, true, true>(C.lds, g, So, E, Cp.tid);
            SEAM();
        }
        if (EN_ROW && RUN(pb + 10)) { FRESH(); phase_row_update(ap, Cp, L, 1); if (L + 1 < DEPTH) SEAM(); }
    }
#undef RUN
#undef Hb
#undef Yb
#undef Qb
#undef KVb
#undef Ob
#undef Gb
#undef HIDb
#undef ropeb
#undef SEAM
}

extern "C" void kernel_launch(void* const* d_in, const int* in_sizes, int n_in, void* d_out, int out_size, void* d_ws, size_t ws_size, hipStream_t stream) {
    static int grid = 0;
    if (grid == 0) {
        if (n_in != 18 || in_sizes[0] != M * D || out_size != M * D || ws_size < WS_END) {
            fprintf(stderr, "kernel_launch: built for 18 inputs, x/out of %d floats, >= %zu bytes of workspace; got n_in %d, in0 %d, out %d, ws %zu; nothing launched\n", M * D, (size_t)WS_END, n_in, n_in > 0 ? in_sizes[0] : -1, out_size, ws_size);
            grid = -1; return; }
        int dev = 0, cus = 0, per_cu = 0;
        if (hipGetDevice(&dev) != hipSuccess || hipDeviceGetAttribute(&cus, hipDeviceAttributeMultiprocessorCount, dev) != hipSuccess) { fprintf(stderr, "kernel_launch: device query failed\n"); grid = -1; return; }
        if (hipFuncSetAttribute((const void*)mk_fwd, hipFuncAttributeMaxDynamicSharedMemorySize, LDS_BYTES) != hipSuccess) { fprintf(stderr, "kernel_launch: hipFuncSetAttribute failed\n"); grid = -1; return; }
        if (hipOccupancyMaxActiveBlocksPerMultiprocessor(&per_cu, (const void*)mk_fwd, 512, LDS_BYTES) != hipSuccess || per_cu < 1)
            fprintf(stderr, "kernel_launch: note: occupancy query reports %d workgroups per CU\n", per_cu);
        (void)hipGetLastError();
        if (cus < 256) { fprintf(stderr, "kernel_launch: built for a 256-CU device, found %d CUs; nothing launched\n", cus); grid = -1; return; }
        grid = 256;
    }
    if (grid < 0) return;
    if (hipMemsetAsync((char*)d_ws + WS_CTL, 0, CTL_ZERO_BYTES, stream) != hipSuccess) { fprintf(stderr, "kernel_launch: memset failed\n"); return; }
    Args a{};
    for (int i = 0; i < 18; ++i) a.in[i] = (const GAS void*)d_in[i];
    a.out = (GAS float*)d_out; a.ws = (GAS unsigned char*)d_ws;
#if MK_ONE_LAUNCH
    a.ph_lo = 0; a.ph_hi = NPHASE;
    hipLaunchKernelGGL(mk_fwd, dim3(grid), dim3(512), LDS_BYTES, stream, a);
#else
    for (int p = 0; p < NPHASE; ++p) { if (!phase_exists(p)) continue;
        a.ph_lo = p; a.ph_hi = p + 1;
        hipLaunchKernelGGL(mk_fwd, dim3(grid), dim3(512), LDS_BYTES, stream, a); }
#endif
    const hipError_t le = hipPeekAtLastError();
    if (le != hipSuccess) fprintf(stderr, "kernel_launch: launch failed: %s\n", hipGetErrorName(le));
}
```

```cpp
#include <hip/hip_runtime.h>
#include <cstdio>
#include <cstdint>

#ifndef MK_ONE_LAUNCH
#define MK_ONE_LAUNCH 1
#endif

#define LAS __attribute__((address_space(3)))
#define GAS __attribute__((address_space(1)))
typedef _Float16 half_t;
typedef _Float16 h8 __attribute__((ext_vector_type(8)));
typedef _Float16 h4 __attribute__((ext_vector_type(4)));
typedef _Float16 h2 __attribute__((ext_vector_type(2)));
typedef float f32x2 __attribute__((ext_vector_type(2)));
typedef float f32x4 __attribute__((ext_vector_type(4)));
typedef float f32x16 __attribute__((ext_vector_type(16)));
typedef unsigned u32x2 __attribute__((ext_vector_type(2)));
typedef unsigned u32x4 __attribute__((ext_vector_type(4)));
typedef short s16x4 __attribute__((ext_vector_type(4)));

constexpr int D = 1024, NB = 16, S = 2048, M = NB * S, DEPTH = 4, HD = 64, FF = 4096;
constexpr int NSA_IN = 2608, NSA_INP = 2816, SWA_IN = 1280;
constexpr int NCMP = 127;
constexpr float NORM_EPS = 1e-6f;
constexpr float LOG2E = 1.4426950408889634f;
constexpr float C2 = 0.125f * LOG2E;
constexpr float NEG_BIG = -1.0e30f;

constexpr size_t MiB = 1u << 20;
constexpr size_t WS_CTL = 0, CTL_ZERO_BYTES = 1 * MiB;
constexpr size_t WS_MOD  = 1 * MiB;
constexpr size_t WS_B1F  = 3 * MiB;
constexpr size_t WS_W2T  = 3 * MiB + 65536;
constexpr size_t WS_B1P  = 3 * MiB + 262144;
constexpr size_t WS_ROPE = 4 * MiB;
constexpr size_t WS_PART = 12 * MiB;
constexpr size_t WS_WINN = 24 * MiB;
constexpr size_t WS_WINS = 36 * MiB;
constexpr size_t WS_WOUT = 41 * MiB;
constexpr size_t WS_W1T  = 49 * MiB;
constexpr size_t WS_WUP  = 53 * MiB;
constexpr size_t WS_WDN  = 85 * MiB;
constexpr size_t WS_X16  = 117 * MiB;
constexpr size_t WS_Y    = 245 * MiB;
constexpr size_t WS_Y2   = 181 * MiB;
constexpr size_t WS_H    = 181 * MiB;
constexpr size_t WS_BIG  = 245 * MiB;
constexpr size_t WS_Q    = 245 * MiB;
constexpr size_t WS_KV   = 309 * MiB;
constexpr size_t WS_O    = 405 * MiB;
constexpr size_t WS_G    = 469 * MiB;
constexpr size_t WS_HIDC = 475 * MiB;
constexpr size_t WS_KCC  = 483 * MiB;
constexpr size_t WS_SELM = 485 * MiB;
constexpr size_t WS_END  = 501 * MiB;
constexpr size_t KVT = (size_t)M * 256;

constexpr int CW_BAR = 4096;

constexpr int RING_BYTES = 131072;
constexpr int LDSCTL_OFF = RING_BYTES, MISC_OFF = LDSCTL_OFF + 320;
constexpr int LDS_BYTES = 147456;

__device__ __forceinline__ unsigned pkh2(float lo, float hi) { h2 p = {(half_t)lo, (half_t)hi}; return __builtin_bit_cast(unsigned, p); }
__device__ __forceinline__ u32x2 pk4(const f32x4 v) { u32x2 w; w.x = pkh2(v[0], v[1]); w.y = pkh2(v[2], v[3]); return w; }
__device__ __forceinline__ float fast_exp2(float x) { return __builtin_amdgcn_exp2f(x); }
__device__ __forceinline__ float fast_rcp(float x) { return __builtin_amdgcn_rcpf(x); }
__device__ __forceinline__ float shx(float v, int o, int lane) { return __builtin_bit_cast(float, __builtin_amdgcn_ds_bpermute((lane ^ o) << 2, __builtin_bit_cast(int, v))); }
__device__ __forceinline__ int shxi(int v, int o, int lane) { return __builtin_amdgcn_ds_bpermute((lane ^ o) << 2, v); }
__device__ __forceinline__ float shidx(float v, int src) { return __builtin_bit_cast(float, __builtin_amdgcn_ds_bpermute(src << 2, __builtin_bit_cast(int, v))); }
__device__ __forceinline__ float wave_sum(float v, int lane) {
#pragma unroll
    for (int o = 1; o < 64; o <<= 1) v += shx(v, o, lane);
    return v;
}

namespace pg8 {
#define PG8_LAS __attribute__((address_space(3)))
typedef _Float16 bf16_t;
typedef _Float16 bf16x8 __attribute__((ext_vector_type(8)));
typedef float f32x4 __attribute__((ext_vector_type(4)));
typedef unsigned u32x4 __attribute__((ext_vector_type(4)));
constexpr int BM = 256, BK = 64, HALF = 128, HTB = HALF * BK * 2  , STAGE_BYTES = 8 * HTB, NXCD = 8, WGM = 8;

__host__ __device__ __forceinline__ int lds_byte(int r, int c) { const int st = (r >> 4) * 2 + (c >> 5), rr = r & 15, cc = c & 31, ob = rr * 64 + cc * 2; return st * 1024 + (ob ^ (((ob >> 9) & 1) << 5)); }
__host__ __device__ __forceinline__ void stage_rc(int b, int& R, int& C) { const int st = b / 1024, sb = b % 1024, swz = sb ^ (((sb >> 9) & 1) << 5); R = (st >> 1) * 16 + swz / 64; C = (st & 1) * 32 + (swz % 64) / 2; }
__host__ __device__ __forceinline__ int perm32(int rho) { const int n = rho >> 4, i = rho & 15; return 8 * (i >> 2) + 4 * n + (i & 3); }

struct Unit { int pm, pn; };
struct Gemm { const bf16_t* A; const bf16_t* Bt; int M, N, K, lda; };

struct StaticOrder {
    int nM, nN, nwg, G, c;
    __host__ __device__ void init(int M, int N, int G_, int c_) { nM = M / BM; nN = N / BM; nwg = nM * nN; G = G_; c = c_; }
    __host__ __device__ bool next(int i, Unit& u) const {
        const long L = (long)i * G + c; if (L >= nwg) return false;
        int wgid = (int)L; { const int q = nwg / NXCD, r = nwg % NXCD, xcd = wgid % NXCD, off = wgid / NXCD; wgid = (xcd < r ? xcd * (q + 1) : r * (q + 1) + (xcd - r) * q) + off; }
        const int nig = WGM * nN, gid = wgid / nig, fm = gid * WGM, gsz = (nM - fm) < WGM ? (nM - fm) : WGM;
        u.pm = fm + ((wgid % nig) % gsz); u.pn = (wgid % nig) / gsz; return true;
    }
    __device__ __forceinline__ void a_ready(const Unit&) const {}
    __device__ __forceinline__ void done(const Unit&) const {}
};


struct CmpOrder {
    int G, c;
    __device__ bool next(int i, Unit& u) const { const int L = i * G + c; if (L >= 64) return false; u.pm = L; u.pn = L >> 5; return true; }
    __device__ __forceinline__ void a_ready(const Unit&) const {}
    __device__ __forceinline__ void done(const Unit&) const {}
};

__device__ __forceinline__ u32x4 pack8h(const f32x4 v0, const f32x4 v1) { u32x4 w; w.x = pkh2(v0[0], v0[1]); w.y = pkh2(v0[2], v0[3]); w.z = pkh2(v1[0], v1[1]); w.w = pkh2(v1[2], v1[3]); return w; }
__device__ __forceinline__ float gelu_tanh(float v) {
    const float u2 = 1.5957691216057308f * (v + 0.044715f * v * v * v);
    return v * fast_rcp(1.0f + fast_exp2(-u2 * LOG2E));
}
template <int ACT> struct EpiF16 {
    static constexpr bool PERM = true, AFTER_DRAIN = false;
    half_t* O; int ldc; const float* bias;
    __device__ __forceinline__ void operator()(const f32x4 (&acc)[2][2][4][2], const Unit& u, int wr, int wc, int fr, int fq) const {
        asm volatile("" : "+v"(fr), "+v"(fq));
        const int row0 = u.pm * BM + wr * 64 + fr;
        const int col0 = (ACT == 2 ? 0 : u.pn * BM) + wc * 32 + 8 * fq, bcol0 = u.pn * BM + wc * 32 + 8 * fq;
        f32x4 bv[2][2];
#pragma unroll
        for (int bj = 0; bj < 2; ++bj)
#pragma unroll
            for (int n = 0; n < 2; ++n) bv[bj][n] = (ACT == 2) ? *(const f32x4*)(bias + bcol0 + bj * HALF + 4 * n) : (f32x4){0.f, 0.f, 0.f, 0.f};
#pragma unroll
        for (int ai = 0; ai < 2; ++ai)
#pragma unroll
            for (int m = 0; m < 4; ++m) { half_t* rowp = O + (size_t)(row0 + ai * HALF + m * 16) * ldc + col0;
#pragma unroll
                for (int bj = 0; bj < 2; ++bj) { f32x4 v0 = acc[ai][bj][m][0], v1 = acc[ai][bj][m][1];
                    if (ACT == 1) {
#pragma unroll
                        for (int e = 0; e < 4; ++e) { const float a = fmaxf(v0[e], 0.f), b = fmaxf(v1[e], 0.f); v0[e] = a * a; v1[e] = b * b; } }
                    if (ACT == 2) { v0 = v0 + bv[bj][0]; v1 = v1 + bv[bj][1];
#pragma unroll
                        for (int e = 0; e < 4; ++e) { v0[e] = gelu_tanh(v0[e]); v1[e] = gelu_tanh(v1[e]); } }
                    *(u32x4*)(rowp + bj * HALF) = pack8h(v0, v1); } }
    }
};

__device__ __forceinline__ void rope8(const f32x4 v0, const f32x4 v1, const float* ropetok, int i0, float sc, f32x4& o1, f32x4& o2) {
    const f32x4 c = *(const f32x4*)(ropetok + i0), s = *(const f32x4*)(ropetok + 32 + i0);
    const f32x4 x1 = {v0[0], v0[2], v1[0], v1[2]}, x2 = {v0[1], v0[3], v1[1], v1[3]};
    o1 = (x1 * c - x2 * s) * sc; o2 = (x2 * c + x1 * s) * sc;
}
__device__ __forceinline__ u32x2 pack4h(const f32x4 v) { u32x2 w; w.x = pkh2(v[0], v[1]); w.y = pkh2(v[2], v[3]); return w; }

struct EpiNsaIn {
    static constexpr bool PERM = true, AFTER_DRAIN = false;
    half_t* Q; half_t* KV; float* G; const float* rope;
    __device__ __forceinline__ void operator()(const f32x4 (&acc)[2][2][4][2], const Unit& u, int wr, int wc, int fr, int fq) const {
        asm volatile("" : "+v"(fr), "+v"(fq));
        const int pn = u.pn;
#pragma unroll
        for (int ai = 0; ai < 2; ++ai)
#pragma unroll
            for (int m = 0; m < 4; ++m) {
                const int tok = u.pm * BM + ai * HALF + wr * 64 + m * 16 + fr, b = tok >> 11, s = tok & 2047;
                const float* rt = rope + (size_t)tok * 64;
#pragma unroll
                for (int bj = 0; bj < 2; ++bj) {
                    const int cit = bj * HALF + wc * 32 + 8 * fq, hh = cit >> 6, jj0 = cit & 63;
                    const f32x4 v0 = acc[ai][bj][m][0], v1 = acc[ai][bj][m][1];
                    if (pn < 4) { f32x4 o1, o2; rope8(v0, v1, rt, jj0 >> 1, C2, o1, o2);
                        half_t* p = Q + (size_t)tok * D + pn * 256 + hh * 64 + (jj0 >> 1);
                        *(u32x2*)p = pack4h(o1); *(u32x2*)(p + 32) = pack4h(o2);
                    } else if (pn == 10) {
                        if (cit < 48) { f32x4 g0, g1;
#pragma unroll
                            for (int e = 0; e < 4; ++e) { g0[e] = fast_rcp(1.0f + fast_exp2(-v0[e] * LOG2E)); g1[e] = fast_rcp(1.0f + fast_exp2(-v1[e] * LOG2E)); }
                            float* p = G + (size_t)tok * 48 + cit; *(f32x4*)p = g0; *(f32x4*)(p + 4) = g1; }
                    } else {
                        const int t = pn - 4;
                        half_t* base = KV + (size_t)t * KVT + ((size_t)(b * 4 + hh) * S + s) * 64;
                        if ((t & 1) == 0) { f32x4 o1, o2; rope8(v0, v1, rt, jj0 >> 1, 1.0f, o1, o2);
                            *(u32x2*)(base + (jj0 >> 1)) = pack4h(o1); *(u32x2*)(base + 32 + (jj0 >> 1)) = pack4h(o2);
                        } else *(u32x4*)(base + jj0) = pack8h(v0, v1);
                    }
                }
                asm volatile("" ::: "memory");
            }
    }
};
struct EpiSwaIn {
    static constexpr bool PERM = true, AFTER_DRAIN = false;
    half_t* Q; half_t* KV; const float* rope;
    __device__ __forceinline__ void operator()(const f32x4 (&acc)[2][2][4][2], const Unit& u, int wr, int wc, int fr, int fq) const {
        asm volatile("" : "+v"(fr), "+v"(fq));
        const int pn = u.pn;
#pragma unroll
        for (int ai = 0; ai < 2; ++ai)
#pragma unroll
            for (int m = 0; m < 4; ++m) {
                const int tok = u.pm * BM + ai * HALF + wr * 64 + m * 16 + fr, b = tok >> 11, s = tok & 2047;
                const float* rt = rope + (size_t)tok * 64;
#pragma unroll
                for (int bj = 0; bj < 2; ++bj) {
                    const int cit = bj * HALF + wc * 32 + 8 * fq, hh = cit >> 6, jj0 = cit & 63;
                    const f32x4 v0 = acc[ai][bj][m][0], v1 = acc[ai][bj][m][1];
                    if (pn < 4) { f32x4 o1, o2; rope8(v0, v1, rt, jj0 >> 1, C2, o1, o2);
                        half_t* p = Q + (size_t)tok * D + pn * 256 + hh * 64 + (jj0 >> 1);
                        *(u32x2*)p = pack4h(o1); *(u32x2*)(p + 32) = pack4h(o2);
                    } else if (bj == 0) {
                        half_t* base = KV + ((size_t)(b * 2 + hh) * S + s) * 64;
                        f32x4 o1, o2; rope8(v0, v1, rt, jj0 >> 1, 1.0f, o1, o2);
                        *(u32x2*)(base + (jj0 >> 1)) = pack4h(o1); *(u32x2*)(base + 32 + (jj0 >> 1)) = pack4h(o2);
                    } else {
                        half_t* base = KV + (size_t)M * 128 + ((size_t)(b * 2 + (hh - 2)) * S + s) * 64;
                        *(u32x4*)(base + jj0) = pack8h(v0, v1);
                    }
                }
                asm volatile("" ::: "memory");
            }
    }
};
template <class Epi, class Sched, bool ALIGN_EPI = false, bool SP2 = false>
__device__ __forceinline__ void gemm_phase(PG8_LAS unsigned char* lds, const Gemm g, const Sched& S, const Epi& E, int tid_in) {
    int tid_ = tid_in; asm volatile("" : "+v"(tid_));
    const int tid = tid_, wid = __builtin_amdgcn_readfirstlane(tid >> 6), lane = tid & 63, wr = wid >> 2, wc = wid & 3, fr = lane & 15, fq = lane >> 4;
    const int K = g.K, nt = K / BK;
    unsigned voffA[2], voffB[2];
#pragma unroll
    for (int i = 0; i < 2; ++i) { int R, C; stage_rc(tid * 16 + i * 8192, R, C); const int Rb = Epi::PERM ? ((R & ~31) + perm32(R & 31)) : R;
        voffA[i] = (unsigned)(R * g.lda + C) * 2u; voffB[i] = (unsigned)(Rb * K + C) * 2u; }
    const size_t kstep = (size_t)(BK * 2);
    const size_t hstep = (size_t)HALF * K * 2;
    const size_t tstep = 2 * hstep;
    const size_t hstepA = (size_t)HALF * g.lda * 2, tstepA = 2 * hstepA;
    const unsigned ldsw = (unsigned)wid * 1024u;
    const int aoff = lds_byte(wr * 64 + fr, fq * 8), boff = lds_byte(wc * 32 + fr, fq * 8);
#define PG8_SA(b, h) (((b) * 2 + (h)) * HTB)
#define PG8_SB(b, h) ((4 + (b) * 2 + (h)) * HTB)
#define PG8_STAGE(bufoff, gbase, voff) do { _Pragma("unroll") for (int _i = 0; _i < 2; ++_i) \
        __builtin_amdgcn_global_load_lds((const unsigned*)((const char*)(gbase) + (voff)[_i]), (PG8_LAS unsigned*)(lds + (bufoff) + ldsw + _i * 8192), 16, 0, 0); } while (0)
#define PG8_LDA(dst, b, h) do { _Pragma("unroll") for (int m = 0; m < 4; ++m) _Pragma("unroll") for (int k = 0; k < 2; ++k) dst[m][k] = *(const PG8_LAS bf16x8*)(lds + PG8_SA(b, h) + aoff + m * 2048 + k * 1024); } while (0)
#define PG8_LDB(dst, b, h) do { _Pragma("unroll") for (int n = 0; n < 2; ++n) _Pragma("unroll") for (int k = 0; k < 2; ++k) dst[n][k] = *(const PG8_LAS bf16x8*)(lds + PG8_SB(b, h) + boff + n * 2048 + k * 1024); } while (0)
#define PG8_MMA(ai, bj, At, Bt) do { __builtin_amdgcn_s_setprio(1); _Pragma("unroll") for (int m = 0; m < 4; ++m) _Pragma("unroll") for (int n = 0; n < 2; ++n) _Pragma("unroll") for (int k = 0; k < 2; ++k) \
        acc[ai][bj][m][n] = __builtin_amdgcn_mfma_f32_16x16x32_f16(Bt[n][k], At[m][k], acc[ai][bj][m][n], 0, 0, 0); __builtin_amdgcn_s_setprio(0); } while (0)
#define PG8_WAIT_V(n) asm volatile("s_waitcnt vmcnt(" #n ")" ::: "memory")
#define PG8_WAIT_L(n) asm volatile("s_waitcnt lgkmcnt(" #n ")" ::: "memory")
#define PG8_BAR __builtin_amdgcn_s_barrier()
#define PG8_SCHED __builtin_amdgcn_sched_barrier(0)
    Unit cur, nxt; int ui = 0;
    if (!S.next(0, cur)) return;
    f32x4 acc[2][2][4][2];
#pragma unroll
    for (int a = 0; a < 2; ++a)
#pragma unroll
        for (int b = 0; b < 2; ++b)
#pragma unroll
            for (int m = 0; m < 4; ++m)
#pragma unroll
                for (int n = 0; n < 2; ++n) acc[a][b][m][n] = (f32x4){0.f, 0.f, 0.f, 0.f};
    bf16x8 At[4][2], B0[2][2], B1[2][2];
    const char* cA = (const char*)g.A + (size_t)cur.pm * tstepA; const char* cB = (const char*)g.Bt + (size_t)cur.pn * tstep;
    S.a_ready(cur);
    static_assert(SP2, "only the SP2 loop is kept in this file");
    {
        PG8_STAGE(PG8_SB(0, 0), cB, voffB); PG8_STAGE(PG8_SB(0, 1), cB + hstep, voffB); PG8_STAGE(PG8_SA(0, 0), cA, voffA); PG8_STAGE(PG8_SA(0, 1), cA + hstepA, voffA);
        if (wr == 1) PG8_BAR;
        PG8_WAIT_V(2); PG8_BAR;
        PG8_STAGE(PG8_SB(1, 0), cB + kstep, voffB); PG8_STAGE(PG8_SA(1, 0), cA + kstep, voffA); PG8_STAGE(PG8_SB(1, 1), cB + hstep + kstep, voffB);
        PG8_WAIT_V(6); PG8_BAR;
    }
    for (;;) {
        const bool has_next = S.next(ui + 1, nxt);
        const char* nA = has_next ? (const char*)g.A + (size_t)nxt.pm * tstepA : cA; const char* nB = has_next ? (const char*)g.Bt + (size_t)nxt.pn * tstep : cB;
        for (int t = 0; t < nt; t += 2) {
            const bool last = (t == nt - 2);
            const char* a1 = cA + (size_t)(t + 1) * kstep;
            const char* a2 = last ? nA : cA + (size_t)(t + 2) * kstep; const char* b2 = last ? nB : cB + (size_t)(t + 2) * kstep;
            const char* a3 = a2 + kstep; const char* b3 = b2 + kstep;
            if (last && has_next) S.a_ready(nxt);
            {
            PG8_LDB(B0, 0, 0); PG8_LDB(B1, 0, 1); PG8_SCHED; PG8_LDA(At, 0, 0); PG8_STAGE(PG8_SA(1, 1), a1 + hstepA, voffA);
            PG8_WAIT_V(8); PG8_WAIT_L(0); PG8_BAR; PG8_MMA(0, 0, At, B0); PG8_MMA(0, 1, At, B1); PG8_BAR; PG8_SCHED;
            PG8_LDA(At, 0, 1); PG8_STAGE(PG8_SB(0, 0), b2, voffB); PG8_STAGE(PG8_SB(0, 1), b2 + hstep, voffB); PG8_STAGE(PG8_SA(0, 0), a2, voffA);
            PG8_WAIT_V(8); PG8_WAIT_L(0); PG8_BAR; PG8_MMA(1, 0, At, B0); PG8_MMA(1, 1, At, B1); PG8_BAR; PG8_SCHED;
            PG8_LDB(B0, 1, 0); PG8_LDB(B1, 1, 1); PG8_SCHED; PG8_LDA(At, 1, 0); PG8_STAGE(PG8_SA(0, 1), a2 + hstepA, voffA);
            PG8_WAIT_V(8); PG8_WAIT_L(0); PG8_BAR; PG8_MMA(0, 0, At, B0); PG8_MMA(0, 1, At, B1); PG8_BAR; PG8_SCHED;
            PG8_LDA(At, 1, 1); PG8_STAGE(PG8_SB(1, 0), b3, voffB); PG8_STAGE(PG8_SB(1, 1), b3 + hstep, voffB); PG8_STAGE(PG8_SA(1, 0), a3, voffA);
            PG8_WAIT_V(8); PG8_WAIT_L(0); PG8_BAR; PG8_MMA(1, 0, At, B0); PG8_MMA(1, 1, At, B1); PG8_BAR; PG8_SCHED;
            }
        }
        if constexpr (ALIGN_EPI) { if (wr == 0) PG8_BAR; }
        if constexpr (!Epi::AFTER_DRAIN) { E(acc, cur, wr, wc, fr, fq); S.done(cur); }
        if (!has_next) break;
#pragma unroll
        for (int a = 0; a < 2; ++a)
#pragma unroll
            for (int b = 0; b < 2; ++b)
#pragma unroll
                for (int m = 0; m < 4; ++m)
#pragma unroll
                    for (int n = 0; n < 2; ++n) acc[a][b][m][n] = (f32x4){0.f, 0.f, 0.f, 0.f};
        cur = nxt; cA = nA; cB = nB; ++ui;
        if constexpr (ALIGN_EPI) { if (wr == 1) PG8_BAR; }
    }
    PG8_WAIT_V(0);
    if constexpr (!ALIGN_EPI) { if (wr == 0) PG8_BAR; }
    PG8_BAR;
    if constexpr (Epi::AFTER_DRAIN) { E.fused(acc, cur, wr, wc, fr, fq, lds, wid, lane); S.done(cur); }
#undef PG8_SA
#undef PG8_SB
#undef PG8_STAGE
#undef PG8_LDA
#undef PG8_LDB
#undef PG8_MMA
#undef PG8_WAIT_V
#undef PG8_WAIT_L
#undef PG8_BAR
#undef PG8_SCHED
}
}

#define XB_TMO      128
#define XB_XCNT(j)  (256  + 64 * (j))
#define XB_XSUB(j)  (1280 + 64 * (j))
#define XB_XGEN(j)  (2304 + 64 * (j))
#define XB_TOP      3328
#define XB_TOPGEN   3392
#define XCD_BAR_WORDS 3456
#define XB_SPIN_CAP (1u << 18)

__device__ __forceinline__ unsigned xb_ld(unsigned* p)              { return __hip_atomic_load(p, __ATOMIC_RELAXED, __HIP_MEMORY_SCOPE_AGENT); }
__device__ __forceinline__ unsigned xb_add(unsigned* p, unsigned v) { return __hip_atomic_fetch_add(p, v, __ATOMIC_RELAXED, __HIP_MEMORY_SCOPE_AGENT); }
__device__ __forceinline__ unsigned xb_xcc_id() { return (unsigned)__builtin_amdgcn_s_getreg((3 << 11) | 20) & 0xFu; }
#define XB_SPIN(cond, bar) do { unsigned _sp = 0; while (cond) { __builtin_amdgcn_s_sleep(1); \
    if ((++_sp & 255u) == 0u) { if (xb_ld(&(bar)[XB_TMO])) break; if (_sp > XB_SPIN_CAP) { atomicAdd(&(bar)[XB_TMO], 1u); break; } } } } while (0)

struct XcdBarrier {
    unsigned* bar; unsigned x;
    volatile LAS unsigned* st;
};

__device__ __forceinline__ XcdBarrier xcd_barrier_post(unsigned* bar, volatile LAS unsigned* st) {
    XcdBarrier b; b.bar = bar; b.x = xb_xcc_id(); b.st = st;
    if (threadIdx.x == 0) (void)xb_add(&bar[XB_XCNT(b.x)], 1u);
    return b;
}
__device__ __forceinline__ void xcd_barrier_complete(unsigned* bar, unsigned x, unsigned& nloc, unsigned& nx) {
    const unsigned G = gridDim.x * gridDim.y * gridDim.z;
    asm volatile("" : "+s"(x));
    unsigned sum, cnt, mine, sp = 0u;
    for (;;) {
        sum = 0u; cnt = 0u; mine = 0u;
#pragma unroll
        for (unsigned j = 0; j < 16; ++j) { const unsigned c = xb_ld(&bar[XB_XCNT(j)]); sum += c; cnt += (c > 0u) ? 1u : 0u; mine = (j == x) ? c : mine; }
        if (sum == G) break;
        __builtin_amdgcn_s_sleep(1);
        if ((++sp & 255u) == 0u) { if (xb_ld(&bar[XB_TMO])) break; if (sp > XB_SPIN_CAP) { atomicAdd(&bar[XB_TMO], 1u); break; } }
    }
    nloc = mine > 0u ? mine : 1u; nx = cnt > 0u ? cnt : 1u;
}

__device__ __forceinline__ void xcd_barrier(const XcdBarrier& b) {
    asm volatile("s_waitcnt vmcnt(0)" ::: "memory");
    __syncthreads();
    if (threadIdx.x == 0) {
        unsigned* bar = b.bar;
        __builtin_amdgcn_s_waitcnt(0);
        unsigned nloc = b.st[0], nx = b.st[1];
        if (nloc == 0u) { xcd_barrier_complete(bar, b.x, nloc, nx); b.st[0] = nloc; b.st[1] = nx; }
        const unsigned old = xb_add(&bar[XB_XSUB(b.x)], 1u);
        const unsigned gen = old / nloc;
        if (old + 1u == (gen + 1u) * nloc) {
            __builtin_amdgcn_fence(__ATOMIC_RELEASE, "agent");
            asm volatile("s_waitcnt vmcnt(0)" ::: "memory");
            const unsigned og = xb_add(&bar[XB_TOP], 1u);
            const unsigned tg = og / nx;
            if (og + 1u == (tg + 1u) * nx) xb_add(&bar[XB_TOPGEN], 1u);
            else XB_SPIN(xb_ld(&bar[XB_TOPGEN]) == tg, bar);
            __builtin_amdgcn_fence(__ATOMIC_ACQUIRE, "agent");
            xb_add(&bar[XB_XGEN(b.x)], 1u);
            asm volatile("s_waitcnt vmcnt(0)" ::: "memory");
        } else {
            XB_SPIN(xb_ld(&bar[XB_XGEN(b.x)]) == gen, bar);
            __builtin_amdgcn_fence(__ATOMIC_ACQUIRE, "agent");
            asm volatile("s_waitcnt vmcnt(0)" ::: "memory");
        }
    }
    __syncthreads();
}

#ifndef REP_PRO_A
#define REP_PRO_A 1
#endif
#ifndef REP_PRO_D
#define REP_PRO_D 1
#endif
#ifndef REP_PRO_C
#define REP_PRO_C 1
#endif
#define REPEAT(n) _Pragma("unroll 1") for (int rep_ = 0; rep_ < (n); ++rep_)
struct Args { const GAS void* in[18]; GAS float* out; GAS unsigned char* ws; int ph_lo, ph_hi; };
typedef const __attribute__((address_space(4))) Args* ArgsP;
struct Ctx {
    LAS unsigned char* lds;
    int tid, lane, wave, G, gw, ngw;
    unsigned char* ws;
};
#define LDS_WAIT() asm volatile("s_waitcnt lgkmcnt(0)" ::: "memory")

__device__ const float INVF[32] = {1.000000000e+00f, 7.498942018e-01f, 5.623413324e-01f, 4.216965139e-01f, 3.162277639e-01f, 2.371373922e-01f, 1.778279394e-01f, 1.333521456e-01f,
    1.000000015e-01f, 7.498941571e-02f, 5.623412877e-02f, 4.216964915e-02f, 3.162277862e-02f, 2.371373586e-02f, 1.778279431e-02f, 1.333521493e-02f,
    9.999999776e-03f, 7.498942316e-03f, 5.623413250e-03f, 4.216964822e-03f, 3.162277862e-03f, 2.371373819e-03f, 1.778279431e-03f, 1.333521446e-03f,
    1.000000047e-03f, 7.498941850e-04f, 5.623413017e-04f, 4.216965463e-04f, 3.162277862e-04f, 2.371373848e-04f, 1.778279402e-04f, 1.333521504e-04f};

__device__ __forceinline__ void sincos_d(double x, double& sn, double& cs) {
    const double k = __builtin_rint(x * 0.63661977236758134308);
    double r = __builtin_fma(-k, 1.57079632679489655800e+00, x); r = __builtin_fma(-k, 6.12323399573676603587e-17, r);
    const double z = r * r;
    double sp = 1.0 / 6227020800.0; sp = sp * z - 1.0 / 39916800.0; sp = sp * z + 1.0 / 362880.0; sp = sp * z - 1.0 / 5040.0; sp = sp * z + 1.0 / 120.0; sp = sp * z - 1.0 / 6.0; sp = sp * z + 1.0;
    const double s0 = sp * r;
    double cp = -1.0 / 87178291200.0; cp = cp * z + 1.0 / 479001600.0; cp = cp * z - 1.0 / 3628800.0; cp = cp * z + 1.0 / 40320.0; cp = cp * z - 1.0 / 720.0; cp = cp * z + 1.0 / 24.0; cp = cp * z - 0.5; cp = cp * z + 1.0;
    const int q = ((int)k) & 3;
    sn = (q == 0) ? s0 : (q == 1) ? cp : (q == 2) ? -s0 : -cp;
    cs = (q == 0) ? cp : (q == 1) ? -s0 : (q == 2) ? -cp : s0;
}

__device__ __forceinline__ int w_rowmap(int mode, int n) {
    if (mode == 0) return n;
    bool rope;
    if (mode == 1) { const int t = n >> 8; rope = (t < 4) || t == 4 || t == 6 || t == 8; }
    else rope = n < 1152;
    if (!rope) return n;
    const int d = n & 63; return (n & ~63) + 2 * (d & 31) + (d >> 5);
}
__device__ __forceinline__ void convert_item(const float* W, int K, int N, half_t* WT, int mode, LAS float* scr, int item, int lane) {
    const int nblk = (N + 31) / 32, kb = item / nblk, nb = item % nblk, k0 = 64 * kb, n0 = 32 * nb;
    const int nn = n0 + (lane & 31);
    float t[32];
#pragma unroll
    for (int i = 0; i < 32; ++i) { const int kk = 2 * i + (lane >> 5); t[i] = (nn < N) ? W[(size_t)(k0 + kk) * N + nn] : 0.f; }
#pragma unroll
    for (int i = 0; i < 32; ++i) { const int kk = 2 * i + (lane >> 5); scr[kk * 33 + (lane & 31)] = t[i]; }
    LDS_WAIT(); asm volatile("" ::: "memory");
    const int c = lane & 7;
#pragma unroll
    for (int j = 0; j < 4; ++j) { const int nl = (lane >> 3) + 8 * j, n = n0 + nl; const LAS float* s = scr + (8 * c) * 33 + nl;
        u32x4 o; o.x = pkh2(s[0 * 33], s[1 * 33]); o.y = pkh2(s[2 * 33], s[3 * 33]); o.z = pkh2(s[4 * 33], s[5 * 33]); o.w = pkh2(s[6 * 33], s[7 * 33]);
        if (n < N) *(u32x4*)(WT + (size_t)w_rowmap(mode, n) * K + k0 + 8 * c) = o; }
    LDS_WAIT(); asm volatile("" ::: "memory");
}
struct WDesc { const float* src; half_t* dst; int K, N, mode; };
__device__ __forceinline__ WDesc wdesc(ArgsP a, int mid) {
    WDesc d; unsigned char* ws = (unsigned char*)a->ws;
    if (mid < 2)       { d.src = (const float*)a->in[6] + (size_t)mid * D * NSA_IN;            d.dst = (half_t*)(ws + WS_WINN) + (size_t)mid * NSA_INP * D;         d.K = D;    d.N = NSA_IN; d.mode = 1; }
    else if (mid < 4)  { d.src = (const float*)a->in[13] + (size_t)(mid - 2) * D * SWA_IN;     d.dst = (half_t*)(ws + WS_WINS) + (size_t)(mid - 2) * SWA_IN * D;    d.K = D;    d.N = SWA_IN; d.mode = 2; }
    else if (mid < 6)  { d.src = (const float*)a->in[7] + (size_t)(mid - 4) * D * D;           d.dst = (half_t*)(ws + WS_WOUT) + (size_t)(2 * (mid - 4)) * D * D;   d.K = D;    d.N = D;      d.mode = 0; }
    else if (mid < 8)  { d.src = (const float*)a->in[14] + (size_t)(mid - 6) * D * D;          d.dst = (half_t*)(ws + WS_WOUT) + (size_t)(2 * (mid - 6) + 1) * D * D; d.K = D;  d.N = D;      d.mode = 0; }
    else if (mid < 12) { d.src = (const float*)a->in[9] + (size_t)(mid - 8) * 2048 * 256;      d.dst = (half_t*)(ws + WS_W1T) + (size_t)(mid - 8) * 256 * 2048;     d.K = 2048; d.N = 256;    d.mode = 0; }
    else if (mid < 16) { d.src = (const float*)a->in[11] + (size_t)(mid - 12) * 256 * 64;      d.dst = (half_t*)(ws + WS_W2T) + (size_t)(mid - 12) * 64 * 256;      d.K = 256;  d.N = 64;     d.mode = 0; }
    else if (mid < 20) { d.src = (const float*)a->in[16] + (size_t)(mid - 16) * D * FF;        d.dst = (half_t*)(ws + WS_WUP) + (size_t)(mid - 16) * FF * D;        d.K = D;    d.N = FF;     d.mode = 0; }
    else               { d.src = (const float*)a->in[17] + (size_t)(mid - 20) * FF * D;        d.dst = (half_t*)(ws + WS_WDN) + (size_t)(mid - 20) * D * FF;        d.K = FF;   d.N = D;      d.mode = 0; }
    return d;
}

__device__ __forceinline__ void phase_prologue(ArgsP a, const Ctx& C) {
    unsigned char* ws = C.ws;
    {
        LAS float* scr = (LAS float*)(C.lds + C.wave * 16384);
        REPEAT(REP_PRO_A) for (int mid = 0; mid < 24; ++mid) { const WDesc d = wdesc(a, mid); const int nit = (d.K / 64) * ((d.N + 31) / 32);
            for (int it = C.gw; it < nit; it += C.ngw) convert_item(d.src, d.K, d.N, d.dst, d.mode, scr, it, C.lane); }
    }
    {
        const int gt = C.gw * 64 + C.lane, ngt = C.ngw * 64;
        for (int i = gt; i < 2 * 208 * 128; i += ngt) { const int mat = i / (208 * 128), r = i % (208 * 128);
            *(u32x4*)((half_t*)(ws + WS_WINN) + (size_t)mat * NSA_INP * D + (size_t)NSA_IN * D + (size_t)r * 8) = (u32x4){0u, 0u, 0u, 0u}; }
        const int* pos = (const int*)a->in[2]; float* rope = (float*)(ws + WS_ROPE);
        REPEAT(REP_PRO_C) for (int i = gt; i < M * 32; i += ngt) { const int tok = i >> 5, fi = i & 31;
            const float ang = (float)pos[tok] * INVF[fi]; double sn, cs; sincos_d((double)ang, sn, cs);
            rope[(size_t)tok * 64 + fi] = (float)cs; rope[(size_t)tok * 64 + 32 + fi] = (float)sn; }
    }
    {
        float* b1p = (float*)(ws + WS_B1P);
        for (int task = C.gw; task < 4 * 4 * 32; task += C.ngw) { const int ks = task & 31, cg = (task >> 5) & 3, lw = task >> 7, j = cg * 64 + C.lane;
            const float* w1 = (const float*)a->in[9] + ((size_t)lw * 2048 + ks * 64) * 256 + j; const float* pe = (const float*)a->in[8] + (size_t)lw * 2048 + ks * 64;
            float s = 0.f;
#pragma unroll 16
            for (int k = 0; k < 64; ++k) s += pe[k] * w1[(size_t)k * 256];
            b1p[ks * 1024 + lw * 256 + j] = s; }
    }
    __syncthreads();
    {
        LAS float* cl = (LAS float*)C.lds; const float* cin = (const float*)a->in[1];
        for (int i = C.tid; i < 16 * 1024; i += 512) { const int b = i >> 10, k = i & 1023; const float v = cin[i]; cl[k * 16 + b] = v / (1.0f + __expf(-v)); }
        __syncthreads();
        const float* aw = (const float*)a->in[3]; float* part = (float*)(ws + WS_PART);
        REPEAT(REP_PRO_D) for (int task = C.gw; task < 4 * 8 * 96; task += C.ngw) {
            const int ng = task % 96, lk = task / 96, ks = lk & 7, L = lk >> 3, col = ng * 64 + C.lane;
            const float* wp = aw + ((size_t)L * 1024 + ks * 128) * 6144 + col;
            float acc[16];
#pragma unroll
            for (int b = 0; b < 16; ++b) acc[b] = 0.f;
#pragma unroll 8
            for (int kk = 0; kk < 128; ++kk) { const float w = wp[(size_t)kk * 6144]; const LAS f32x4* cv = (const LAS f32x4*)(cl + (ks * 128 + kk) * 16);
#pragma unroll
                for (int q = 0; q < 4; ++q) { const f32x4 c4 = cv[q]; acc[4 * q] += c4[0] * w; acc[4 * q + 1] += c4[1] * w; acc[4 * q + 2] += c4[2] * w; acc[4 * q + 3] += c4[3] * w; } }
#pragma unroll
            for (int b = 0; b < 16; ++b) part[((size_t)(ks * 4 + L) * 16 + b) * 6144 + col] = acc[b];
        }
    }
}
__device__ __forceinline__ void phase_modfinal(ArgsP a, const Ctx& C) {
    const float* part = (const float*)(C.ws + WS_PART); const float* ab = (const float*)a->in[4]; float* mod = (float*)(C.ws + WS_MOD);
    for (int i = C.gw * 64 + C.lane; i < 4 * 16 * 6144; i += C.ngw * 64) { const int L = i / 98304, rem = i % 98304, n = rem % 6144;
        float s = ab[L * 6144 + n];
#pragma unroll
        for (int ks = 0; ks < 8; ++ks) s += part[(size_t)(ks * 4 + L) * 98304 + rem];
        mod[i] = s; }
    const float* b1p = (const float*)(C.ws + WS_B1P); const float* b1 = (const float*)a->in[10]; float* b1f = (float*)(C.ws + WS_B1F);
    for (int i = C.gw * 64 + C.lane; i < 1024; i += C.ngw * 64) { float s = b1[i];
#pragma unroll 8
        for (int ks = 0; ks < 32; ++ks) s += b1p[ks * 1024 + i];
        b1f[i] = s; }
}

__device__ __forceinline__ void row_norm_mod(const f32x4 (&v)[4], float rstd, const float* gain, const float* sh, const float* sc, half_t* hrow, int lane) {
#pragma unroll
    for (int j = 0; j < 4; ++j) { const int c = 4 * lane + 256 * j;
        const f32x4 g = *(const f32x4*)(gain + c), s1 = *(const f32x4*)(sc + c), s0 = *(const f32x4*)(sh + c);
        const f32x4 h = (v[j] * rstd * g) * (s1 + 1.0f) + s0;
        *(u32x2*)(hrow + c) = pk4(h); }
}

constexpr int ROW_RB = 4;
__device__ __forceinline__ float sumsq4(const f32x4 (&v)[4]) { float s = 0.f;
#pragma unroll
    for (int j = 0; j < 4; ++j) s += (v[j][0] * v[j][0] + v[j][1] * v[j][1]) + (v[j][2] * v[j][2] + v[j][3] * v[j][3]);
    return s; }
__device__ __forceinline__ f32x4 h4f(const h4 h) { return (f32x4){(float)h[0], (float)h[1], (float)h[2], (float)h[3]}; }
__device__ __forceinline__ void phase_row_first(ArgsP a, const Ctx& C) {
    const float* x = (const float*)a->in[0]; const float* ng = (const float*)a->in[5]; const float* mod = (const float*)(C.ws + WS_MOD); half_t* H = (half_t*)(C.ws + WS_H);
    const int rpw = M / C.ngw, row0 = C.gw * rpw, b = row0 >> 11;
    const float* mb = mod + (size_t)b * 6144;
    f32x4 vg[4], vsh[4], vsc[4];
#pragma unroll
    for (int j = 0; j < 4; ++j) { const int c = 4 * C.lane + 256 * j; vg[j] = *(const f32x4*)(ng + c); vsh[j] = *(const f32x4*)(mb + c); vsc[j] = *(const f32x4*)(mb + 1024 + c) + 1.0f; }
    for (int r0 = 0; r0 < rpw; r0 += ROW_RB) {
        f32x4 v[ROW_RB][4];
#pragma unroll
        for (int q = 0; q < ROW_RB; ++q)
#pragma unroll
            for (int j = 0; j < 4; ++j) v[q][j] = *(const f32x4*)(x + (size_t)(row0 + r0 + q) * D + 4 * C.lane + 256 * j);
#pragma unroll
        for (int q = 0; q < ROW_RB; ++q) {
            const float rstd = 1.0f / sqrtf(wave_sum(sumsq4(v[q]), C.lane) * (1.0f / D) + NORM_EPS);
#pragma unroll
            for (int j = 0; j < 4; ++j) *(u32x2*)(H + (size_t)(row0 + r0 + q) * D + 4 * C.lane + 256 * j) = pk4((v[q][j] * rstd * vg[j]) * vsc[j] + vsh[j]);
        }
    }
}
__device__ __forceinline__ void phase_row_update(ArgsP a, const Ctx& C, int L, int which) {
    const float* ng = (const float*)a->in[5]; const float* mod = (const float*)(C.ws + WS_MOD);
    const half_t* Y = (const half_t*)(C.ws + (which ? WS_Y2 : WS_Y)); half_t* H = (half_t*)(C.ws + WS_H); half_t* X16 = (half_t*)(C.ws + WS_X16);
    const bool first = (L == 0 && which == 0), last = (which == 1 && L == DEPTH - 1);
    const float* xin32 = (const float*)a->in[0]; float* xout32 = (float*)a->out;
    const int Lh = which ? L + 1 : L;
    const int rpw = M / C.ngw, row0 = C.gw * rpw, b = row0 >> 11;
    const float* gy = ng + (size_t)(L * 4 + (which ? 3 : 1)) * D;
    const float* gh = ng + (size_t)((last ? L : Lh) * 4 + (which ? 0 : 2)) * D;
    const float* mg = mod + ((size_t)L * 16 + b) * 6144 + (which ? 5 : 2) * 1024;
    const float* mh = mod + ((size_t)(last ? L : Lh) * 16 + b) * 6144 + (which ? 0 : 3) * 1024;
    f32x4 wy[4], vg[4], vsh[4], vsc[4];
#pragma unroll
    for (int j = 0; j < 4; ++j) { const int c = 4 * C.lane + 256 * j; wy[j] = (*(const f32x4*)(mg + c) + 1.0f) * *(const f32x4*)(gy + c);
        vg[j] = *(const f32x4*)(gh + c); vsh[j] = *(const f32x4*)(mh + c); vsc[j] = *(const f32x4*)(mh + 1024 + c) + 1.0f; }
    for (int r0 = 0; r0 < rpw; r0 += ROW_RB) {
        h4 yh[ROW_RB][4]; f32x4 xv[ROW_RB][4];
#pragma unroll
        for (int q = 0; q < ROW_RB; ++q)
#pragma unroll
            for (int j = 0; j < 4; ++j) { const size_t o = (size_t)(row0 + r0 + q) * D + 4 * C.lane + 256 * j; yh[q][j] = *(const h4*)(Y + o);
                if (first) xv[q][j] = *(const f32x4*)(xin32 + o); else xv[q][j] = h4f(*(const h4*)(X16 + o)); }
#pragma unroll
        for (int q = 0; q < ROW_RB; ++q) {
            f32x4 y[4];
#pragma unroll
            for (int j = 0; j < 4; ++j) y[j] = h4f(yh[q][j]);
            const float r1 = 1.0f / sqrtf(wave_sum(sumsq4(y), C.lane) * (1.0f / D) + NORM_EPS);
#pragma unroll
            for (int j = 0; j < 4; ++j) { const size_t o = (size_t)(row0 + r0 + q) * D + 4 * C.lane + 256 * j;
                xv[q][j] = xv[q][j] + wy[j] * (y[j] * r1);
                if (last) *(f32x4*)(xout32 + o) = xv[q][j]; else *(u32x2*)(X16 + o) = pk4(xv[q][j]); }
            if (!last) { const float r2 = 1.0f / sqrtf(wave_sum(sumsq4(xv[q]), C.lane) * (1.0f / D) + NORM_EPS);
#pragma unroll
                for (int j = 0; j < 4; ++j) *(u32x2*)(H + (size_t)(row0 + r0 + q) * D + 4 * C.lane + 256 * j) = pk4((xv[q][j] * r2 * vg[j]) * vsc[j] + vsh[j]); }
        }
    }
}

__device__ __forceinline__ void phase_cmp2(ArgsP a, const Ctx& C, int la) {
    const half_t* HC = (const half_t*)(C.ws + WS_HIDC); half_t* KCC = (half_t*)(C.ws + WS_KCC);
    const int r32 = C.lane & 31, hi = C.lane >> 5;
    for (int task = C.gw; task < 512; task += C.ngw) {
        const int R0 = task * 32, which = R0 >> 13;
        const half_t* W2 = (const half_t*)(C.ws + WS_W2T) + (size_t)(la * 2 + which) * 64 * 256;
        const float* b2 = (const float*)a->in[12] + (la * 2 + which) * 64;
        f32x16 acc[2]; acc[0] = (f32x16){}; acc[1] = (f32x16){};
        const half_t* ap = HC + (size_t)(R0 + r32) * 256 + hi * 8;
#pragma unroll 4
        for (int ks = 0; ks < 16; ++ks) {
            const h8 af = *(const h8*)(ap + ks * 16);
            const h8 w0 = *(const h8*)(W2 + (size_t)r32 * 256 + ks * 16 + hi * 8), w1 = *(const h8*)(W2 + (size_t)(32 + r32) * 256 + ks * 16 + hi * 8);
            acc[0] = __builtin_amdgcn_mfma_f32_32x32x16_f16(w0, af, acc[0], 0, 0, 0);
            acc[1] = __builtin_amdgcn_mfma_f32_32x32x16_f16(w1, af, acc[1], 0, 0, 0);
        }
        const int row = R0 + r32; const bool dead = (row & 127) == 127;
#pragma unroll
        for (int ct = 0; ct < 2; ++ct)
#pragma unroll
            for (int rg = 0; rg < 4; ++rg) { const int oc = 32 * ct + 8 * rg + 4 * hi; const f32x4 bb = *(const f32x4*)(b2 + oc);
                f32x4 v = {acc[ct][4 * rg] + bb[0], acc[ct][4 * rg + 1] + bb[1], acc[ct][4 * rg + 2] + bb[2], acc[ct][4 * rg + 3] + bb[3]};
                if (dead) v = (f32x4){0.f, 0.f, 0.f, 0.f};
                *(u32x2*)(KCC + (size_t)row * 64 + oc) = pk4(v); }
    }
}

constexpr int AL_K = 0, AL_V = 16384, AL_PSUM = 32768, AL_W = 65536;
__device__ __forceinline__ int crow(int r, int hi) { return (r & 3) + 8 * (r >> 2) + 4 * hi; }
__device__ __forceinline__ void kv_load(const half_t* Kt, const half_t* Vt, int wave, int lane, u32x4& kr, u32x4& vr) {
    kr = *(const u32x4*)(Kt + (size_t)lane * 64 + wave * 8);
    vr = *(const u32x4*)(Vt + (size_t)(16 * (wave & 3) + (lane >> 2)) * 64 + (wave >> 2) * 32 + (lane & 3) * 8);
}
__device__ __forceinline__ void kv_store(LAS unsigned char* Kb, LAS unsigned char* Vb, int wave, int lane, const u32x4 kr, const u32x4 vr) {
    *(LAS u32x4*)(Kb + wave * 1024 + lane * 16) = kr;
    *(LAS u32x4*)(Vb + (wave >> 2) * 4096 + (16 * (wave & 3) + (lane >> 2)) * 64 + (lane & 3) * 16) = vr;
}
__device__ __forceinline__ void qk_tile(f32x16& p0, f32x16& p1, const LAS unsigned char* Kb, const h8 (&qf)[4], int r32, int hi) {
    p0 = (f32x16){}; p1 = (f32x16){};
#pragma unroll
    for (int d0 = 0; d0 < 4; ++d0) {
        const h8 k0 = *(const LAS h8*)(Kb + (2 * d0 + hi) * 1024 + r32 * 16), k1 = *(const LAS h8*)(Kb + (2 * d0 + hi) * 1024 + (32 + r32) * 16);
        p0 = __builtin_amdgcn_mfma_f32_32x32x16_f16(k0, qf[d0], p0, 0, 0, 0);
        p1 = __builtin_amdgcn_mfma_f32_32x32x16_f16(k1, qf[d0], p1, 0, 0, 0);
    }
}
__device__ __forceinline__ s16x4 tr_read(const LAS unsigned char* p) { return __builtin_amdgcn_ds_read_tr16_b64_v4i16((LAS s16x4*)p); }
__device__ __forceinline__ h8 p8(const f32x16& p, int base) {
    return (h8){(half_t)p[base], (half_t)p[base + 1], (half_t)p[base + 2], (half_t)p[base + 3], (half_t)p[base + 4], (half_t)p[base + 5], (half_t)p[base + 6], (half_t)p[base + 7]};
}
__device__ __forceinline__ void pv_tile(f32x16 (&o)[2], const LAS unsigned char* Vb, const f32x16& p0, const f32x16& p1, int lane) {
    const int hi = lane >> 5;
    const LAS unsigned char* va = Vb + ((lane >> 4) & 1) * 32 + (lane & 3) * 8 + (4 * hi + ((lane & 15) >> 2)) * 64;
    h8 pf[4]; pf[0] = p8(p0, 0); pf[1] = p8(p0, 8); pf[2] = p8(p1, 0); pf[3] = p8(p1, 8);
#pragma unroll
    for (int dh = 0; dh < 2; ++dh)
#pragma unroll
        for (int s = 0; s < 4; ++s) {
            const s16x4 lo = tr_read(va + dh * 4096 + s * 1024), hh = tr_read(va + dh * 4096 + s * 1024 + 512);
            typedef short s16x8 __attribute__((ext_vector_type(8)));
            const s16x8 t8 = {lo[0], lo[1], lo[2], lo[3], hh[0], hh[1], hh[2], hh[3]};
            const h8 vf = __builtin_bit_cast(h8, t8);
            o[dh] = __builtin_amdgcn_mfma_f32_32x32x16_f16(vf, pf[s], o[dh], 0, 0, 0);
        }
}
__device__ __forceinline__ float max16(const f32x16& p) {
    float a = fmaxf(fmaxf(p[0], p[1]), fmaxf(p[2], p[3])), b = fmaxf(fmaxf(p[4], p[5]), fmaxf(p[6], p[7]));
    float c = fmaxf(fmaxf(p[8], p[9]), fmaxf(p[10], p[11])), d = fmaxf(fmaxf(p[12], p[13]), fmaxf(p[14], p[15]));
    return fmaxf(fmaxf(a, b), fmaxf(c, d));
}
__device__ __forceinline__ float sum16(const f32x16& p) {
    return (((p[0] + p[1]) + (p[2] + p[3])) + ((p[4] + p[5]) + (p[6] + p[7]))) + (((p[8] + p[9]) + (p[10] + p[11])) + ((p[12] + p[13]) + (p[14] + p[15])));
}

enum { MODE_WIN = 0, MODE_SEL = 1, MODE_SWA = 2 };
template <int MODE>
__device__ __forceinline__ void attn_unit(const Ctx& C, int b, int hkv, int chunk, const half_t* Q, const half_t* Kh, const half_t* Vh,
                                          const unsigned* selm, const float* Gt, float* Oacc, half_t* O, const float* sinks) {
    constexpr int GH = (MODE == MODE_SWA) ? 8 : 4, TPW = 32 / GH, TPB = 8 * TPW, WIN = (MODE == MODE_SWA) ? 128 : 512;
    const int lane = C.lane, wave = C.wave, r32 = lane & 31, hi = lane >> 5;
    const int t0 = chunk * TPB, tw0 = t0 + wave * TPW, tok = tw0 + r32 / GH, head = hkv * GH + (r32 % GH);
    const size_t gtok = (size_t)b * S + tok;
    LAS unsigned char* lds = C.lds;
    h8 qf[4];
#pragma unroll
    for (int d0 = 0; d0 < 4; ++d0) qf[d0] = *(const h8*)(Q + gtok * D + head * 64 + d0 * 16 + hi * 8);
    const int jlast = (t0 + TPB - 1) >> 6;
    unsigned tiles, msk = 0u, wneed = 0u;
    if (MODE == MODE_SEL) {
        msk = selm[tok]; unsigned x = msk;
#pragma unroll
        for (int o = 1; o < 64; o <<= 1) x |= (unsigned)shxi((int)x, o, lane);
        wneed = (unsigned)__builtin_amdgcn_readfirstlane((int)x);
        LAS unsigned* bw = (LAS unsigned*)(lds + AL_W);
        if (C.tid == 0) bw[0] = 0u;
        __syncthreads();
        if (lane == 0) __hip_atomic_fetch_or(bw, wneed, __ATOMIC_RELAXED, __HIP_MEMORY_SCOPE_WORKGROUP);
        __syncthreads();
        tiles = bw[0];
        tiles = (unsigned)__builtin_amdgcn_readfirstlane((int)tiles);
    } else {
        const int kfirst = t0 - WIN + 1, jlo = (kfirst > 0 ? kfirst : 0) >> 6;
        tiles = (jlast >= 31 ? 0xffffffffu : ((1u << (jlast + 1)) - 1u)) & ~((1u << jlo) - 1u);
    }
    float m = NEG_BIG, l = 0.f; f32x16 o[2]; o[0] = (f32x16){}; o[1] = (f32x16){};
    u32x4 kr, vr; int buf = 0;
    unsigned tm = tiles;
    { const int j = __builtin_ctz(tm); kv_load(Kh + (size_t)j * 4096, Vh + (size_t)j * 4096, wave, lane, kr, vr); kv_store(lds + AL_K, lds + AL_V, wave, lane, kr, vr); }
    __syncthreads();
    while (tm) {
        const int j = __builtin_ctz(tm); tm &= tm - 1u;
        const bool more = tm != 0u;
        if (more) { const int jn = __builtin_ctz(tm); kv_load(Kh + (size_t)jn * 4096, Vh + (size_t)jn * 4096, wave, lane, kr, vr); }
        bool need;
        if (MODE == MODE_SEL) need = (wneed >> j) & 1u;
        else need = (64 * j <= tw0 + TPW - 1) && (64 * j + 63 >= tw0 - WIN + 1);
        if (need) {
            f32x16 p0, p1; qk_tile(p0, p1, lds + AL_K + buf * 8192, qf, r32, hi);
            const bool rowok = (MODE == MODE_SEL) ? (((msk >> j) & 1u) != 0u) : true;
            float tmax = NEG_BIG;
#pragma unroll
            for (int r = 0; r < 16; ++r) { const int k0 = 64 * j + crow(r, hi), k1 = k0 + 32;
                const bool v0 = rowok && (k0 <= tok) && (MODE == MODE_SEL || k0 > tok - WIN), v1 = rowok && (k1 <= tok) && (MODE == MODE_SEL || k1 > tok - WIN);
                p0[r] = v0 ? p0[r] : NEG_BIG; p1[r] = v1 ? p1[r] : NEG_BIG; tmax = fmaxf(tmax, fmaxf(p0[r], p1[r])); }
            tmax = fmaxf(tmax, shx(tmax, 32, lane));
            const float mn = fmaxf(m, tmax), alpha = fast_exp2(m - mn);
            m = mn;
#pragma unroll
            for (int r = 0; r < 16; ++r) { p0[r] = (p0[r] > -1.0e29f) ? fast_exp2(p0[r] - mn) : 0.f; p1[r] = (p1[r] > -1.0e29f) ? fast_exp2(p1[r] - mn) : 0.f; }
            l = l * alpha + (sum16(p0) + sum16(p1));
#pragma unroll
            for (int r = 0; r < 16; ++r) { o[0][r] *= alpha; o[1][r] *= alpha; }
            pv_tile(o, lds + AL_V + buf * 8192, p0, p1, lane);
        }
        if (more) kv_store(lds + AL_K + (buf ^ 1) * 8192, lds + AL_V + (buf ^ 1) * 8192, wave, lane, kr, vr);
        __syncthreads();
        buf ^= 1;
    }
    float lt = l + shx(l, 32, lane);
    if (MODE == MODE_SWA) lt += fast_exp2(sinks[head] * LOG2E - m);
    float sc = 1.0f / lt;
    if (MODE != MODE_SWA) sc *= Gt[gtok * 48 + head * 3 + (MODE == MODE_SEL ? 1 : 2)];
#pragma unroll
    for (int dh = 0; dh < 2; ++dh)
#pragma unroll
        for (int rg = 0; rg < 4; ++rg) { const size_t off = gtok * D + head * 64 + 32 * dh + 8 * rg + 4 * hi;
            f32x4 v = {o[dh][4 * rg] * sc, o[dh][4 * rg + 1] * sc, o[dh][4 * rg + 2] * sc, o[dh][4 * rg + 3] * sc};
            if (MODE == MODE_SEL) { *(f32x4*)(Oacc + off) = *(const f32x4*)(Oacc + off) + v; }
            else { if (MODE == MODE_WIN) v = v + *(const f32x4*)(Oacc + off); *(u32x2*)(O + off) = pk4(v); } }
}

__device__ __forceinline__ void cmp_unit(const Ctx& C, int b, int hkv, int c, const half_t* Q, const half_t* Kc, const half_t* Vc, const float* Gt, float* Oacc, unsigned* selm) {
    const int lane = C.lane, wave = C.wave, r32 = lane & 31, hi = lane >> 5;
    const int t0 = c * 64, tl = wave * 8 + (r32 >> 2), tok = t0 + tl, head = hkv * 4 + (r32 & 3);
    const size_t gtok = (size_t)b * S + tok;
    LAS unsigned char* lds = C.lds;
    h8 qf[4];
#pragma unroll
    for (int d0 = 0; d0 < 4; ++d0) qf[d0] = *(const h8*)(Q + gtok * D + head * 64 + d0 * 16 + hi * 8);
    { u32x4 kr, vr;
      kv_load(Kc, Vc, wave, lane, kr, vr); kv_store(lds + AL_K, lds + AL_V, wave, lane, kr, vr);
      kv_load(Kc + 4096, Vc + 4096, wave, lane, kr, vr); kv_store(lds + AL_K + 8192, lds + AL_V + 8192, wave, lane, kr, vr); }
    __syncthreads();
    f32x16 p[4];
    qk_tile(p[0], p[1], lds + AL_K, qf, r32, hi); qk_tile(p[2], p[3], lds + AL_K + 8192, qf, r32, hi);
    const int nvis = (tok >= 31) ? ((tok - 31) >> 4) + 1 : 0;
    float mx = NEG_BIG;
#pragma unroll
    for (int q = 0; q < 4; ++q)
#pragma unroll
        for (int r = 0; r < 16; ++r) { const int n = 32 * q + crow(r, hi); p[q][r] = (n < nvis) ? p[q][r] : NEG_BIG; mx = fmaxf(mx, p[q][r]); }
    mx = fmaxf(mx, shx(mx, 32, lane));
    float l = 0.f;
#pragma unroll
    for (int q = 0; q < 4; ++q) {
#pragma unroll
        for (int r = 0; r < 16; ++r) p[q][r] = (p[q][r] > -1.0e29f) ? fast_exp2(p[q][r] - mx) : 0.f;
        l += sum16(p[q]); }
    l += shx(l, 32, lane);
    const float inv = (l > 0.f) ? 1.0f / l : 0.f;
#pragma unroll
    for (int q = 0; q < 4; ++q)
#pragma unroll
        for (int r = 0; r < 16; ++r) p[q][r] *= inv;
    f32x16 o[2]; o[0] = (f32x16){}; o[1] = (f32x16){};
    pv_tile(o, lds + AL_V, p[0], p[1], lane); pv_tile(o, lds + AL_V + 8192, p[2], p[3], lane);
    const float g0 = Gt[gtok * 48 + head * 3 + 0];
#pragma unroll
    for (int dh = 0; dh < 2; ++dh)
#pragma unroll
        for (int rg = 0; rg < 4; ++rg) { const size_t off = gtok * D + head * 64 + 32 * dh + 8 * rg + 4 * hi;
            *(f32x4*)(Oacc + off) = (f32x4){o[dh][4 * rg] * g0, o[dh][4 * rg + 1] * g0, o[dh][4 * rg + 2] * g0, o[dh][4 * rg + 3] * g0}; }
    LAS float* ps = (LAS float*)(lds + AL_PSUM);
#pragma unroll
    for (int q = 0; q < 4; ++q)
#pragma unroll
        for (int rg = 0; rg < 4; ++rg) { f32x4 v = {p[q][4 * rg], p[q][4 * rg + 1], p[q][4 * rg + 2], p[q][4 * rg + 3]};
#pragma unroll
            for (int e = 0; e < 4; ++e) { v[e] += shx(v[e], 1, lane); v[e] += shx(v[e], 2, lane); }
            if ((r32 & 3) == 0) *(LAS f32x4*)(ps + tl * 128 + 32 * q + 8 * rg + 4 * hi) = v; }
    __syncthreads();
#pragma unroll 1
    for (int it = 0; it < 4; ++it) {
        const int tl2 = wave * 8 + 2 * it + hi, j = r32; const LAS float* pr = ps + tl2 * 128 + 4 * j;
        const f32x4 q4 = *(const LAS f32x4*)pr; const float pm1 = (j > 0) ? pr[-1] : 0.f;
        const float imp = pm1 + 2.0f * q4[0] + 2.0f * q4[1] + 2.0f * q4[2] + q4[3];
        const bool forced = (j == 0) || (j == c) || (j == c - 1);
        const float val = forced ? __builtin_inff() : ((j <= c) ? imp : -__builtin_inff());
        int rank = 0;
#pragma unroll 8
        for (int jj = 0; jj < 32; ++jj) { const float vv = shidx(val, (lane & 32) + jj); rank += (vv > val || (vv == val && jj < j)) ? 1 : 0; }
        const bool sel = (rank < 8) && (j <= c);
        const unsigned long long bal = __ballot(sel);
        if (r32 == 0) selm[t0 + tl2] = hi ? (unsigned)(bal >> 32) : (unsigned)bal;
    }
    __syncthreads();
}

#ifndef REP_CMPSTAGE
#define REP_CMPSTAGE 1
#endif
#ifndef PROBE_MFMA2
#define PROBE_MFMA2 0
#endif
#ifndef PROBE_EXP2
#define PROBE_EXP2 0
#endif
#ifndef PROBE_LDS2
#define PROBE_LDS2 0
#endif
#ifndef PROBE_BAR2
#define PROBE_BAR2 0
#endif
constexpr int RG_SLOT = 16384;
constexpr int RG_NSLOT = 4;
constexpr int FL_CMPK = 65536, FL_CMPV = 81920, FL_PSUM = 98304, FL_MASK = LDSCTL_OFF + 1024, FL_WORD = LDSCTL_OFF + 1280;
constexpr float ATT_THR = 8.0f, M_INIT = -64.0f;
__device__ __forceinline__ void glds16(const void* gsrc, unsigned lds_dst) { unsigned keep;
    asm volatile("s_mov_b32 %0, m0\n\ts_mov_b32 m0, %2\n\ts_nop 0\n\tglobal_load_lds_dwordx4 %1, off\n\ts_mov_b32 m0, %0" : "=&s"(keep) : "v"(gsrc), "s"(lds_dst) : "memory"); }
#define ATT_WAIT_BAR(N) asm volatile("s_waitcnt vmcnt(" #N ") lgkmcnt(0)\n\ts_barrier" ::: "memory")
__device__ __forceinline__ void dma_tile(const half_t* Kt, const half_t* Vt, unsigned slot, int wave, int lane) {
    glds16(Kt + (size_t)lane * 64 + wave * 8, (unsigned)__builtin_amdgcn_readfirstlane((int)(slot + wave * 1024)));
    glds16(Vt + (size_t)(16 * (wave & 3) + (lane >> 2)) * 64 + (wave >> 2) * 32 + (lane & 3) * 8, (unsigned)__builtin_amdgcn_readfirstlane((int)(slot + 8192 + wave * 1024)));
}
template <int CTRL> __device__ __forceinline__ float dpp_f(float v) { return __builtin_bit_cast(float, __builtin_amdgcn_update_dpp(0, __builtin_bit_cast(int, v), CTRL, 0xF, 0xF, true)); }
__device__ __forceinline__ float swapmax(float v) { auto rr = __builtin_amdgcn_permlane32_swap(__float_as_uint(v), __float_as_uint(v), false, false); return fmaxf(__uint_as_float(rr[0]), __uint_as_float(rr[1])); }
__device__ __forceinline__ float swapsum(float v) { auto rr = __builtin_amdgcn_permlane32_swap(__float_as_uint(v), __float_as_uint(v), false, false); return __uint_as_float(rr[0]) + __uint_as_float(rr[1]); }

__device__ __forceinline__ float max3f(float a, float b, float c) { return __builtin_fmaxf(__builtin_fmaxf(a, b), c); }
__device__ __forceinline__ void k_frags(h8 (&kf)[8], const LAS unsigned char* Kb, int r32, int hi) {
#pragma unroll
    for (int d0 = 0; d0 < 4; ++d0) { kf[2 * d0] = *(const LAS h8*)(Kb + (2 * d0 + hi) * 1024 + r32 * 16); kf[2 * d0 + 1] = *(const LAS h8*)(Kb + (2 * d0 + hi) * 1024 + (32 + r32) * 16); }
}
template <bool PREF>
__device__ __forceinline__ void tile_step(const bool BOUNDARY, float& m, float& l, f32x16 (&o)[2], const h8 (&qf)[4], const h8 (&kf)[8], h8 (&kfn)[8],
                                          const LAS unsigned char* Vb, const LAS unsigned char* Kn, float rowbias, int kbase, int tok, int win, int lane) {
    typedef short s16x8 __attribute__((ext_vector_type(8)));
    const int r32 = lane & 31, hi = lane >> 5;
    const float ci = rowbias - m;
    f32x16 p0, p1;
#pragma unroll
    for (int r = 0; r < 16; ++r) { p0[r] = ci; p1[r] = ci; }
#pragma unroll
    for (int d0 = 0; d0 < 4; ++d0) {
        p0 = __builtin_amdgcn_mfma_f32_32x32x16_f16(kf[2 * d0], qf[d0], p0, 0, 0, 0);
        p1 = __builtin_amdgcn_mfma_f32_32x32x16_f16(kf[2 * d0 + 1], qf[d0], p1, 0, 0, 0);
    }
    if (PROBE_MFMA2) { f32x16 d0_ = p0, d1_ = p1;
#pragma unroll
        for (int d0 = 0; d0 < 4; ++d0) { d0_ = __builtin_amdgcn_mfma_f32_32x32x16_f16(kf[2 * d0], qf[d0], d0_, 0, 0, 0); d1_ = __builtin_amdgcn_mfma_f32_32x32x16_f16(kf[2 * d0 + 1], qf[d0], d1_, 0, 0, 0); }
        asm volatile("" :: "v"(d0_), "v"(d1_)); }
    const LAS unsigned char* va = Vb + ((lane >> 4) & 1) * 32 + (lane & 3) * 8 + (4 * hi + ((lane & 15) >> 2)) * 64;
    s16x4 vlo[8], vhi[8];
#pragma unroll
    for (int i = 0; i < 8; ++i) { vlo[i] = tr_read(va + (i >> 2) * 4096 + (i & 3) * 1024); vhi[i] = tr_read(va + (i >> 2) * 4096 + (i & 3) * 1024 + 512); }
    asm volatile("" ::: "memory");
    if (PREF) k_frags(kfn, Kn, r32, hi);
    asm volatile("" ::: "memory");
    if (BOUNDARY) {
        asm volatile("; boundary tile" ::: "memory");
        const int ub = tok - kbase - 4 * hi, lb = ub - win;
#pragma unroll
        for (int r = 0; r < 16; ++r) { const int cr = (r & 3) + 8 * (r >> 2);
            p0[r] = (cr <= ub && cr > lb) ? p0[r] : NEG_BIG; p1[r] = (cr + 32 <= ub && cr + 32 > lb) ? p1[r] : NEG_BIG; }
    }
    float ta = max3f(p0[0], p0[1], p0[2]), tb = max3f(p1[0], p1[1], p1[2]);
    ta = max3f(ta, p0[3], p0[4]); tb = max3f(tb, p1[3], p1[4]); ta = max3f(ta, p0[5], p0[6]); tb = max3f(tb, p1[5], p1[6]);
    ta = max3f(ta, p0[7], p0[8]); tb = max3f(tb, p1[7], p1[8]); ta = max3f(ta, p0[9], p0[10]); tb = max3f(tb, p1[9], p1[10]);
    ta = max3f(ta, p0[11], p0[12]); tb = max3f(tb, p1[11], p1[12]); ta = max3f(ta, p0[13], p0[14]); tb = max3f(tb, p1[13], p1[14]);
    const float tmax = swapmax(max3f(ta, tb, fmaxf(p0[15], p1[15])));
    if (__any(tmax > ATT_THR)) {
        asm volatile("; rescale" ::: "memory");
        const float dl = fmaxf(tmax, 0.f), f = fast_exp2(-dl);
        m += dl; l *= f;
#pragma unroll
        for (int r = 0; r < 16; ++r) { o[0][r] *= f; o[1][r] *= f; p0[r] -= dl; p1[r] -= dl; }
    }
    if (PROBE_EXP2) { f32x16 e_;
#pragma unroll
        for (int r = 0; r < 16; ++r) e_[r] = fast_exp2(p0[r] + 1.0f);
        asm volatile("" :: "v"(e_));
#pragma unroll
        for (int r = 0; r < 16; ++r) e_[r] = fast_exp2(p1[r] + 1.0f);
        asm volatile("" :: "v"(e_)); }
#pragma unroll
    for (int r = 0; r < 16; ++r) { p0[r] = fast_exp2(p0[r]); p1[r] = fast_exp2(p1[r]); }
    f32x2 s2 = {0.f, 0.f};
#pragma unroll
    for (int r = 0; r < 16; r += 2) { s2 += (f32x2){p0[r], p0[r + 1]}; s2 += (f32x2){p1[r], p1[r + 1]}; }
    l += s2[0] + s2[1];
    h8 pf[4]; pf[0] = p8(p0, 0); pf[1] = p8(p0, 8); pf[2] = p8(p1, 0); pf[3] = p8(p1, 8);
    asm volatile("s_waitcnt lgkmcnt(0)" : "+v"(vlo[0]), "+v"(vlo[1]), "+v"(vlo[2]), "+v"(vlo[3]), "+v"(vlo[4]), "+v"(vlo[5]), "+v"(vlo[6]), "+v"(vlo[7]),
                 "+v"(vhi[0]), "+v"(vhi[1]), "+v"(vhi[2]), "+v"(vhi[3]), "+v"(vhi[4]), "+v"(vhi[5]), "+v"(vhi[6]), "+v"(vhi[7]) :: "memory");
#pragma unroll
    for (int s = 0; s < 4; ++s)
#pragma unroll
        for (int dh = 0; dh < 2; ++dh) { const int i = dh * 4 + s;
            const s16x8 t8 = {vlo[i][0], vlo[i][1], vlo[i][2], vlo[i][3], vhi[i][0], vhi[i][1], vhi[i][2], vhi[i][3]};
            o[dh] = __builtin_amdgcn_mfma_f32_32x32x16_f16(__builtin_bit_cast(h8, t8), pf[s], o[dh], 0, 0, 0); }
}

__device__ __forceinline__ void nsa_unit(const Ctx& C, int b, int hkv, int c, const half_t* Q, const half_t* KV, const half_t* KCC, const float* Gt, half_t* O, const bool dry = false) {
    int lane_ = C.lane; asm volatile("" : "+v"(lane_));
    const int lane = lane_, wave = C.wave, r32 = lane & 31, hi = lane >> 5;
    const int bh = b * 4 + hkv, t0 = c * 64, tw0 = t0 + wave * 8, tl = wave * 8 + (r32 >> 2), tok = t0 + tl, head = hkv * 4 + (r32 & 3);
    const size_t gtok = (size_t)b * S + tok;
    LAS unsigned char* lds = C.lds;
    const unsigned ring = (unsigned)(size_t)lds;
    const half_t* Ks = KV + 2 * KVT + (size_t)bh * S * 64; const half_t* Vs = KV + 3 * KVT + (size_t)bh * S * 64;
    const half_t* Kw = KV + 4 * KVT + (size_t)bh * S * 64; const half_t* Vw = KV + 5 * KVT + (size_t)bh * S * 64;
    const int jlo = (c > 8) ? c - 8 : 0, n_win = dry ? 1 : c - jlo + 1;
    asm volatile("s_waitcnt vmcnt(0)" ::: "memory");
    dma_tile(Kw + (size_t)jlo * 4096, Vw + (size_t)jlo * 4096, ring, wave, lane);
    if (n_win >= 2) dma_tile(Kw + (size_t)(jlo + 1) * 4096, Vw + (size_t)(jlo + 1) * 4096, ring + RG_SLOT, wave, lane);
    if (n_win >= 3) dma_tile(Kw + (size_t)(jlo + 2) * 4096, Vw + (size_t)(jlo + 2) * 4096, ring + 2 * RG_SLOT, wave, lane);
    h8 qf[4];
#pragma unroll
    for (int d0 = 0; d0 < 4; ++d0) qf[d0] = *(const h8*)(Q + gtok * D + head * 64 + d0 * 16 + hi * 8);
    const float g_cmp = Gt[gtok * 48 + head * 3 + 0], g_sel = Gt[gtok * 48 + head * 3 + 1], g_win = Gt[gtok * 48 + head * 3 + 2];
    f32x16 oc[2];
    REPEAT(REP_CMPSTAGE) {
        const half_t* Kc = KCC + (size_t)bh * 128 * 64; const half_t* Vc = Kc + (size_t)64 * 128 * 64;
        { u32x4 kr, vr;
          kv_load(Kc, Vc, wave, lane, kr, vr); kv_store(lds + FL_CMPK, lds + FL_CMPV, wave, lane, kr, vr);
          kv_load(Kc + 4096, Vc + 4096, wave, lane, kr, vr); kv_store(lds + FL_CMPK + 8192, lds + FL_CMPV + 8192, wave, lane, kr, vr); }
        if (C.tid == 0) ((LAS unsigned*)(lds + FL_WORD))[0] = 0u;
        __syncthreads();
        const bool two = c > 15;
        f32x16 p[4];
        { h8 ka[8], kb[8]; k_frags(ka, lds + FL_CMPK, r32, hi); if (two) k_frags(kb, lds + FL_CMPK + 8192, r32, hi);
          asm volatile("s_waitcnt lgkmcnt(0)" : "+v"(ka[0]), "+v"(ka[1]), "+v"(ka[2]), "+v"(ka[3]), "+v"(ka[4]), "+v"(ka[5]), "+v"(ka[6]), "+v"(ka[7]) :: "memory");
          p[0] = (f32x16){}; p[1] = (f32x16){};
#pragma unroll
          for (int d0 = 0; d0 < 4; ++d0) { p[0] = __builtin_amdgcn_mfma_f32_32x32x16_f16(ka[2 * d0], qf[d0], p[0], 0, 0, 0); p[1] = __builtin_amdgcn_mfma_f32_32x32x16_f16(ka[2 * d0 + 1], qf[d0], p[1], 0, 0, 0); }
          if (two) { p[2] = (f32x16){}; p[3] = (f32x16){};
#pragma unroll
              for (int d0 = 0; d0 < 4; ++d0) { p[2] = __builtin_amdgcn_mfma_f32_32x32x16_f16(kb[2 * d0], qf[d0], p[2], 0, 0, 0); p[3] = __builtin_amdgcn_mfma_f32_32x32x16_f16(kb[2 * d0 + 1], qf[d0], p[3], 0, 0, 0); } }
          else {
#pragma unroll
              for (int r = 0; r < 16; ++r) { p[2][r] = NEG_BIG; p[3][r] = NEG_BIG; } } }
        const int nvis = ((tok >= 31) ? ((tok - 31) >> 4) + 1 : 0) - 4 * hi;
        float mx = NEG_BIG;
#pragma unroll
        for (int q = 0; q < 4; ++q)
#pragma unroll
            for (int r = 0; r < 16; ++r) { const int cn = 32 * q + (r & 3) + 8 * (r >> 2); p[q][r] = (cn < nvis) ? p[q][r] : NEG_BIG; mx = fmaxf(mx, p[q][r]); }
        mx = swapmax(mx);
        float l = 0.f;
#pragma unroll
        for (int q = 0; q < 4; ++q) {
#pragma unroll
            for (int r = 0; r < 16; ++r) p[q][r] = (p[q][r] > -1.0e29f) ? fast_exp2(p[q][r] - mx) : 0.f;
            l += sum16(p[q]); }
        l = swapsum(l);
        const float inv = (l > 0.f) ? 1.0f / l : 0.f;
#pragma unroll
        for (int q = 0; q < 4; ++q)
#pragma unroll
            for (int r = 0; r < 16; ++r) p[q][r] *= inv;
        oc[0] = (f32x16){}; oc[1] = (f32x16){};
        pv_tile(oc, lds + FL_CMPV, p[0], p[1], lane); if (two) pv_tile(oc, lds + FL_CMPV + 8192, p[2], p[3], lane);
#pragma unroll
        for (int r = 0; r < 16; ++r) { oc[0][r] *= g_cmp; oc[1][r] *= g_cmp; }
        LAS float* ps = (LAS float*)(lds + FL_PSUM);
#pragma unroll
        for (int q = 0; q < 4; ++q)
#pragma unroll
            for (int rg = 0; rg < 4; ++rg) { f32x4 v = {p[q][4 * rg], p[q][4 * rg + 1], p[q][4 * rg + 2], p[q][4 * rg + 3]};
#pragma unroll
                for (int e = 0; e < 4; ++e) { v[e] += dpp_f<0xB1>(v[e]); v[e] += dpp_f<0x4E>(v[e]); }
                if ((r32 & 3) == 0) *(LAS f32x4*)(ps + tl * 128 + 32 * q + 8 * rg + 4 * hi) = v; }
        asm volatile("s_waitcnt lgkmcnt(0)" ::: "memory");
        LAS unsigned* mk = (LAS unsigned*)(lds + FL_MASK); unsigned wor = 0u;
        if (c < 8) {
            const unsigned all = (2u << c) - 1u;
            if (lane < 8) mk[wave * 8 + lane] = all;
            wor = all;
        } else {
            LAS float* vl = (LAS float*)(lds + 3 * RG_SLOT) + wave * 256;
            float val[4];
#pragma unroll
            for (int it = 0; it < 4; ++it) {
                const int tl2 = wave * 8 + 2 * it + hi, j = r32; const LAS float* pr = ps + tl2 * 128 + 4 * j;
                const f32x4 q4 = *(const LAS f32x4*)pr; const float pm1 = (j > 0) ? pr[-1] : 0.f;
                const float imp = pm1 + 2.0f * q4[0] + 2.0f * q4[1] + 2.0f * q4[2] + q4[3];
                const bool forced = (j == 0) || (j == c) || (j == c - 1);
                val[it] = forced ? __builtin_inff() : ((j <= c) ? imp : -__builtin_inff());
            }
#pragma unroll
            for (int it = 0; it < 4; ++it) vl[(2 * it + hi) * 32 + r32] = val[it];
            asm volatile("s_waitcnt lgkmcnt(0)" ::: "memory");
#pragma unroll 1
            for (int it = 0; it < 4; ++it) {
                const LAS f32x4* vr = (const LAS f32x4*)(vl + (2 * it + hi) * 32); const int j = r32; const float v0 = val[it];
                f32x4 w[8];
#pragma unroll
                for (int q = 0; q < 8; ++q) w[q] = vr[q];
                int rank = 0;
#pragma unroll
                for (int q = 0; q < 8; ++q)
#pragma unroll
                    for (int e = 0; e < 4; ++e) { const float vv = w[q][e]; const int jj = 4 * q + e; rank += (vv > v0 || (vv == v0 && jj < j)) ? 1 : 0; }
                const bool sel = (rank < 8) && (j <= c);
                const unsigned long long bal = __ballot(sel);
                const unsigned mine = hi ? (unsigned)(bal >> 32) : (unsigned)bal;
                if (r32 == 0) mk[wave * 8 + 2 * it + hi] = mine;
                wor |= (unsigned)bal | (unsigned)(bal >> 32);
            }
        }
        if (lane == 0) __hip_atomic_fetch_or((LAS unsigned*)(lds + FL_WORD), wor, __ATOMIC_RELAXED, __HIP_MEMORY_SCOPE_WORKGROUP);
        __syncthreads();
    }
    LAS f32x4* ocl = (LAS f32x4*)(lds + FL_CMPK + wave * 8192) + lane;
#pragma unroll
    for (int q = 0; q < 8; ++q) ocl[q * 64] = (f32x4){oc[q >> 2][4 * (q & 3)], oc[q >> 2][4 * (q & 3) + 1], oc[q >> 2][4 * (q & 3) + 2], oc[q >> 2][4 * (q & 3) + 3]};
    const unsigned msk = ((const LAS unsigned*)(lds + FL_MASK))[tl];
    unsigned wneed = msk;
#pragma unroll
    for (int o_ = 1; o_ < 64; o_ <<= 1) wneed |= (unsigned)shxi((int)wneed, o_, lane);
    wneed = (unsigned)__builtin_amdgcn_readfirstlane((int)wneed);
    const unsigned bneed = dry ? 0u : (unsigned)__builtin_amdgcn_readfirstlane((int)((const LAS unsigned*)(lds + FL_WORD))[0]);
    const int n_tot = n_win + __builtin_popcount(bneed);
    unsigned dbits = bneed, cbits = bneed;
    if (n_win < 2 && n_tot >= 2) { const int j = __builtin_ctz(dbits); dbits &= dbits - 1u; dma_tile(Ks + (size_t)j * 4096, Vs + (size_t)j * 4096, ring + RG_SLOT, wave, lane); }
    if (n_win < 3 && n_tot >= 3) { const int j = __builtin_ctz(dbits); dbits &= dbits - 1u; dma_tile(Ks + (size_t)j * 4096, Vs + (size_t)j * 4096, ring + 2 * RG_SLOT, wave, lane); }
    float m = M_INIT, l = 0.f; f32x16 o[2]; o[0] = (f32x16){}; o[1] = (f32x16){};
    h8 kf[8];
    int j_c, win_c, j_n = 0, win_n = 512; bool need_c, bnd_c, need_n = false, bnd_n = false; float rb_c, rb_n = 0.f;
#define NSA_DECODE(E, J, NEED, BND, RB, WIN) do { if ((E) < n_win) { J = jlo + (E); NEED = (64 * J <= tw0 + 7) && (64 * J + 63 >= tw0 - 511); BND = (64 * J + 63 > tw0) || (64 * J <= tw0 + 7 - 512); RB = 0.f; WIN = 512; } \
        else { J = __builtin_ctz(cbits); cbits &= cbits - 1u; NEED = (wneed >> J) & 1u; BND = (J == c); RB = ((msk >> J) & 1u) ? 0.f : NEG_BIG; WIN = 1 << 20; } } while (0)
    NSA_DECODE(0, j_c, need_c, bnd_c, rb_c, win_c);
    if (n_tot >= 3) ATT_WAIT_BAR(2); else ATT_WAIT_BAR(0);
    h8 kfB[8];
    if (need_c) k_frags(kf, lds, r32, hi);
    int slot_c = 0, slot_d = 3;
#define NSA_STEP(E, KU, KP) do { \
        if ((E) > 0) { if ((E) + 2 < n_tot) ATT_WAIT_BAR(2); else ATT_WAIT_BAR(0); }     \
        if (PROBE_BAR2) asm volatile("s_barrier" ::: "memory"); \
        if ((E) + 3 < n_tot) { \
            if ((E) + 3 < n_win) { const int jn = jlo + (E) + 3; dma_tile(Kw + (size_t)jn * 4096, Vw + (size_t)jn * 4096, ring + slot_d * RG_SLOT, wave, lane); } \
            else { const int jn = __builtin_ctz(dbits); dbits &= dbits - 1u; dma_tile(Ks + (size_t)jn * 4096, Vs + (size_t)jn * 4096, ring + slot_d * RG_SLOT, wave, lane); } \
        } \
        const bool has_n = (E) + 1 < n_tot; \
        if (has_n) NSA_DECODE((E) + 1, j_n, need_n, bnd_n, rb_n, win_n); \
        const int slot_n = (slot_c == RG_NSLOT - 1) ? 0 : slot_c + 1; \
        const LAS unsigned char* Vb = lds + slot_c * RG_SLOT + 8192; const LAS unsigned char* Kn = lds + slot_n * RG_SLOT; \
        if (need_c) tile_step<true>(bnd_c, m, l, o, qf, KU, KP, Vb, Kn, rb_c, 64 * j_c, tok, win_c, lane);     \
        else k_frags(KP, Kn, r32, hi); \
        if ((E) == n_win - 1) {                                          \
            const float sc = g_win / swapsum(l); \
            _Pragma("unroll") for (int q = 0; q < 8; ++q) { f32x4 t = ocl[q * 64]; t[0] += o[q >> 2][4 * (q & 3)] * sc; t[1] += o[q >> 2][4 * (q & 3) + 1] * sc; t[2] += o[q >> 2][4 * (q & 3) + 2] * sc; t[3] += o[q >> 2][4 * (q & 3) + 3] * sc; ocl[q * 64] = t; } \
            o[0] = (f32x16){}; o[1] = (f32x16){}; \
            m = M_INIT; l = 0.f; \
        } \
        j_c = j_n; need_c = need_n; bnd_c = bnd_n; rb_c = rb_n; win_c = win_n; \
        slot_c = slot_n; slot_d = (slot_d == RG_NSLOT - 1) ? 0 : slot_d + 1; \
    } while (0)
#pragma unroll 1
    for (int e = 0; e < n_tot; e += 2) {
        NSA_STEP(e, kf, kfB);
        if (e + 1 < n_tot) NSA_STEP(e + 1, kfB, kf);
    }
#undef NSA_STEP
#undef NSA_DECODE
    {
        const float sc = g_sel / swapsum(l);
#pragma unroll
        for (int dh = 0; dh < 2; ++dh)
#pragma unroll
            for (int rg = 0; rg < 4; ++rg) { const size_t off = gtok * D + head * 64 + 32 * dh + 8 * rg + 4 * hi;
                const f32x4 t = ocl[(dh * 4 + rg) * 64];
                const f32x4 v = {t[0] + o[dh][4 * rg] * sc, t[1] + o[dh][4 * rg + 1] * sc, t[2] + o[dh][4 * rg + 2] * sc, t[3] + o[dh][4 * rg + 3] * sc};
                if (!dry) *(u32x2*)(O + off) = pk4(v); }
    }
    asm volatile("s_waitcnt lgkmcnt(0)\n\ts_barrier" ::: "memory");
}

__device__ __forceinline__ void swa_unit(const Ctx& C, int b, int hkv, int j, const half_t* Q, const half_t* Kh, const half_t* Vh, const float* sinks, half_t* O) {
    int lane_ = C.lane; asm volatile("" : "+v"(lane_));
    const int lane = lane_, wave = C.wave, r32 = lane & 31, hi = lane >> 5;
    const int head = hkv * 8 + (r32 & 7);
    LAS unsigned char* lds = C.lds; const unsigned ring = (unsigned)(size_t)lds;
    const int jlo = (j > 2) ? j - 2 : 0, n_tot = j - jlo + 1;
    asm volatile("s_waitcnt vmcnt(0)" ::: "memory");
    dma_tile(Kh + (size_t)jlo * 4096, Vh + (size_t)jlo * 4096, ring, wave, lane);
    if (n_tot >= 2) dma_tile(Kh + (size_t)(jlo + 1) * 4096, Vh + (size_t)(jlo + 1) * 4096, ring + RG_SLOT, wave, lane);
    if (n_tot >= 3) dma_tile(Kh + (size_t)(jlo + 2) * 4096, Vh + (size_t)(jlo + 2) * 4096, ring + 2 * RG_SLOT, wave, lane);
    const float sk = sinks[head] * LOG2E;
    h8 qfa[4], qfb[4];
    const int tokA = j * 64 + 4 * wave + (r32 >> 3), tokB = tokA + 32;
    const size_t gA = (size_t)b * S + tokA, gB = gA + 32;
#pragma unroll
    for (int d0 = 0; d0 < 4; ++d0) { qfa[d0] = *(const h8*)(Q + gA * D + head * 64 + d0 * 16 + hi * 8); qfb[d0] = *(const h8*)(Q + gB * D + head * 64 + d0 * 16 + hi * 8); }
    ATT_WAIT_BAR(0);
#pragma unroll
    for (int g = 0; g < 2; ++g) {
        const int tw0 = j * 64 + 32 * g + 4 * wave, tok = g ? tokB : tokA; const size_t gtok = g ? gB : gA;
        float m = M_INIT, l = 0.f; f32x16 o[2]; o[0] = (f32x16){}; o[1] = (f32x16){};
        h8 kf0[8], kf1[8];
        k_frags(kf0, lds, r32, hi);
#define SWA_STEP(E, KU, KP) do { if ((E) < n_tot) { const int jt = jlo + (E); const LAS unsigned char* Kb = lds + (E) * RG_SLOT; \
            const bool need = (64 * jt <= tw0 + 3) && (64 * jt + 63 >= tw0 - 127), bnd = (64 * jt + 63 > tw0) || (64 * jt <= tw0 + 3 - 128); \
            if (need) tile_step<true>(bnd, m, l, o, g ? qfb : qfa, KU, KP, Kb + 8192, lds + (((E) + 1) % 3) * RG_SLOT, 0.f, 64 * jt, tok, 128, lane); \
            else k_frags(KP, lds + (((E) + 1) % 3) * RG_SLOT, r32, hi); } } while (0)
        SWA_STEP(0, kf0, kf1); SWA_STEP(1, kf1, kf0); SWA_STEP(2, kf0, kf1);
#undef SWA_STEP
        const float sc = 1.0f / (swapsum(l) + fast_exp2(sk - m));
#pragma unroll
        for (int dh = 0; dh < 2; ++dh)
#pragma unroll
            for (int rg = 0; rg < 4; ++rg) { const size_t off = gtok * D + head * 64 + 32 * dh + 8 * rg + 4 * hi;
                const f32x4 v = {o[dh][4 * rg] * sc, o[dh][4 * rg + 1] * sc, o[dh][4 * rg + 2] * sc, o[dh][4 * rg + 3] * sc};
                *(u32x2*)(O + off) = pk4(v); }
        __builtin_amdgcn_sched_barrier(0);
    }
    asm volatile("s_waitcnt lgkmcnt(0)\n\ts_barrier" ::: "memory");
}

#ifndef EN_PRO
#define EN_PRO 1
#endif
#ifndef EN_ROW
#define EN_ROW 1
#endif
#ifndef EN_INPROJ
#define EN_INPROJ 1
#endif
#ifndef EN_CMP1
#define EN_CMP1 1
#endif
#ifndef EN_CMP2
#define EN_CMP2 1
#endif
#ifndef EN_CMPATT
#define EN_CMPATT 1
#endif
#ifndef EN_SEL
#define EN_SEL 1
#endif
#ifndef EN_WIN
#define EN_WIN 1
#endif
#ifndef EN_SWA
#define EN_SWA 1
#endif
#ifndef EN_OUT
#define EN_OUT 1
#endif
#ifndef EN_UP
#define EN_UP 1
#endif
#ifndef EN_DOWN
#define EN_DOWN 1
#endif
#ifndef REP_PRO
#define REP_PRO 1
#endif
#ifndef REP_ROWF
#define REP_ROWF 1
#endif
#ifndef REP_INPROJ
#define REP_INPROJ 1
#endif
#ifndef REP_CMP1
#define REP_CMP1 1
#endif
#ifndef REP_CMP2
#define REP_CMP2 1
#endif
#ifndef REP_NSA
#define REP_NSA 1
#endif
#ifndef REP_SWA
#define REP_SWA 1
#endif
#ifndef REP_OUT
#define REP_OUT 1
#endif
#ifndef REP_UP
#define REP_UP 1
#endif
#ifndef REP_DOWN
#define REP_DOWN 1
#endif
#ifndef PROBE_DRY
#define PROBE_DRY 0
#endif
constexpr int NPHASE = 3 + 11 * DEPTH;
__host__ __device__ constexpr bool phase_exists(int p) { return p < 3 ? true : (((p - 3) / 11) % 2 == 0 ? !(((p - 3) % 11) == 4 || ((p - 3) % 11) == 5) : !(((p - 3) % 11) >= 1 && ((p - 3) % 11) <= 4)); }

__global__ void __launch_bounds__(512, 2) mk_fwd(Args a) {
    extern __shared__ __attribute__((aligned(16))) unsigned char lds_raw[];
    Ctx C;
    C.lds = (LAS unsigned char*)lds_raw;
    const int wave0 = __builtin_amdgcn_readfirstlane((int)(threadIdx.x >> 6));
    C.lane = (int)__builtin_amdgcn_mbcnt_hi(~0u, __builtin_amdgcn_mbcnt_lo(~0u, 0u)); C.wave = wave0; C.tid = wave0 * 64 + C.lane;
    C.G = gridDim.x; C.gw = blockIdx.x * 8 + C.wave; C.ngw = C.G * 8; C.ws = (unsigned char*)a.ws;
    GAS unsigned char* ws = a.ws;
    for (int u = C.tid; u < (LDS_BYTES - LDSCTL_OFF) / 4; u += 512) ((LAS unsigned*)(C.lds + LDSCTL_OFF))[u] = 0u;
    __syncthreads();
#if MK_ONE_LAUNCH
    XcdBarrier bar = xcd_barrier_post((unsigned*)(ws + WS_CTL) + CW_BAR, (volatile LAS unsigned*)(C.lds + MISC_OFF) + 8);
#define SEAM() xcd_barrier(bar)
#else
#define SEAM() do { } while (0)
#endif
    const int lo = a.ph_lo, hi = a.ph_hi;
#define RUN(p) (lo <= (p) && (p) < hi)
#define FRESH() Ctx Cp = C; ArgsP ap = (ArgsP)__builtin_amdgcn_kernarg_segment_ptr(); { int w_ = wave0; asm volatile("" : "+s"(w_), "+s"(ap)); int l_; asm volatile("v_mbcnt_lo_u32_b32 %0, -1, 0\n\tv_mbcnt_hi_u32_b32 %0, -1, %0" : "=v"(l_)); Cp.tid = w_ * 64 + l_; Cp.lane = l_; Cp.wave = w_; Cp.gw = blockIdx.x * 8 + w_; } GAS unsigned char* const wsx = ap->ws; Cp.ws = (unsigned char*)wsx; (void)wsx;
#define Hb ((half_t*)(wsx + WS_H))
#define Yb ((half_t*)(wsx + WS_Y))
#define Qb ((half_t*)(wsx + WS_Q))
#define KVb ((half_t*)(wsx + WS_KV))
#define Ob ((half_t*)(wsx + WS_O))
#define Gb ((float*)(wsx + WS_G))
#define HIDb ((half_t*)(wsx + WS_BIG))
#define ropeb ((const float*)(wsx + WS_ROPE))

    if (EN_PRO && RUN(0)) { FRESH(); REPEAT(REP_PRO) { phase_prologue(ap, Cp); __syncthreads(); } SEAM(); }
    if (EN_PRO && RUN(1)) { FRESH(); phase_modfinal(ap, Cp); SEAM(); }
    if (EN_ROW && RUN(2)) { FRESH(); REPEAT(REP_ROWF) phase_row_first(ap, Cp); SEAM(); }

#pragma unroll 1
    for (int L = 0; L < DEPTH; ++L) {
        const int pb = 3 + 11 * L, la = L >> 1; const bool nsa = (L & 1) == 0;
        if (EN_INPROJ && RUN(pb + 0)) { FRESH();
            if (nsa) { pg8::Gemm g{Hb, (const half_t*)(wsx + WS_WINN) + (size_t)la * NSA_INP * D, M, NSA_INP, D, D}; pg8::StaticOrder So; So.init(M, NSA_INP, C.G, (int)blockIdx.x);
                pg8::EpiNsaIn E{Qb, KVb, Gb, ropeb};
                REPEAT(REP_INPROJ) pg8::gemm_phase<pg8::EpiNsaIn, pg8::StaticOrder, true, true>(C.lds, g, So, E, Cp.tid);
            } else { pg8::Gemm g{Hb, (const half_t*)(wsx + WS_WINS) + (size_t)la * SWA_IN * D, M, SWA_IN, D, D}; pg8::StaticOrder So; So.init(M, SWA_IN, C.G, (int)blockIdx.x);
                pg8::EpiSwaIn E{Qb, KVb, ropeb};
                REPEAT(REP_INPROJ) pg8::gemm_phase<pg8::EpiSwaIn, pg8::StaticOrder, true, true>(C.lds, g, So, E, Cp.tid);
            }
            SEAM();
        }
        if (nsa) {
            if (EN_CMP1 && RUN(pb + 1)) { FRESH();
                pg8::Gemm g{KVb, (const half_t*)(wsx + WS_W1T) + (size_t)la * 512 * 2048, 16384, 512, 2048, 1024}; pg8::CmpOrder So{C.G, (int)blockIdx.x};
                pg8::EpiF16<2> E{(half_t*)(wsx + WS_HIDC), 256, (const float*)(wsx + WS_B1F) + la * 512};
                REPEAT(REP_CMP1) pg8::gemm_phase<pg8::EpiF16<2>, pg8::CmpOrder, true, true>(C.lds, g, So, E, Cp.tid);
                SEAM();
            }
            if (EN_CMP2 && RUN(pb + 2)) { FRESH(); REPEAT(REP_CMP2) phase_cmp2(ap, Cp, la); SEAM(); }
            if (EN_CMPATT && RUN(pb + 3)) { FRESH();
                REPEAT(REP_NSA) for (int u = blockIdx.x; u < NB * 4 * 32; u += C.G) { const int k = u & 255, i = u >> 8, bh = k >> 2, s_ = k & 3, a_ = 3 - (i >> 1), c = (i & 1) ? (8 * a_ + s_) : (8 * a_ + 7 - s_);
                    nsa_unit(Cp, bh >> 2, bh & 3, c, Qb, KVb, (const half_t*)(wsx + WS_KCC), Gb, Ob);
                    if (PROBE_DRY) nsa_unit(Cp, bh >> 2, bh & 3, c, Qb, KVb, (const half_t*)(wsx + WS_KCC), Gb, Ob, true); }
                SEAM();
            }
        } else {
            if (EN_SWA && RUN(pb + 5)) { FRESH();
                const float* sinks = (const float*)ap->in[15] + la * 16;
                REPEAT(REP_SWA) for (int u = blockIdx.x; u < NB * 2 * 32; u += C.G) { const int j = 31 - (u & 31), bh = u >> 5;
                    swa_unit(Cp, bh >> 1, bh & 1, j, Qb, KVb + (size_t)bh * S * 64, KVb + (size_t)M * 128 + (size_t)bh * S * 64, sinks, Ob); }
                SEAM();
            }
        }
        if (EN_OUT && RUN(pb + 6)) { FRESH();
            pg8::Gemm g{Ob, (const half_t*)(wsx + WS_WOUT) + (size_t)L * D * D, M, D, D, D}; pg8::StaticOrder So; So.init(M, D, C.G, (int)blockIdx.x);
            pg8::EpiF16<0> E{Yb, D, nullptr};
            REPEAT(REP_OUT) pg8::gemm_phase<pg8::EpiF16<0>, pg8::StaticOrder, true, true>(C.lds, g, So, E, Cp.tid);
            SEAM();
        }
        if (EN_ROW && RUN(pb + 7)) { FRESH(); phase_row_update(ap, Cp, L, 0); SEAM(); }
        if (EN_UP && RUN(pb + 8)) { FRESH();
            pg8::Gemm g{Hb, (const half_t*)(wsx + WS_WUP) + (size_t)L * FF * D, M, FF, D, D}; pg8::StaticOrder So; So.init(M, FF, C.G, (int)blockIdx.x);
            pg8::EpiF16<1> E{HIDb, FF, nullptr};
            REPEAT(REP_UP) pg8::gemm_phase<pg8::EpiF16<1>, pg8::StaticOrder, true, true>(C.lds, g, So, E, Cp.tid);
            SEAM();
        }
        if (EN_DOWN && RUN(pb + 9)) { FRESH();
            pg8::Gemm g{HIDb, (const half_t*)(wsx + WS_WDN) + (size_t)L * D * FF, M, D, FF, FF}; pg8::StaticOrder So; So.init(M, D, C.G, (int)blockIdx.x);
            pg8::EpiF16<0> E{(half_t*)(wsx + WS_Y2), D, nullptr};
            REPEAT(REP_DOWN) pg8::gemm_phase<pg8::EpiF16<0>, pg8::StaticOrder, true, true>(C.lds, g, So, E, Cp.tid);
            SEAM();
        }
        if (EN_ROW && RUN(pb + 10)) { FRESH(); phase_row_update(ap, Cp, L, 1); if (L + 1 < DEPTH) SEAM(); }
    }
#undef RUN
#undef Hb
#undef Yb
#undef Qb
#undef KVb
#undef Ob
#undef Gb
#undef HIDb
#undef ropeb
#undef SEAM
}

extern "C" void kernel_launch(void* const* d_in, const int* in_sizes, int n_in, void* d_out, int out_size, void* d_ws, size_t ws_size, hipStream_t stream) {
    static int grid = 0;
    if (grid == 0) {
        if (n_in != 18 || in_sizes[0] != M * D || out_size != M * D || ws_size < WS_END) {
            fprintf(stderr, "kernel_launch: built for 18 inputs, x/out of %d floats, >= %zu bytes of workspace; got n_in %d, in0 %d, out %d, ws %zu; nothing launched\n", M * D, (size_t)WS_END, n_in, n_in > 0 ? in_sizes[0] : -1, out_size, ws_size);
            grid = -1; return; }
        int dev = 0, cus = 0, per_cu = 0;
        if (hipGetDevice(&dev) != hipSuccess || hipDeviceGetAttribute(&cus, hipDeviceAttributeMultiprocessorCount, dev) != hipSuccess) { fprintf(stderr, "kernel_launch: device query failed\n"); grid = -1; return; }
        if (hipFuncSetAttribute((const void*)mk_fwd, hipFuncAttributeMaxDynamicSharedMemorySize, LDS_BYTES) != hipSuccess) { fprintf(stderr, "kernel_launch: hipFuncSetAttribute failed\n"); grid = -1; return; }
        if (hipOccupancyMaxActiveBlocksPerMultiprocessor(&per_cu, (const void*)mk_fwd, 512, LDS_BYTES) != hipSuccess || per_cu < 1)
            fprintf(stderr, "kernel_launch: note: occupancy query reports %d workgroups per CU\n", per_cu);
        (void)hipGetLastError();
        if (cus < 256) { fprintf(stderr, "kernel_launch: built for a 256-CU device, found %d CUs; nothing launched\n", cus); grid = -1; return; }
        grid = 256;
    }
    if (grid < 0) return;
    if (hipMemsetAsync((char*)d_ws + WS_CTL, 0, CTL_ZERO_BYTES, stream) != hipSuccess) { fprintf(stderr, "kernel_launch: memset failed\n"); return; }
    Args a{};
    for (int i = 0; i < 18; ++i) a.in[i] = (const GAS void*)d_in[i];
    a.out = (GAS float*)d_out; a.ws = (GAS unsigned char*)d_ws;
#if MK_ONE_LAUNCH
    a.ph_lo = 0; a.ph_hi = NPHASE;
    hipLaunchKernelGGL(mk_fwd, dim3(grid), dim3(512), LDS_BYTES, stream, a);
#else
    for (int p = 0; p < NPHASE; ++p) { if (!phase_exists(p)) continue;
        a.ph_lo = p; a.ph_hi = p + 1;
        hipLaunchKernelGGL(mk_fwd, dim3(grid), dim3(512), LDS_BYTES, stream, a); }
#endif
    const hipError_t le = hipPeekAtLastError();
    if (le != hipSuccess) fprintf(stderr, "kernel_launch: launch failed: %s\n", hipGetErrorName(le));
}
```
